# Optimizing an MI355X kernel written in HIP

```python
import math
import jax
import jax.numpy as jnp
from jax import lax
import numpy as np

D_MODEL = 1024
BATCH = 32
SEQ = 256
DEPTH = 4
DEC_BATCH = 2
DEC_SEQ = 2048
PAST_LEN = 256

GRID_W = 64
N_MIXERS = 4
EXPAND = 2
E = EXPAND * D_MODEL
EPS = 1e-6
SSD_HEAD_DIM = 64
SSD_HEADS = E // SSD_HEAD_DIM
SSD_GROUPS = 8
SSD_STATE = 128
SSD_CHUNK = 128
CONV_W = 5
SSD_GN = SSD_GROUPS * SSD_STATE
SSD_CONV_CH = E + 2 * SSD_GN
SSD_IN = E + SSD_CONV_CH + 2 * SSD_HEADS
MLP_CHUNK = 128
MLP_GROUPS = 8
S5_GROUP = 16
S5_GROUPS = E // S5_GROUP
S5_STATE = 64
ATT_HEAD_DIM = 64
ATT_HEADS = E // ATT_HEAD_DIM
WIN_ROWS = 8
WIN_COLS = 16
ATT_BLOCK = 128
N_SSD = (DEPTH + 3) // 4
N_MLP = (DEPTH + 2) // 4
N_S5 = (DEPTH + 1) // 4
N_NAT = DEPTH // 4

kernel_name = 'hybrid_ssd_gmlp_s5_natten_diffusion_step'


def rms_norm(x, g):
    xf = x.astype(jnp.float32)
    y = xf * lax.rsqrt(jnp.mean(xf * xf, axis=-1, keepdims=True) + EPS)
    return (y * g.astype(jnp.float32)).astype(x.dtype)


def layer_norm(x, g, b):
    xf = x.astype(jnp.float32)
    xc = xf - jnp.mean(xf, axis=-1, keepdims=True)
    y = xc * lax.rsqrt(jnp.mean(xc * xc, axis=-1, keepdims=True) + EPS)
    return (y * g.astype(jnp.float32) + b.astype(jnp.float32)).astype(x.dtype)


def adaln(x, g, mod):
    shift, scale, gate = jnp.split(mod, 3, axis=-1)
    return rms_norm(x, g) * (1.0 + scale) + shift, gate


def dw_conv(x, w, bias):
    k = w.shape[0]
    l = x.shape[1]
    pad = k // 2
    xp = jnp.pad(x, ((0, 0), (pad, k - 1 - pad), (0, 0)))
    acc = xp[:, 0:l] * w[0]
    for j in range(1, k):
        acc = acc + xp[:, j:j + l] * w[j]
    return acc + bias


def segsum(x):
    t = x.shape[-1]
    xr = jnp.broadcast_to(x[..., :, None], x.shape + (t,))
    xr = jnp.where(jnp.tril(jnp.ones((t, t), bool), -1), xr, 0.0)
    ss = jnp.cumsum(xr, axis=-2)
    return jnp.where(jnp.tril(jnp.ones((t, t), bool)), ss, -jnp.inf)


def ssd_scan(x, dt, a, bmat, cmat, h0):
    b, l, h, p = x.shape
    g, n = bmat.shape[2], bmat.shape[3]
    r = h // g
    nc = l // SSD_CHUNK
    xd = (x * dt[..., None]).reshape(b, nc, SSD_CHUNK, g, r, p)
    da = (dt * a).astype(jnp.float32).reshape(b, nc, SSD_CHUNK, g, r)
    da = jnp.transpose(da, (0, 3, 4, 1, 2))
    bm = bmat.reshape(b, nc, SSD_CHUNK, g, n)
    cm = cmat.reshape(b, nc, SSD_CHUNK, g, n)
    a_cum = jnp.cumsum(da, axis=-1)
    decay_in = jnp.exp(segsum(da))
    y_diag = jnp.einsum('bclgn,bcsgn,bgrcls,bcsgrp->bclgrp', cm, bm, decay_in, xd)
    decay_st = jnp.exp(a_cum[..., -1:] - a_cum)
    states = jnp.einsum('bclgn,bgrcl,bclgrp->bcgrpn', bm, decay_st, xd)
    h0r = h0.reshape(b, g, r, p, n).astype(states.dtype)
    states = jnp.concatenate([h0r[:, None], states], axis=1)
    chunk_tot = jnp.pad(a_cum[..., -1], ((0, 0), (0, 0), (0, 0), (1, 0)))
    decay_ch = jnp.exp(segsum(chunk_tot))
    new_states = jnp.einsum('bgrzc,bcgrpn->bzgrpn', decay_ch, states)
    states, final = new_states[:, :-1], new_states[:, -1]
    y_off = jnp.einsum('bclgn,bcgrpn,bgrcl->bclgrp', cm, states, jnp.exp(a_cum))
    y = (y_diag + y_off).reshape(b, l, h, p)
    return y, final.reshape(b, h, p, n)


def ssd_mixer(u, conv_w, conv_b, dt_bias, a_log, d_skip, norm_g, h0):
    b, l, _ = u.shape
    z = u[..., :E]
    xbc = jax.nn.silu(dw_conv(u[..., E:E + SSD_CONV_CH], conv_w, conv_b))
    dt_raw = u[..., E + SSD_CONV_CH:].reshape(b, l, 2, SSD_HEADS)
    xs = xbc[..., :E].reshape(b, l, SSD_HEADS, SSD_HEAD_DIM)
    bm = xbc[..., E:E + SSD_GN].reshape(b, l, SSD_GROUPS, SSD_STATE)
    cm = xbc[..., E + SSD_GN:].reshape(b, l, SSD_GROUPS, SSD_STATE)
    dt = jax.nn.softplus((dt_raw + dt_bias).astype(jnp.float32))
    a = -jnp.exp(a_log.astype(jnp.float32))
    flip = lambda t: jnp.flip(t, axis=1)
    y_f, h_f = ssd_scan(xs, dt[:, :, 0], a[0], bm, cm, h0[:, 0])
    y_b, h_b = ssd_scan(flip(xs), flip(dt[:, :, 1]), a[1], flip(bm), flip(cm), h0[:, 1])
    y = y_f + flip(y_b) + d_skip[:, None] * xs
    y = rms_norm(y.reshape(b, l, E) * jax.nn.silu(z), norm_g)
    return y.astype(u.dtype), jnp.stack([h_f, h_b], axis=1)


def gmlp_mixer(u, ln_g, ln_b, w_s, b_s):
    b, l, _ = u.shape
    uu = jax.nn.gelu(u[..., :E])
    vv = layer_norm(jax.nn.gelu(u[..., E:2 * E]), ln_g, ln_b)
    z = u[..., 2 * E:]
    nc = l // MLP_CHUNK
    vv = vv.reshape(b, nc, MLP_CHUNK, MLP_GROUPS, E // MLP_GROUPS)
    s = jnp.einsum('gij,bcjgd->bcigd', w_s, vv) + b_s.T[:, :, None]
    return uu * s.reshape(b, l, E) * jax.nn.silu(z)


def complex_combine(e1, e2):
    a1r, a1i, b1r, b1i = e1
    a2r, a2i, b2r, b2i = e2
    return (a2r * a1r - a2i * a1i, a2r * a1i + a2i * a1r,
            a2r * b1r - a2i * b1i + b2r, a2r * b1i + a2i * b1r + b2i)


def s5_mixer(u, lam_re, lam_im, log_step, b_re, b_im, c_re, c_im, d_skip, w_glu, b_glu, h0):
    b, l, _ = u.shape
    uu = u[..., :E]
    z = u[..., E:]
    ug = uu.reshape(b, l, S5_GROUPS, S5_GROUP).astype(jnp.float32)
    ys = []
    finals = []
    for d in range(2):
        lr = lam_re[d].astype(jnp.float32)
        li = lam_im[d].astype(jnp.float32)
        step = jnp.exp(log_step[d].astype(jnp.float32))[:, None]
        mag = jnp.exp(lr * step)
        ang = li * step
        ab_re = mag * jnp.cos(ang)
        ab_im = mag * jnp.sin(ang)
        den = lr * lr + li * li
        nr = ab_re - 1.0
        cr = (nr * lr + ab_im * li) / den
        ci = (ab_im * lr - nr * li) / den
        br = b_re[d].astype(jnp.float32)
        bi = b_im[d].astype(jnp.float32)
        bb_re = cr[..., None] * br - ci[..., None] * bi
        bb_im = cr[..., None] * bi + ci[..., None] * br
        seq = ug if d == 0 else jnp.flip(ug, axis=1)
        drv_re = jnp.einsum('gnj,blgj->blgn', bb_re, seq)
        drv_im = jnp.einsum('gnj,blgj->blgn', bb_im, seq)
        h_re = h0[:, d, 0].astype(jnp.float32)
        h_im = h0[:, d, 1].astype(jnp.float32)
        drv_re = drv_re.at[:, 0].add(ab_re * h_re - ab_im * h_im)
        drv_im = drv_im.at[:, 0].add(ab_re * h_im + ab_im * h_re)
        a_re = jnp.broadcast_to(ab_re, (1, l, S5_GROUPS, S5_STATE))
        a_im = jnp.broadcast_to(ab_im, (1, l, S5_GROUPS, S5_STATE))
        _, _, s_re, s_im = lax.associative_scan(complex_combine, (a_re, a_im, drv_re, drv_im), axis=1)
        y_d = (jnp.einsum('gjn,blgn->blgj', c_re[d].astype(jnp.float32), s_re)
               - jnp.einsum('gjn,blgn->blgj', c_im[d].astype(jnp.float32), s_im))
        if d == 1:
            y_d = jnp.flip(y_d, axis=1)
        ys.append(y_d)
        finals.append(jnp.stack([s_re[:, -1], s_im[:, -1]], axis=1))
    y = ((ys[0] + ys[1]).reshape(b, l, E) + d_skip * uu).astype(u.dtype)
    y = jax.nn.gelu(y)
    y = y * jax.nn.sigmoid(y @ w_glu + b_glu)
    return y * jax.nn.silu(z), jnp.stack(finals, axis=1)


def split_heads(t):
    return t.reshape(t.shape[0], t.shape[1], ATT_HEADS, ATT_HEAD_DIM)


def context_attention(q, k, v):
    b, s = q.shape[0], q.shape[1]
    nb = s // ATT_BLOCK
    scale = ATT_HEAD_DIM ** -0.5
    qb = jnp.moveaxis(q.reshape(b, nb, ATT_BLOCK, ATT_HEADS, ATT_HEAD_DIM), 1, 0)

    def one_block(qi):
        logits = jnp.einsum('bqhd,bhkd->bhqk', qi, k).astype(jnp.float32) * scale
        p = jax.nn.softmax(logits, axis=-1).astype(v.dtype)
        return jnp.einsum('bhqk,bhkd->bqhd', p, v)

    out = lax.map(one_block, qb)
    return jnp.moveaxis(out, 0, 1).reshape(b, s, E)


def neighbourhood_attention(q, k, v, ck, cv, rpb):
    b, l = q.shape[0], q.shape[1]
    rows = l // GRID_W
    wr = min(WIN_ROWS, rows)
    nw = wr * GRID_W
    scale = ATT_HEAD_DIM ** -0.5
    qg = q.reshape(b, rows, GRID_W, ATT_HEADS, ATT_HEAD_DIM)
    kg = k.reshape(b, rows, GRID_W, ATT_HEADS, ATT_HEAD_DIM)
    vg = v.reshape(b, rows, GRID_W, ATT_HEADS, ATT_HEAD_DIM)
    r_idx = jnp.arange(rows)
    r_start = jnp.clip(r_idx - wr // 2, 0, rows - wr)
    key_rows = r_start[:, None] + jnp.arange(wr)[None, :]
    kb = kg[:, key_rows].reshape(b, rows, nw, ATT_HEADS, ATT_HEAD_DIM)
    vb = vg[:, key_rows].reshape(b, rows, nw, ATT_HEADS, ATT_HEAD_DIM)
    c_idx = jnp.arange(GRID_W)
    c_start = jnp.clip(c_idx - WIN_COLS // 2, 0, GRID_W - WIN_COLS)
    col_ok = (c_idx[None, :] >= c_start[:, None]) & (c_idx[None, :] < c_start[:, None] + WIN_COLS)
    mask = jnp.broadcast_to(col_ok[:, None, :], (GRID_W, wr, GRID_W)).reshape(GRID_W, nw)
    idx_r = key_rows - r_idx[:, None] + (WIN_ROWS - 1)
    idx_c = jnp.clip(c_idx[None, :] - c_idx[:, None] + (WIN_COLS - 1), 0, 2 * WIN_COLS - 2)
    bias = rpb[:, idx_r[:, None, :, None], idx_c[None, :, None, :]].reshape(ATT_HEADS, rows, GRID_W, nw)
    s_win = jnp.einsum('brqhd,brkhd->bhrqk', qg, kb).astype(jnp.float32) * scale + bias.astype(jnp.float32)
    s_win = jnp.where(mask, s_win, -jnp.inf)
    s_ctx = jnp.einsum('brqhd,bhpd->bhrqp', qg, ck).astype(jnp.float32) * scale
    p = jax.nn.softmax(jnp.concatenate([s_win, s_ctx], axis=-1), axis=-1).astype(v.dtype)
    out = (jnp.einsum('bhrqk,brkhd->brqhd', p[..., :nw], vb)
           + jnp.einsum('bhrqp,bhpd->brqhd', p[..., nw:], cv))
    return out.reshape(b, l, E)


def setup_inputs(seed: int = 0) -> dict:
    key = jax.random.key(seed)
    keys = iter(jax.random.split(key, 64))

    def nrm(shape, scale):
        return jax.random.normal(next(keys), shape, jnp.float32) * scale

    def unif(shape, lo, hi):
        return jax.random.uniform(next(keys), shape, jnp.float32, minval=lo, maxval=hi)

    dt0 = jnp.exp(unif((N_SSD, 2, SSD_HEADS), math.log(1e-3), math.log(1e-1)))
    inp = {}
    inp['x_prompt'] = nrm((BATCH, SEQ, D_MODEL), 1.0)
    inp['x_sample'] = nrm((DEC_BATCH, DEC_SEQ, D_MODEL), 1.0)
    inp['state_ssd'] = nrm((DEC_BATCH, N_SSD, 2, SSD_HEADS, SSD_HEAD_DIM, SSD_STATE), 0.1)
    inp['state_s5'] = nrm((DEC_BATCH, N_S5, 2, 2, S5_GROUPS, S5_STATE), 0.1)
    inp['cache_k'] = nrm((DEC_BATCH, N_NAT, ATT_HEADS, PAST_LEN, ATT_HEAD_DIM), 1.0)
    inp['cache_v'] = nrm((DEC_BATCH, N_NAT, ATT_HEADS, PAST_LEN, ATT_HEAD_DIM), 1.0)
    inp['c'] = nrm((DEC_BATCH, D_MODEL), 1.0)
    inp['c_ctx'] = nrm((D_MODEL,), 1.0)
    inp['norm_g'] = 1.0 + nrm((DEPTH, D_MODEL), 0.02)
    inp['w_mod'] = nrm((DEPTH, D_MODEL, 3 * D_MODEL), 0.5 * D_MODEL ** -0.5)
    inp['b_mod'] = nrm((DEPTH, 3 * D_MODEL), 0.02)
    inp['w_out'] = nrm((DEPTH, E, D_MODEL), E ** -0.5)
    inp['final_g'] = 1.0 + nrm((D_MODEL,), 0.02)
    inp['ssd_w_in'] = nrm((N_SSD, D_MODEL, SSD_IN), D_MODEL ** -0.5)
    inp['ssd_conv_w'] = nrm((N_SSD, CONV_W, SSD_CONV_CH), CONV_W ** -0.5)
    inp['ssd_conv_b'] = nrm((N_SSD, SSD_CONV_CH), 0.02)
    inp['ssd_dt_bias'] = dt0 + jnp.log(-jnp.expm1(-dt0))
    inp['ssd_a_log'] = jnp.log(unif((N_SSD, 2, SSD_HEADS), 1.0, 16.0))
    inp['ssd_d'] = 1.0 + nrm((N_SSD, SSD_HEADS), 0.02)
    inp['ssd_norm_g'] = 1.0 + nrm((N_SSD, E), 0.02)
    inp['mlp_w_in'] = nrm((N_MLP, D_MODEL, 3 * E), D_MODEL ** -0.5)
    inp['mlp_ln_g'] = 1.0 + nrm((N_MLP, E), 0.02)
    inp['mlp_ln_b'] = nrm((N_MLP, E), 0.02)
    inp['mlp_w_s'] = nrm((N_MLP, MLP_GROUPS, MLP_CHUNK, MLP_CHUNK), MLP_CHUNK ** -0.5)
    inp['mlp_b_s'] = 1.0 + nrm((N_MLP, MLP_GROUPS, MLP_CHUNK), 0.02)
    inp['s5_w_in'] = nrm((N_S5, D_MODEL, 2 * E), D_MODEL ** -0.5)
    inp['s5_lam_re'] = -0.5 + nrm((N_S5, 2, S5_GROUPS, S5_STATE), 0.01)
    inp['s5_lam_im'] = jnp.pi * jnp.arange(S5_STATE, dtype=jnp.float32) + nrm((N_S5, 2, S5_GROUPS, S5_STATE), 0.01)
    inp['s5_log_step'] = unif((N_S5, 2, S5_GROUPS), math.log(1e-3), math.log(1e-1))
    inp['s5_b_re'] = nrm((N_S5, 2, S5_GROUPS, S5_STATE, S5_GROUP), (2 * S5_GROUP) ** -0.5)
    inp['s5_b_im'] = nrm((N_S5, 2, S5_GROUPS, S5_STATE, S5_GROUP), (2 * S5_GROUP) ** -0.5)
    inp['s5_c_re'] = nrm((N_S5, 2, S5_GROUPS, S5_GROUP, S5_STATE), S5_STATE ** -0.5)
    inp['s5_c_im'] = nrm((N_S5, 2, S5_GROUPS, S5_GROUP, S5_STATE), S5_STATE ** -0.5)
    inp['s5_d'] = nrm((N_S5, E), 1.0)
    inp['s5_w_glu'] = nrm((N_S5, E, E), E ** -0.5)
    inp['s5_b_glu'] = nrm((N_S5, E), 0.02)
    inp['nat_w_in'] = nrm((N_NAT, D_MODEL, 4 * E), D_MODEL ** -0.5)
    inp['nat_rpb'] = nrm((N_NAT, ATT_HEADS, 2 * WIN_ROWS - 1, 2 * WIN_COLS - 1), 0.1)
    return inp


def reference(x_prompt, x_sample, state_ssd, state_s5, cache_k, cache_v, c, c_ctx,
              norm_g, w_mod, b_mod, w_out, final_g,
              ssd_w_in, ssd_conv_w, ssd_conv_b, ssd_dt_bias, ssd_a_log, ssd_d, ssd_norm_g,
              mlp_w_in, mlp_ln_g, mlp_ln_b, mlp_w_s, mlp_b_s,
              s5_w_in, s5_lam_re, s5_lam_im, s5_log_step, s5_b_re, s5_b_im, s5_c_re, s5_c_im,
              s5_d, s5_w_glu, s5_b_glu,
              nat_w_in, nat_rpb):
    xc = x_prompt
    xl = x_sample
    bc, sc_len = xc.shape[0], xc.shape[1]
    cond_ctx = jax.nn.silu(c_ctx)
    cond_lat = jax.nn.silu(c)[:, None, :]
    new_ssd, new_s5, new_k, new_v = [], [], [], []
    for i in range(DEPTH):
        kind = i % N_MIXERS
        j = i // N_MIXERS
        hc, gate_c = adaln(xc, norm_g[i], cond_ctx @ w_mod[i] + b_mod[i])
        hl, gate_l = adaln(xl, norm_g[i], cond_lat @ w_mod[i] + b_mod[i])
        if kind == 0:
            h0 = jnp.zeros((bc, 2, SSD_HEADS, SSD_HEAD_DIM, SSD_STATE), jnp.float32)
            yc, st = ssd_mixer(hc @ ssd_w_in[j], ssd_conv_w[j], ssd_conv_b[j], ssd_dt_bias[j],
                               ssd_a_log[j], ssd_d[j], ssd_norm_g[j], h0)
            yl, _ = ssd_mixer(hl @ ssd_w_in[j], ssd_conv_w[j], ssd_conv_b[j], ssd_dt_bias[j],
                              ssd_a_log[j], ssd_d[j], ssd_norm_g[j], state_ssd[:, j])
            new_ssd.append(st.astype(x_prompt.dtype))
        elif kind == 1:
            yc = gmlp_mixer(hc @ mlp_w_in[j], mlp_ln_g[j], mlp_ln_b[j], mlp_w_s[j], mlp_b_s[j])
            yl = gmlp_mixer(hl @ mlp_w_in[j], mlp_ln_g[j], mlp_ln_b[j], mlp_w_s[j], mlp_b_s[j])
        elif kind == 2:
            h0 = jnp.zeros((bc, 2, 2, S5_GROUPS, S5_STATE), jnp.float32)
            yc, st = s5_mixer(hc @ s5_w_in[j], s5_lam_re[j], s5_lam_im[j], s5_log_step[j], s5_b_re[j],
                              s5_b_im[j], s5_c_re[j], s5_c_im[j], s5_d[j], s5_w_glu[j], s5_b_glu[j], h0)
            yl, _ = s5_mixer(hl @ s5_w_in[j], s5_lam_re[j], s5_lam_im[j], s5_log_step[j], s5_b_re[j],
                             s5_b_im[j], s5_c_re[j], s5_c_im[j], s5_d[j], s5_w_glu[j], s5_b_glu[j],
                             state_s5[:, j])
            new_s5.append(st.astype(x_prompt.dtype))
        else:
            uc = hc @ nat_w_in[j]
            k_ctx = jnp.transpose(split_heads(uc[..., E:2 * E]), (0, 2, 1, 3))
            v_ctx = jnp.transpose(split_heads(uc[..., 2 * E:3 * E]), (0, 2, 1, 3))
            yc = context_attention(split_heads(uc[..., :E]), k_ctx, v_ctx) * jax.nn.silu(uc[..., 3 * E:])
            ul = hl @ nat_w_in[j]
            yl = neighbourhood_attention(split_heads(ul[..., :E]), split_heads(ul[..., E:2 * E]),
                                         split_heads(ul[..., 2 * E:3 * E]), cache_k[:, j], cache_v[:, j],
                                         nat_rpb[j]) * jax.nn.silu(ul[..., 3 * E:])
            new_k.append(k_ctx)
            new_v.append(v_ctx)
        xc = xc + gate_c * (yc @ w_out[i])
        xl = xl + gate_l * (yl @ w_out[i])
    y_prompt = rms_norm(xc, final_g)
    y_sample = rms_norm(xl, final_g)
    return (y_prompt, y_sample, jnp.stack(new_ssd, axis=1), jnp.stack(new_s5, axis=1),
            jnp.stack(new_k, axis=1), jnp.stack(new_v, axis=1))
```

```cpp
#include <hip/hip_runtime.h>
#include <hip/hip_cooperative_groups.h>
#include <cstdio>
#include <cstdint>
#include <cstring>
namespace cg = cooperative_groups;

typedef unsigned short bf16_t;
typedef short bf16x8 __attribute__((ext_vector_type(8)));
typedef short s16x4 __attribute__((ext_vector_type(4)));
typedef float f32x4 __attribute__((ext_vector_type(4)));
typedef float f32x2 __attribute__((ext_vector_type(2)));
typedef unsigned u32x4 __attribute__((ext_vector_type(4)));
typedef unsigned u32x2 __attribute__((ext_vector_type(2)));
#define LAS __attribute__((address_space(3)))
#define WAVE_LDS_SYNC() do { asm volatile("s_waitcnt lgkmcnt(0)" ::: "memory"); __builtin_amdgcn_wave_barrier(); } while (0)

constexpr int NT = 512;
constexpr int DM = 1024, EE = 2048;
constexpr int TOK = 12288, TOKC = 8192;
constexpr int NCHUNK = 96;
constexpr float EPSN = 1e-6f;
constexpr int LDS_BYTES = 147456;

constexpr size_t WS_WT_SSD = 0;
constexpr size_t WS_WT_MLP = WS_WT_SSD + (size_t)6272 * 1024 * 2;
constexpr size_t WS_WT_S5  = WS_WT_MLP + (size_t)6144 * 1024 * 2;
constexpr size_t WS_WT_NAT = WS_WT_S5 + (size_t)4096 * 1024 * 2;
constexpr size_t WS_WT_GLU = WS_WT_NAT + (size_t)8192 * 1024 * 2;
constexpr size_t WS_WT_OUT = WS_WT_GLU + (size_t)2048 * 2048 * 2;
constexpr size_t WS_H      = WS_WT_OUT + (size_t)4 * 1024 * 2048 * 2;
constexpr size_t WS_MOD    = WS_H + (size_t)TOK * 1024 * 2;
constexpr size_t WS_DT     = WS_MOD + 147456;
constexpr size_t WS_ACUM   = WS_DT + (size_t)TOK * 64 * 4;
constexpr size_t WS_SSQ    = WS_ACUM + (size_t)TOK * 64 * 4;
constexpr size_t WS_STATS  = WS_SSQ + (size_t)TOK * 32 * 4;
constexpr size_t WS_U      = WS_H + (size_t)TOK * 1024 * 2 + 8388608;
constexpr size_t WS_END    = WS_U + (size_t)TOK * 6144 * 2;
static_assert(WS_STATS + (size_t)TOK * 8 <= WS_U, "small region overflow");
static_assert(WS_END <= 268435456, "workspace over 256 MiB");

constexpr size_t OUT_SSD = (size_t)TOK * 1024;
constexpr size_t OUT_S5  = OUT_SSD + (size_t)32 * 2 * 32 * 64 * 128;
constexpr size_t OUT_CK  = OUT_S5 + (size_t)32 * 2 * 2 * 128 * 64;
constexpr size_t OUT_CV  = OUT_CK + (size_t)32 * 32 * 256 * 64;

struct TJob { const float* src; bf16_t* dst; int K, N, Npad, tile0; };
struct Params {
    const float* in[38];
    float* out;
    char* ws;
    TJob jobs[9];
    int total_tiles, pad;
};

__device__ __forceinline__ float bf2f(unsigned h) { return __uint_as_float(h << 16); }
__device__ __forceinline__ float bflo(unsigned u) { return __uint_as_float(u << 16); }
__device__ __forceinline__ float bfhi(unsigned u) { return __uint_as_float(u & 0xffff0000u); }
__device__ __forceinline__ unsigned f2bf(float f) { unsigned u = __float_as_uint(f); u += 0x7fffu + ((u >> 16) & 1u); return u >> 16; }
__device__ __forceinline__ unsigned pack2(float a, float b) { return f2bf(a) | (f2bf(b) << 16); }
__device__ __forceinline__ u32x2 pack4(f32x4 v) { u32x2 r; r.x = pack2(v[0], v[1]); r.y = pack2(v[2], v[3]); return r; }
__device__ __forceinline__ f32x4 unpack4(u32x2 u) { f32x4 r; r[0] = bflo(u.x); r[1] = bfhi(u.x); r[2] = bflo(u.y); r[3] = bfhi(u.y); return r; }
__device__ __forceinline__ void unpack8(u32x4 u, float* f) {
    f[0] = bflo(u.x); f[1] = bfhi(u.x); f[2] = bflo(u.y); f[3] = bfhi(u.y); f[4] = bflo(u.z); f[5] = bfhi(u.z); f[6] = bflo(u.w); f[7] = bfhi(u.w);
}
__device__ __forceinline__ u32x4 pack8(const float* f) { u32x4 r; r.x = pack2(f[0], f[1]); r.y = pack2(f[2], f[3]); r.z = pack2(f[4], f[5]); r.w = pack2(f[6], f[7]); return r; }
__device__ __forceinline__ float siluf(float x) { return x / (1.f + __expf(-x)); }
__device__ __forceinline__ float sigmf(float x) { return 1.f / (1.f + __expf(-x)); }
__device__ __forceinline__ float geluf(float x) {
    const float y = 0.7978845608028654f * (x + 0.044715f * x * x * x);
    const float t = 1.f - 2.f / (__expf(2.f * y) + 1.f);
    return 0.5f * x * (1.f + t);
}
__device__ __forceinline__ float softplusf(float x) { return x > 20.f ? x : log1pf(__expf(x)); }
__device__ __forceinline__ float wave_sum(float v) {
#pragma unroll
    for (int o = 32; o > 0; o >>= 1) v += __shfl_xor(v, o);
    return v;
}
__device__ __forceinline__ int cond_idx(int t) { return t < TOKC ? 0 : 1 + ((t - TOKC) >> 11); }
__device__ __forceinline__ f32x4 mfma16(bf16x8 a, bf16x8 b, f32x4 c) { return __builtin_amdgcn_mfma_f32_16x16x32_bf16(a, b, c, 0, 0, 0); }
__device__ __forceinline__ bf16x8 as_frag(u32x4 u) { union { u32x4 a; bf16x8 b; } x; x.a = u; return x.b; }

__device__ __forceinline__ bf16x8 frag_rm(const bf16_t* tile, int stride, int row0, int k0, int lane) {
    return *(const bf16x8*)(tile + (row0 + (lane & 15)) * stride + k0 + 8 * (lane >> 4));
}
__device__ __forceinline__ bf16x8 frag_tr(const bf16_t* tile, int stride, int k0, int c0, int lane) {
    const bf16_t* p = tile + (k0 + 8 * (lane >> 4) + ((lane >> 2) & 3)) * stride + c0 + 4 * (lane & 3);
    s16x4 lo = __builtin_amdgcn_ds_read_tr16_b64_v4i16((LAS s16x4*)p);
    s16x4 hi = __builtin_amdgcn_ds_read_tr16_b64_v4i16((LAS s16x4*)(p + 4 * stride));
    bf16x8 r; r[0] = lo[0]; r[1] = lo[1]; r[2] = lo[2]; r[3] = lo[3]; r[4] = hi[0]; r[5] = hi[1]; r[6] = hi[2]; r[7] = hi[3];
    return r;
}
__device__ __forceinline__ int sw64(int row, int col) { return row * 64 + ((((col >> 3) ^ (row >> 1)) & 7) << 3) + (col & 7); }
__device__ __forceinline__ bf16x8 frag_rm_sw(const bf16_t* tile, int row0, int k0, int lane) {
    const int row = row0 + (lane & 15);
    return *(const bf16x8*)(tile + sw64(row, k0 + 8 * (lane >> 4)));
}
__device__ __forceinline__ bf16x8 frag_tr_sw(const bf16_t* tile, int k0, int c0, int lane) {
    const int row = k0 + 8 * (lane >> 4) + ((lane >> 2) & 3), col = c0 + 4 * (lane & 3);
    s16x4 lo = __builtin_amdgcn_ds_read_tr16_b64_v4i16((LAS s16x4*)(tile + sw64(row, col)));
    s16x4 hi = __builtin_amdgcn_ds_read_tr16_b64_v4i16((LAS s16x4*)(tile + sw64(row + 4, col)));
    bf16x8 r; r[0] = lo[0]; r[1] = lo[1]; r[2] = lo[2]; r[3] = lo[3]; r[4] = hi[0]; r[5] = hi[1]; r[6] = hi[2]; r[7] = hi[3];
    return r;
}

template <int MI, class Epi>
__device__ __forceinline__ void gemm_phase(const bf16_t* __restrict__ A, int lda, const bf16_t* __restrict__ Bt, int M, int Npad, int K,
                                           const Epi& epi, char* smem) {
    constexpr int BM = 64 * MI, BN = 128, BK = 64;
    constexpr int BUF = (BM + BN) * 128;
    const int tid = threadIdx.x, lane = tid & 63, wid = tid >> 6, wm = wid & 3, wn = wid >> 2;
    const int nM = M / BM, nN = Npad / BN, nk = K / BK;
    const int G = gridDim.x, bid = blockIdx.x;
    const bool xmap = ((G & 7) == 0) && ((nM & 7) == 0);
    const int tmPerX = nM >> 3, perX = tmPerX * nN;
    const int jstart = xmap ? (bid >> 3) : bid, jstep = xmap ? (G >> 3) : G, jend = xmap ? perX : nM * nN;
    const int srow = tid >> 3, sc = tid & 7;
    const int soff = srow * 128 + ((sc ^ ((srow >> 1) & 7)) << 4);
    const int fsw = (lane >> 1) & 7;
    for (int j = jstart; j < jend; j += jstep) {
        int tm, tn;
        if (xmap) { tn = j / tmPerX; tm = (bid & 7) * tmPerX + (j - tn * tmPerX); } else { tm = j % nM; tn = j / nM; }
        const int m0 = tm * BM, n0 = tn * BN;
        const bf16_t* ag = A + (size_t)(m0 + srow) * lda + sc * 8;
        const bf16_t* bg = Bt + (size_t)(n0 + srow) * K + sc * 8;
        f32x4 acc[MI][4];
#pragma unroll
        for (int a = 0; a < MI; ++a)
#pragma unroll
            for (int b = 0; b < 4; ++b) acc[a][b] = (f32x4){0.f, 0.f, 0.f, 0.f};
        u32x4 ra[MI], rb[2];
#pragma unroll
        for (int a = 0; a < MI; ++a) ra[a] = *(const u32x4*)(ag + (size_t)a * 64 * lda);
#pragma unroll
        for (int b = 0; b < 2; ++b) rb[b] = *(const u32x4*)(bg + (size_t)b * 64 * K);
#pragma unroll
        for (int a = 0; a < MI; ++a) *(u32x4*)(smem + soff + a * 8192) = ra[a];
#pragma unroll
        for (int b = 0; b < 2; ++b) *(u32x4*)(smem + BM * 128 + soff + b * 8192) = rb[b];
        __syncthreads();
        for (int kt = 0; kt < nk; ++kt) {
            const char* cur = smem + (kt & 1) * BUF;
            char* nxt = smem + ((kt + 1) & 1) * BUF;
            if (kt + 1 < nk) {
#pragma unroll
                for (int a = 0; a < MI; ++a) ra[a] = *(const u32x4*)(ag + (size_t)a * 64 * lda + (kt + 1) * BK);
#pragma unroll
                for (int b = 0; b < 2; ++b) rb[b] = *(const u32x4*)(bg + (size_t)b * 64 * K + (kt + 1) * BK);
            }
#pragma unroll
            for (int ks = 0; ks < 2; ++ks) {
                bf16x8 af[MI], bfr[4];
                const int ch = (((ks * 4 + (lane >> 4)) ^ fsw) << 4);
#pragma unroll
                for (int a = 0; a < MI; ++a) af[a] = *(const bf16x8*)(cur + (wm * 16 * MI + a * 16 + (lane & 15)) * 128 + ch);
#pragma unroll
                for (int b = 0; b < 4; ++b) bfr[b] = *(const bf16x8*)(cur + BM * 128 + (wn * 64 + b * 16 + (lane & 15)) * 128 + ch);
#pragma unroll
                for (int a = 0; a < MI; ++a)
#pragma unroll
                    for (int b = 0; b < 4; ++b) acc[a][b] = mfma16(bfr[b], af[a], acc[a][b]);
            }
            if (kt + 1 < nk) {
#pragma unroll
                for (int a = 0; a < MI; ++a) *(u32x4*)(nxt + soff + a * 8192) = ra[a];
#pragma unroll
                for (int b = 0; b < 2; ++b) *(u32x4*)(nxt + BM * 128 + soff + b * 8192) = rb[b];
            }
            __syncthreads();
        }
#pragma unroll
        for (int a = 0; a < MI; ++a) {
            const int row = m0 + wm * 16 * MI + a * 16 + (lane & 15);
            const float rs = epi.rowscale(row);
#pragma unroll
            for (int b = 0; b < 4; ++b) epi(row, n0 + wn * 64 + b * 16 + (lane >> 4) * 4, acc[a][b], rs);
        }
    }
}

struct EpiSSD {
    bf16_t* Uz; bf16_t* Uxbc; float* DT; const float* dt_bias;
    __device__ __forceinline__ float rowscale(int) const { return 1.f; }
    __device__ __forceinline__ void operator()(int row, int col, f32x4 v, float) const {
        if (col < 2048) { f32x4 s; for (int i = 0; i < 4; ++i) s[i] = siluf(v[i]); *(u32x2*)(Uz + (size_t)row * 2048 + col) = pack4(s); }
        else if (col < 6144) { *(u32x2*)(Uxbc + (size_t)row * 4096 + (col - 2048)) = pack4(v); }
        else if (col < 6208) { const int c = col - 6144; f32x4 s; for (int i = 0; i < 4; ++i) s[i] = softplusf(v[i] + dt_bias[c + i]); *(f32x4*)(DT + (size_t)row * 64 + c) = s; }
    }
};
struct EpiMLP {
    bf16_t* U;
    __device__ __forceinline__ float rowscale(int) const { return 1.f; }
    __device__ __forceinline__ void operator()(int row, int col, f32x4 v, float) const {
        f32x4 s;
        if (col < 4096) { for (int i = 0; i < 4; ++i) s[i] = geluf(v[i]); } else { for (int i = 0; i < 4; ++i) s[i] = siluf(v[i]); }
        *(u32x2*)(U + (size_t)row * 6144 + col) = pack4(s);
    }
};
struct EpiS5 {
    bf16_t* Uu; bf16_t* Uz;
    __device__ __forceinline__ float rowscale(int) const { return 1.f; }
    __device__ __forceinline__ void operator()(int row, int col, f32x4 v, float) const {
        if (col < 2048) *(u32x2*)(Uu + (size_t)row * 2048 + col) = pack4(v);
        else { f32x4 s; for (int i = 0; i < 4; ++i) s[i] = siluf(v[i]); *(u32x2*)(Uz + (size_t)row * 2048 + (col - 2048)) = pack4(s); }
    }
};
struct EpiNAT {
    bf16_t* Q; bf16_t* Z; bf16_t* Kl; bf16_t* Vl; float* ck; float* cv;
    __device__ __forceinline__ float rowscale(int) const { return 1.f; }
    __device__ __forceinline__ void operator()(int row, int col, f32x4 v, float) const {
        if (col < 2048) { *(u32x2*)(Q + (size_t)row * 2048 + col) = pack4(v * 0.125f); }
        else if (col < 6144) {
            const bool isv = col >= 4096; const int c = col - (isv ? 4096 : 2048);
            if (row < TOKC) { const int b = row >> 8, s = row & 255, h = c >> 6, d = c & 63; float* dst = (isv ? cv : ck) + ((size_t)((b * 32 + h) * 256 + s)) * 64 + d; *(f32x4*)dst = v; }
            else { bf16_t* dst = (isv ? Vl : Kl) + (size_t)(row - TOKC) * 2048 + c; *(u32x2*)dst = pack4(v); }
        } else { f32x4 s; for (int i = 0; i < 4; ++i) s[i] = siluf(v[i]); *(u32x2*)(Z + (size_t)row * 2048 + (col - 6144)) = pack4(s); }
    }
};
struct EpiOut {
    const float* xp; const float* xs; float* X; const float* modl; const float* ssq; int first;
    __device__ __forceinline__ float rowscale(int row) const {
        if (!ssq) return 1.f;
        const f32x4* p = (const f32x4*)(ssq + (size_t)row * 32); float s = 0.f;
#pragma unroll
        for (int i = 0; i < 8; ++i) { f32x4 v = p[i]; s += (v[0] + v[1]) + (v[2] + v[3]); }
        return rsqrtf(s * (1.f / 2048.f) + EPSN);
    }
    __device__ __forceinline__ void operator()(int row, int col, f32x4 v, float rs) const {
        const f32x4 g = *(const f32x4*)(modl + cond_idx(row) * 3072 + 2048 + col);
        const float* xin = first ? (row < TOKC ? xp + (size_t)row * 1024 : xs + (size_t)(row - TOKC) * 1024) : X + (size_t)row * 1024;
        const f32x4 x = *(const f32x4*)(xin + col);
        *(f32x4*)(X + (size_t)row * 1024 + col) = x + g * (v * rs);
    }
};
struct EpiGLU {
    const bf16_t* Yb; bf16_t* Uz; const float* bglu;
    __device__ __forceinline__ float rowscale(int) const { return 1.f; }
    __device__ __forceinline__ void operator()(int row, int col, f32x4 v, float) const {
        const f32x4 y = unpack4(*(const u32x2*)(Yb + (size_t)row * 2048 + col));
        const f32x4 z = unpack4(*(const u32x2*)(Uz + (size_t)row * 2048 + col));
        const f32x4 b = *(const f32x4*)(bglu + col);
        f32x4 o; for (int i = 0; i < 4; ++i) o[i] = y[i] * sigmf(v[i] + b[i]) * z[i];
        *(u32x2*)(Uz + (size_t)row * 2048 + col) = pack4(o);
    }
};

__device__ __forceinline__ void prep_phase(const Params& p, char* smem) {
    const int tid = threadIdx.x, lane = tid & 63, wid = tid >> 6;
    float* tile = (float*)smem;
    for (int T = blockIdx.x; T < p.total_tiles; T += gridDim.x) {
        int j = 0;
#pragma unroll
        for (int q = 1; q < 9; ++q) if (T >= p.jobs[q].tile0) j = q;
        const float* src = p.jobs[j].src; bf16_t* dst = p.jobs[j].dst; const int K = p.jobs[j].K, N = p.jobs[j].N;
        const int local = T - p.jobs[j].tile0, nkt = K >> 6, kt = local % nkt, nt = local / nkt, k0 = kt * 64, n0 = nt * 64;
        __syncthreads();
        if (n0 < N) {
#pragma unroll
            for (int q = tid; q < 1024; q += NT) { const int r = q >> 4, c4 = q & 15; const f32x4 v = *(const f32x4*)(src + (size_t)(k0 + r) * N + n0 + c4 * 4);
                tile[r * 65 + c4 * 4 + 0] = v[0]; tile[r * 65 + c4 * 4 + 1] = v[1]; tile[r * 65 + c4 * 4 + 2] = v[2]; tile[r * 65 + c4 * 4 + 3] = v[3]; }
        }
        __syncthreads();
        {
            const int nn = tid >> 3, kc = tid & 7; float f[8];
#pragma unroll
            for (int i = 0; i < 8; ++i) f[i] = (n0 < N) ? tile[(kc * 8 + i) * 65 + nn] : 0.f;
            *(u32x4*)(dst + (size_t)(n0 + nn) * K + k0 + kc * 8) = pack8(f);
        }
    }
    __syncthreads();
    float* sc = (float*)smem;
    float* part = (float*)smem + 3072;
    for (int q = tid; q < 3072; q += NT) { const int ci = q >> 10, k = q & 1023; const float cv = ci == 0 ? p.in[7][k] : p.in[6][(ci - 1) * 1024 + k]; sc[q] = siluf(cv); }
    __syncthreads();
    float* MOD = (float*)(p.ws + WS_MOD);
    for (int it = blockIdx.x; it < 192; it += gridDim.x) {
        const int layer = it / 48, cg0 = (it % 48) * 64, col = cg0 + lane;
        const float* w = p.in[9] + (size_t)layer * 1024 * 3072 + col;
        float a0 = 0.f, a1 = 0.f, a2 = 0.f;
        for (int k = wid * 128; k < wid * 128 + 128; ++k) { const float wv = w[(size_t)k * 3072]; a0 += sc[k] * wv; a1 += sc[1024 + k] * wv; a2 += sc[2048 + k] * wv; }
        part[(wid * 3 + 0) * 64 + lane] = a0; part[(wid * 3 + 1) * 64 + lane] = a1; part[(wid * 3 + 2) * 64 + lane] = a2;
        __syncthreads();
        if (tid < 192) { const int ci = tid >> 6, l = tid & 63; float s = p.in[10][layer * 3072 + cg0 + l];
#pragma unroll
            for (int w8 = 0; w8 < 8; ++w8) s += part[(w8 * 3 + ci) * 64 + l];
            MOD[(layer * 3 + ci) * 3072 + cg0 + l] = s; }
        __syncthreads();
    }
}

__device__ __forceinline__ void norm_phase(const Params& p, int layer) {
    const int lane = threadIdx.x & 63, gw = blockIdx.x * 8 + (threadIdx.x >> 6), nw = gridDim.x * 8;
    const float* g = p.in[8] + layer * 1024;
    const float* MOD = (const float*)(p.ws + WS_MOD) + layer * 3 * 3072;
    bf16_t* H = (bf16_t*)(p.ws + WS_H);
    for (int t = gw; t < TOK; t += nw) {
        const float* xr = layer == 0 ? (t < TOKC ? p.in[0] + (size_t)t * 1024 : p.in[1] + (size_t)(t - TOKC) * 1024) : p.out + (size_t)t * 1024;
        f32x4 v[4]; float ss = 0.f;
#pragma unroll
        for (int j = 0; j < 4; ++j) { v[j] = *(const f32x4*)(xr + j * 256 + lane * 4); ss += v[j][0] * v[j][0] + v[j][1] * v[j][1] + v[j][2] * v[j][2] + v[j][3] * v[j][3]; }
        ss = wave_sum(ss);
        const float rstd = rsqrtf(ss * (1.f / 1024.f) + EPSN);
        const float* md = MOD + cond_idx(t) * 3072;
#pragma unroll
        for (int j = 0; j < 4; ++j) {
            const int c = j * 256 + lane * 4;
            const f32x4 gg = *(const f32x4*)(g + c), sh = *(const f32x4*)(md + c), scl = *(const f32x4*)(md + 1024 + c);
            f32x4 h; for (int i = 0; i < 4; ++i) h[i] = v[j][i] * rstd * gg[i] * (1.f + scl[i]) + sh[i];
            *(u32x2*)(H + (size_t)t * 1024 + c) = pack4(h);
        }
    }
}
__device__ __forceinline__ void final_phase(const Params& p) {
    const int lane = threadIdx.x & 63, gw = blockIdx.x * 8 + (threadIdx.x >> 6), nw = gridDim.x * 8;
    const float* g = p.in[12];
    for (int t = gw; t < TOK; t += nw) {
        float* xr = p.out + (size_t)t * 1024;
        f32x4 v[4]; float ss = 0.f;
#pragma unroll
        for (int j = 0; j < 4; ++j) { v[j] = *(const f32x4*)(xr + j * 256 + lane * 4); ss += v[j][0] * v[j][0] + v[j][1] * v[j][1] + v[j][2] * v[j][2] + v[j][3] * v[j][3]; }
        ss = wave_sum(ss);
        const float rstd = rsqrtf(ss * (1.f / 1024.f) + EPSN);
#pragma unroll
        for (int j = 0; j < 4; ++j) { const int c = j * 256 + lane * 4; const f32x4 gg = *(const f32x4*)(g + c); *(f32x4*)(xr + c) = v[j] * rstd * gg; }
    }
}


__device__ __forceinline__ void ssd_conv_phase(const Params& p, const bf16_t* Uxbc, bf16_t* XBC) {
    const int tid = threadIdx.x, lane = tid & 63, wid = tid >> 6;
    const float* DT = (const float*)(p.ws + WS_DT);
    float* ACUM = (float*)(p.ws + WS_ACUM);
    for (int ch = blockIdx.x * 8 + wid; ch < NCHUNK; ch += gridDim.x * 8) {
        const int t0 = ch * 128, d = lane >> 5;
        const float a = -__expf(p.in[17][lane]);
        float acc = 0.f;
        for (int i = 0; i < 128; ++i) { const int l = d ? 127 - i : i; acc += DT[(size_t)(t0 + l) * 64 + lane] * a; ACUM[(size_t)(t0 + l) * 64 + lane] = acc; }
    }
    const int chn = tid * 8;
    float w[5][8], bias[8];
#pragma unroll
    for (int j = 0; j < 5; ++j) { const f32x4 a = *(const f32x4*)(p.in[14] + j * 4096 + chn), b = *(const f32x4*)(p.in[14] + j * 4096 + chn + 4);
        w[j][0] = a[0]; w[j][1] = a[1]; w[j][2] = a[2]; w[j][3] = a[3]; w[j][4] = b[0]; w[j][5] = b[1]; w[j][6] = b[2]; w[j][7] = b[3]; }
    { const f32x4 a = *(const f32x4*)(p.in[15] + chn), b = *(const f32x4*)(p.in[15] + chn + 4);
      bias[0] = a[0]; bias[1] = a[1]; bias[2] = a[2]; bias[3] = a[3]; bias[4] = b[0]; bias[5] = b[1]; bias[6] = b[2]; bias[7] = b[3]; }
    const int rpb = (TOK + gridDim.x - 1) / gridDim.x;
    const int r0 = blockIdx.x * rpb, r1 = min(TOK, r0 + rpb);
    for (int t = r0; t < r1; ++t) {
        int s0, s1;
        if (t < TOKC) { s0 = t & ~255; s1 = s0 + 256; } else { s0 = TOKC + ((t - TOKC) & ~2047); s1 = s0 + 2048; }
        float acc[8];
#pragma unroll
        for (int i = 0; i < 8; ++i) acc[i] = bias[i];
#pragma unroll
        for (int j = 0; j < 5; ++j) {
            const int tt = t + j - 2;
            if (tt >= s0 && tt < s1) {
                float f[8]; unpack8(*(const u32x4*)(Uxbc + (size_t)tt * 4096 + chn), f);
#pragma unroll
                for (int i = 0; i < 8; ++i) acc[i] += w[j][i] * f[i];
            }
        }
#pragma unroll
        for (int i = 0; i < 8; ++i) acc[i] = siluf(acc[i]);
        *(u32x4*)(XBC + (size_t)t * 4096 + chn) = pack8(acc);
    }
}

__device__ __forceinline__ void ssd_state_phase(const Params& p, const bf16_t* XBC, bf16_t* SB, char* smem) {
    const int tid = threadIdx.x, lane = tid & 63, wid = tid >> 6;
    const float* DT = (const float*)(p.ws + WS_DT);
    const float* ACUM = (const float*)(p.ws + WS_ACUM);
    bf16_t* Bt = (bf16_t*)smem;
    bf16_t* Xf = Bt + 128 * 136;
    bf16_t* Xb = Xf + 128 * 72;
    for (int item = blockIdx.x; item < NCHUNK * 8; item += gridDim.x) {
        const int ch = item >> 3, g = item & 7, t0 = ch * 128;
        __syncthreads();
#pragma unroll
        for (int j = 0; j < 4; ++j) { const int q = tid + NT * j, row = q >> 4, c = q & 15;
            *(u32x4*)(Bt + row * 136 + c * 8) = *(const u32x4*)(XBC + (size_t)(t0 + row) * 4096 + 2048 + g * 128 + c * 8); }
        for (int hh = 0; hh < 4; ++hh) {
            const int h = g * 4 + hh;
            __syncthreads();
            const float af_last = ACUM[(size_t)(t0 + 127) * 64 + h], sb_first = ACUM[(size_t)t0 * 64 + 32 + h];
#pragma unroll
            for (int j = 0; j < 2; ++j) { const int q = tid + NT * j, row = q >> 3, c = q & 7; const size_t tr = (size_t)(t0 + row);
                const float wf = __expf(af_last - ACUM[tr * 64 + h]) * DT[tr * 64 + h];
                const float wb = __expf(sb_first - ACUM[tr * 64 + 32 + h]) * DT[tr * 64 + 32 + h];
                float f[8], o[8]; unpack8(*(const u32x4*)(XBC + tr * 4096 + h * 64 + c * 8), f);
#pragma unroll
                for (int i = 0; i < 8; ++i) o[i] = f[i] * wf;
                *(u32x4*)(Xf + row * 72 + c * 8) = pack8(o);
#pragma unroll
                for (int i = 0; i < 8; ++i) o[i] = f[i] * wb;
                *(u32x4*)(Xb + row * 72 + c * 8) = pack8(o); }
            __syncthreads();
            const int dir = wid >> 2, nq = wid & 3;
            const bf16_t* Xd = dir ? Xb : Xf;
            f32x4 acc[4][2];
#pragma unroll
            for (int a = 0; a < 4; ++a) { acc[a][0] = (f32x4){0.f, 0.f, 0.f, 0.f}; acc[a][1] = (f32x4){0.f, 0.f, 0.f, 0.f}; }
#pragma unroll
            for (int ks = 0; ks < 4; ++ks) {
                bf16x8 xa[4], bb[2];
#pragma unroll
                for (int a = 0; a < 4; ++a) xa[a] = frag_tr(Xd, 72, ks * 32, a * 16, lane);
#pragma unroll
                for (int b = 0; b < 2; ++b) bb[b] = frag_tr(Bt, 136, ks * 32, nq * 32 + b * 16, lane);
#pragma unroll
                for (int a = 0; a < 4; ++a)
#pragma unroll
                    for (int b = 0; b < 2; ++b) acc[a][b] = mfma16(bb[b], xa[a], acc[a][b]);
            }
            bf16_t* dst = SB + ((size_t)((ch * 2 + dir) * 32 + h)) * 8192;
#pragma unroll
            for (int a = 0; a < 4; ++a)
#pragma unroll
                for (int b = 0; b < 2; ++b) { const int pp = a * 16 + (lane & 15), n = nq * 32 + b * 16 + (lane >> 4) * 4;
                    *(u32x2*)(dst + pp * 128 + n) = pack4(acc[a][b]); }
        }
    }
}

__device__ __forceinline__ void ssd_scan_phase(const Params& p, bf16_t* SB) {
    const int tid = threadIdx.x;
    const float* ACUM = (const float*)(p.ws + WS_ACUM);
    for (int item = blockIdx.x; item < 34 * 64; item += gridDim.x) {
        const int seq = item >> 6, d = (item >> 5) & 1, h = item & 31;
        const int nc = seq < 32 ? 2 : 16, ch0 = seq < 32 ? seq * 2 : 64 + (seq - 32) * 16;
#pragma unroll
        for (int j = 0; j < 2; ++j) {
            const int e = (tid + NT * j) * 8;
            float st[8];
            if (seq >= 32) { const float* h0 = p.in[2] + ((size_t)(((seq - 32) * 2 + d) * 32 + h)) * 8192 + e; const f32x4 a = *(const f32x4*)h0, b = *(const f32x4*)(h0 + 4);
                st[0] = a[0]; st[1] = a[1]; st[2] = a[2]; st[3] = a[3]; st[4] = b[0]; st[5] = b[1]; st[6] = b[2]; st[7] = b[3]; }
            else {
#pragma unroll
                for (int i = 0; i < 8; ++i) st[i] = 0.f; }
            for (int ci = 0; ci < nc; ++ci) {
                const int c = d ? nc - 1 - ci : ci, ch = ch0 + c, t0 = ch * 128;
                const float tot = d ? ACUM[(size_t)t0 * 64 + 32 + h] : ACUM[(size_t)(t0 + 127) * 64 + h];
                bf16_t* ptr = SB + ((size_t)((ch * 2 + d) * 32 + h)) * 8192 + e;
                float s[8]; unpack8(*(const u32x4*)ptr, s);
                *(u32x4*)ptr = pack8(st);
                const float dec = __expf(tot);
#pragma unroll
                for (int i = 0; i < 8; ++i) st[i] = dec * st[i] + s[i];
            }
            if (seq < 32) { float* o = p.out + OUT_SSD + ((size_t)((seq * 2 + d) * 32 + h)) * 8192 + e;
                *(f32x4*)o = (f32x4){st[0], st[1], st[2], st[3]}; *(f32x4*)(o + 4) = (f32x4){st[4], st[5], st[6], st[7]}; }
        }
    }
}

__device__ __forceinline__ void ssd_out_phase(const Params& p, const bf16_t* XBC, const bf16_t* SB, bf16_t* Uz, char* smem) {
    const int tid = threadIdx.x, lane = tid & 63, wid = tid >> 6;
    const float* DT = (const float*)(p.ws + WS_DT);
    const float* ACUM = (const float*)(p.ws + WS_ACUM);
    float* SSQ = (float*)(p.ws + WS_SSQ);
    bf16_t* Ct = (bf16_t*)smem;
    bf16_t* R1 = Ct + 128 * 136;
    bf16_t* Mt = R1 + 128 * 136;
    bf16_t* Xt = Mt + 128 * 136;
    float* vec = (float*)(Xt + 128 * 72);
    for (int item = blockIdx.x; item < NCHUNK * 8; item += gridDim.x) {
        const int ch = item >> 3, g = item & 7, t0 = ch * 128;
        __syncthreads();
#pragma unroll
        for (int j = 0; j < 4; ++j) { const int q = tid + NT * j, row = q >> 4, c = q & 15; const bf16_t* src = XBC + (size_t)(t0 + row) * 4096 + g * 128 + c * 8;
            *(u32x4*)(R1 + row * 136 + c * 8) = *(const u32x4*)(src + 2048);
            *(u32x4*)(Ct + row * 136 + c * 8) = *(const u32x4*)(src + 3072); }
#pragma unroll
        for (int j = 0; j < 4; ++j) { const int idx = tid + NT * j, kind = idx >> 9, hh = (idx >> 7) & 3, l = idx & 127; const int h = g * 4 + hh;
            const float* srcp = (kind < 2 ? ACUM : DT) + (size_t)(t0 + l) * 64 + (kind & 1) * 32 + h;
            vec[idx] = *srcp; }
        __syncthreads();
        f32x4 gacc[8];
#pragma unroll
        for (int st = 0; st < 8; ++st) gacc[st] = (f32x4){0.f, 0.f, 0.f, 0.f};
#pragma unroll
        for (int ks = 0; ks < 4; ++ks) {
            const bf16x8 cf = frag_rm(Ct, 136, 16 * wid, ks * 32, lane);
#pragma unroll
            for (int st = 0; st < 8; ++st) gacc[st] = mfma16(frag_rm(R1, 136, st * 16, ks * 32, lane), cf, gacc[st]);
        }
        const int l = 16 * wid + (lane & 15);
        for (int hh = 0; hh < 4; ++hh) {
            const int h = g * 4 + hh;
            const float* Af = vec + hh * 128; const float* Sb = vec + 512 + hh * 128; const float* dtf = vec + 1024 + hh * 128; const float* dtb = vec + 1536 + hh * 128;
            __syncthreads();
#pragma unroll
            for (int j = 0; j < 2; ++j) { const int q = tid + NT * j, row = q >> 3, c = q & 7;
                *(u32x4*)(Xt + row * 72 + c * 8) = *(const u32x4*)(XBC + (size_t)(t0 + row) * 4096 + h * 64 + c * 8); }
#pragma unroll
            for (int j = 0; j < 4; ++j) { const int q = tid + NT * j, dd = q >> 10, row = (q >> 4) & 63, c = q & 15;
                *(u32x4*)(R1 + (dd * 64 + row) * 136 + c * 8) = *(const u32x4*)(SB + ((size_t)((ch * 2 + dd) * 32 + h)) * 8192 + row * 128 + c * 8); }
            {
                const float afl = Af[l], sbl = Sb[l];
#pragma unroll
                for (int st = 0; st < 8; ++st) {
                    f32x4 m;
#pragma unroll
                    for (int r = 0; r < 4; ++r) { const int s = st * 16 + (lane >> 4) * 4 + r;
                        float wgt = 0.f;
                        if (s <= l) wgt += __expf(afl - Af[s]) * dtf[s];
                        if (s >= l) wgt += __expf(sbl - Sb[s]) * dtb[s];
                        m[r] = gacc[st][r] * wgt; }
                    *(u32x2*)(Mt + l * 136 + st * 16 + (lane >> 4) * 4) = pack4(m);
                }
            }
            __syncthreads();
            f32x4 ad[4], af[4], ab[4];
#pragma unroll
            for (int a = 0; a < 4; ++a) { ad[a] = (f32x4){0.f, 0.f, 0.f, 0.f}; af[a] = ad[a]; ab[a] = ad[a]; }
#pragma unroll
            for (int ks = 0; ks < 4; ++ks) {
                const bf16x8 mf = frag_rm(Mt, 136, 16 * wid, ks * 32, lane);
                const bf16x8 cf = frag_rm(Ct, 136, 16 * wid, ks * 32, lane);
#pragma unroll
                for (int a = 0; a < 4; ++a) {
                    ad[a] = mfma16(frag_tr(Xt, 72, ks * 32, a * 16, lane), mf, ad[a]);
                    af[a] = mfma16(frag_rm(R1, 136, a * 16, ks * 32, lane), cf, af[a]);
                    ab[a] = mfma16(frag_rm(R1 + 64 * 136, 136, a * 16, ks * 32, lane), cf, ab[a]);
                }
            }
            const float ef = __expf(Af[l]), eb = __expf(Sb[l]), Dh = p.in[18][h];
            const size_t t = (size_t)(t0 + l);
            float ssq = 0.f;
#pragma unroll
            for (int a = 0; a < 4; ++a) {
                const int pp = a * 16 + (lane >> 4) * 4, col = h * 64 + pp;
                const f32x4 x = unpack4(*(const u32x2*)(Xt + l * 72 + pp));
                const f32x4 sz = unpack4(*(const u32x2*)(Uz + t * 2048 + col));
                const f32x4 ng = *(const f32x4*)(p.in[19] + col);
                f32x4 y = (ad[a] + af[a] * ef + ab[a] * eb + x * Dh) * sz;
                ssq += y[0] * y[0] + y[1] * y[1] + y[2] * y[2] + y[3] * y[3];
                *(u32x2*)(Uz + t * 2048 + col) = pack4(y * ng);
            }
            ssq += __shfl_xor(ssq, 16); ssq += __shfl_xor(ssq, 32);
            if (lane < 16) SSQ[t * 32 + h] = ssq;
        }
    }
}


__device__ __forceinline__ void mlp_stats_phase(const Params& p, const bf16_t* U) {
    const int lane = threadIdx.x & 63, gw = blockIdx.x * 8 + (threadIdx.x >> 6), nw = gridDim.x * 8;
    float* STATS = (float*)(p.ws + WS_STATS);
    for (int t = gw; t < TOK; t += nw) {
        float f[32]; float s = 0.f;
#pragma unroll
        for (int j = 0; j < 4; ++j) { unpack8(*(const u32x4*)(U + (size_t)t * 6144 + 2048 + j * 512 + lane * 8), f + j * 8); }
#pragma unroll
        for (int i = 0; i < 32; ++i) s += f[i];
        s = wave_sum(s);
        const float mean = s * (1.f / 2048.f);
        float q = 0.f;
#pragma unroll
        for (int i = 0; i < 32; ++i) { const float d = f[i] - mean; q += d * d; }
        q = wave_sum(q);
        if (lane == 0) { STATS[(size_t)t * 2] = mean; STATS[(size_t)t * 2 + 1] = rsqrtf(q * (1.f / 2048.f) + EPSN); }
    }
}
__device__ __forceinline__ void mlp_mix_phase(const Params& p, bf16_t* U, char* smem) {
    const int tid = threadIdx.x, lane = tid & 63, wid = tid >> 6;
    const float* STATS = (const float*)(p.ws + WS_STATS);
    bf16_t* Wt = (bf16_t*)smem;
    bf16_t* Vt = Wt + 128 * 136;
    for (int item = blockIdx.x; item < NCHUNK * 16; item += gridDim.x) {
        const int ch = item >> 4, ct = item & 15, g = ct >> 1, c0 = ct * 128, t0 = ch * 128;
        __syncthreads();
#pragma unroll
        for (int jj = 0; jj < 8; ++jj) { const int q = tid + NT * jj, i = q >> 5, j4 = q & 31;
            const f32x4 w = *(const f32x4*)(p.in[23] + ((size_t)(g * 128 + i)) * 128 + j4 * 4);
            *(u32x2*)(Wt + i * 136 + j4 * 4) = pack4(w); }
#pragma unroll
        for (int jj = 0; jj < 4; ++jj) { const int q = tid + NT * jj, j = q >> 4, c = q & 15; const size_t t = (size_t)(t0 + j);
            const float mean = STATS[t * 2], rstd = STATS[t * 2 + 1];
            float f[8]; unpack8(*(const u32x4*)(U + t * 6144 + 2048 + c0 + c * 8), f);
            const f32x4 g0 = *(const f32x4*)(p.in[21] + c0 + c * 8), g1 = *(const f32x4*)(p.in[21] + c0 + c * 8 + 4);
            const f32x4 b0 = *(const f32x4*)(p.in[22] + c0 + c * 8), b1 = *(const f32x4*)(p.in[22] + c0 + c * 8 + 4);
#pragma unroll
            for (int i = 0; i < 4; ++i) { f[i] = (f[i] - mean) * rstd * g0[i] + b0[i]; f[4 + i] = (f[4 + i] - mean) * rstd * g1[i] + b1[i]; }
            *(u32x4*)(Vt + j * 136 + c * 8) = pack8(f); }
        __syncthreads();
        f32x4 acc[8];
#pragma unroll
        for (int a = 0; a < 8; ++a) acc[a] = (f32x4){0.f, 0.f, 0.f, 0.f};
#pragma unroll
        for (int ks = 0; ks < 4; ++ks) {
            const bf16x8 wf = frag_rm(Wt, 136, 16 * wid, ks * 32, lane);
#pragma unroll
            for (int a = 0; a < 8; ++a) acc[a] = mfma16(frag_tr(Vt, 136, ks * 32, a * 16, lane), wf, acc[a]);
        }
        const int i = 16 * wid + (lane & 15); const size_t t = (size_t)(t0 + i);
        const float bs = p.in[24][g * 128 + i];
#pragma unroll
        for (int a = 0; a < 8; ++a) {
            const int col = c0 + a * 16 + (lane >> 4) * 4;
            const f32x4 gu = unpack4(*(const u32x2*)(U + t * 6144 + col));
            const f32x4 sz = unpack4(*(const u32x2*)(U + t * 6144 + 4096 + col));
            *(u32x2*)(U + t * 6144 + col) = pack4(gu * (acc[a] + bs) * sz);
        }
    }
}

__device__ __forceinline__ void s5_scan_phase(const Params& p, const bf16_t* Uu, bf16_t* Ydir, char* smem) {
    const int tid = threadIdx.x, lane = tid & 63, wid = tid >> 6;
    float* drv = (float*)(smem + wid * 12800);
    bf16_t* Sbuf = (bf16_t*)(smem + wid * 12800 + 8448);
    const int nwaves = gridDim.x * 8;
    for (int wi = blockIdx.x * 8 + wid; wi < 2048; wi += nwaves) {
        const int combo = wi >> 3, slot = wi & 7, d = combo >> 7, g = combo & 127;
        const int dg = d * 128 + g;
        const float step = __expf(p.in[28][dg]);
        float ar, ai;
        {
            const float lr = p.in[26][dg * 64 + lane], li = p.in[27][dg * 64 + lane];
            const float mag = __expf(lr * step), ang = li * step;
            const float kk = rintf(ang * 0.15915494309189535f);
            float rr = fmaf(-kk, 6.2831854820251465f, ang); rr = fmaf(-kk, -1.7484555e-7f, rr);
            ar = mag * __cosf(rr); ai = mag * __sinf(rr);
        }
        bf16x8 bfr[8];
#pragma unroll
        for (int tq = 0; tq < 4; ++tq) {
            const int n = tq * 16 + (lane & 15);
            const float lr = p.in[26][dg * 64 + n], li = p.in[27][dg * 64 + n];
            const float mag = __expf(lr * step), ang = li * step;
            const float kk = rintf(ang * 0.15915494309189535f);
            float rr = fmaf(-kk, 6.2831854820251465f, ang); rr = fmaf(-kk, -1.7484555e-7f, rr);
            const float abr = mag * __cosf(rr), abi = mag * __sinf(rr);
            const float den = lr * lr + li * li, nr = abr - 1.f;
            const float cr = (nr * lr + abi * li) / den, ci = (abi * lr - nr * li) / den;
            float fr[8], fi[8];
            if ((lane >> 4) < 2) {
                const float* pr = p.in[29] + ((size_t)(dg * 64 + n)) * 16 + 8 * (lane >> 4);
                const float* pi = p.in[30] + ((size_t)(dg * 64 + n)) * 16 + 8 * (lane >> 4);
#pragma unroll
                for (int j = 0; j < 8; ++j) { const float br = pr[j], bi = pi[j]; fr[j] = cr * br - ci * bi; fi[j] = cr * bi + ci * br; }
            } else {
#pragma unroll
                for (int j = 0; j < 8; ++j) { fr[j] = 0.f; fi[j] = 0.f; }
            }
            bfr[tq] = as_frag(pack8(fr)); bfr[4 + tq] = as_frag(pack8(fi));
        }
        bf16x8 cfr[4];
#pragma unroll
        for (int ks = 0; ks < 4; ++ks) {
            const float* pc = (ks < 2 ? p.in[31] : p.in[32]) + ((size_t)(dg * 16 + (lane & 15))) * 64 + (ks & 1) * 32 + 8 * (lane >> 4);
            float f[8];
#pragma unroll
            for (int j = 0; j < 8; ++j) f[j] = ks < 2 ? pc[j] : -pc[j];
            cfr[ks] = as_frag(pack8(f));
        }
        const int nseq = slot < 2 ? 1 : (32 - (slot - 2) + 5) / 6;
        for (int si = 0; si < nseq; ++si) {
            const int seq = slot < 2 ? 32 + slot : (slot - 2) + 6 * si;
            const int L = seq < 32 ? 256 : 2048, tb = seq < 32 ? seq * 256 : TOKC + (seq - 32) * 2048, nchunks = L >> 4;
            float sr = 0.f, sim = 0.f;
            if (seq >= 32) { const float* h0 = p.in[3] + ((size_t)(((seq - 32) * 2 + d) * 2) * 128 + g) * 64 + lane; sr = h0[0]; sim = h0[128 * 64]; }
            u32x4 ucur = (u32x4){0u, 0u, 0u, 0u};
            { const int c = d ? nchunks - 1 : 0; if ((lane >> 4) < 2) ucur = *(const u32x4*)(Uu + (size_t)(tb + c * 16 + (lane & 15)) * 2048 + g * 16 + 8 * (lane >> 4)); }
            for (int ci = 0; ci < nchunks; ++ci) {
                const int c = d ? nchunks - 1 - ci : ci, tok0 = tb + c * 16;
                u32x4 unext = (u32x4){0u, 0u, 0u, 0u};
                if (ci + 1 < nchunks && (lane >> 4) < 2) { const int c2 = d ? c - 1 : c + 1; unext = *(const u32x4*)(Uu + (size_t)(tb + c2 * 16 + (lane & 15)) * 2048 + g * 16 + 8 * (lane >> 4)); }
                const bf16x8 uf = as_frag(ucur);
#pragma unroll
                for (int tl = 0; tl < 8; ++tl) {
                    const f32x4 dv = mfma16(bfr[tl], uf, (f32x4){0.f, 0.f, 0.f, 0.f});
                    *(f32x4*)(drv + (lane & 15) * 132 + tl * 16 + (lane >> 4) * 4) = dv;
                }
                WAVE_LDS_SYNC();
                float dre[16], dim[16];
#pragma unroll
                for (int i = 0; i < 16; ++i) { const int tt = d ? 15 - i : i; dre[i] = drv[tt * 132 + lane]; dim[i] = drv[tt * 132 + 64 + lane]; }
#pragma unroll
                for (int i = 0; i < 16; ++i) { const int tt = d ? 15 - i : i;
                    const float nr2 = ar * sr - ai * sim + dre[i], ni2 = ar * sim + ai * sr + dim[i];
                    sr = nr2; sim = ni2;
                    Sbuf[tt * 136 + lane] = (bf16_t)f2bf(sr); Sbuf[tt * 136 + 64 + lane] = (bf16_t)f2bf(sim); }
                WAVE_LDS_SYNC();
                f32x4 ya = (f32x4){0.f, 0.f, 0.f, 0.f};
#pragma unroll
                for (int ks = 0; ks < 4; ++ks) ya = mfma16(cfr[ks], frag_rm(Sbuf, 136, 0, ks * 32, lane), ya);
                *(u32x2*)(Ydir + ((size_t)d * TOK + tok0 + (lane & 15)) * 2048 + g * 16 + (lane >> 4) * 4) = pack4(ya);
                WAVE_LDS_SYNC();
                ucur = unext;
            }
            if (seq < 32) { float* o = p.out + OUT_S5 + ((size_t)((seq * 2 + d) * 2) * 128 + g) * 64 + lane; o[0] = sr; o[128 * 64] = sim; }
        }
    }
}
__device__ __forceinline__ void s5_post_phase(const Params& p, const bf16_t* Uu, bf16_t* Ydir) {
    const size_t nvec = (size_t)TOK * 2048 / 8;
    for (size_t v = (size_t)blockIdx.x * NT + threadIdx.x; v < nvec; v += (size_t)gridDim.x * NT) {
        const int col = (int)((v * 8) & 2047);
        float a[8], b[8], u[8];
        unpack8(*(const u32x4*)(Ydir + v * 8), a); unpack8(*(const u32x4*)(Ydir + (size_t)TOK * 2048 + v * 8), b); unpack8(*(const u32x4*)(Uu + v * 8), u);
        const f32x4 d0 = *(const f32x4*)(p.in[33] + col), d1 = *(const f32x4*)(p.in[33] + col + 4);
#pragma unroll
        for (int i = 0; i < 4; ++i) { a[i] = geluf(a[i] + b[i] + d0[i] * u[i]); a[4 + i] = geluf(a[4 + i] + b[4 + i] + d1[i] * u[4 + i]); }
        *(u32x4*)(Ydir + v * 8) = pack8(a);
    }
}

struct AttnState { float m, l; f32x4 o[4]; };
template <bool WIN, int KSTRIDE>
__device__ __forceinline__ void attend128(AttnState& st, const bf16x8 (&qf)[2], const bf16_t* Kt, const bf16_t* Vt, int krow0,
                                          bf16_t* Pbuf, int lane, const float* rpbh, int qc, int kcol0, int idxr0) {
    f32x4 s[8];
    {
        const int row = krow0 + (lane & 15), ksw = (row >> 1) & 7;
        const bf16_t* k0p = Kt + row * 64 + ((((lane >> 4)) ^ ksw) << 3);
        const bf16_t* k1p = Kt + row * 64 + (((4 + (lane >> 4)) ^ ksw) << 3);
#pragma unroll
        for (int kt = 0; kt < 8; ++kt) {
            const int ro = ((kt >> 1) * KSTRIDE + (kt & 1) * 16) * 64;
            s[kt] = mfma16(*(const bf16x8*)(k0p + ro), qf[0], (f32x4){0.f, 0.f, 0.f, 0.f});
            s[kt] = mfma16(*(const bf16x8*)(k1p + ro), qf[1], s[kt]);
        }
    }
    if (WIN) {
        const int cs = min(max(qc - 8, 0), 48);
#pragma unroll
        for (int kt = 0; kt < 8; ++kt) {
            const int ir = idxr0 + (kt >> 1);
#pragma unroll
            for (int r = 0; r < 4; ++r) { const int kc = kcol0 + (kt & 1) * 16 + (lane >> 4) * 4 + r;
                const bool ok = (kc >= cs) && (kc < cs + 16);
                const int ic = min(max(kc - qc + 15, 0), 30);
                s[kt][r] = ok ? s[kt][r] + rpbh[ir * 31 + ic] : -1e30f; }
        }
    }
    float mx = st.m;
#pragma unroll
    for (int kt = 0; kt < 8; ++kt) mx = fmaxf(mx, fmaxf(fmaxf(s[kt][0], s[kt][1]), fmaxf(s[kt][2], s[kt][3])));
    mx = fmaxf(mx, __shfl_xor(mx, 16)); mx = fmaxf(mx, __shfl_xor(mx, 32));
    const float alpha = __expf(st.m - mx);
    st.m = mx; st.l *= alpha;
#pragma unroll
    for (int a = 0; a < 4; ++a) st.o[a] = st.o[a] * alpha;
    const int vrow = krow0 + 8 * (lane >> 4) + ((lane >> 2) & 3);
    const int vs0 = (vrow >> 1) & 7, vs1 = ((vrow + 4) >> 1) & 7, c1 = (lane & 3) >> 1, cin = 4 * (lane & 1);
    const bf16_t* vb0 = Vt + vrow * 64 + cin;
    const bf16_t* vb1 = Vt + (vrow + 4) * 64 + cin;
    bf16_t* pw = Pbuf + (lane & 15) * 40 + (lane >> 4) * 4;
    const bf16_t* pr = Pbuf + (lane & 15) * 40 + 8 * (lane >> 4);
#pragma unroll
    for (int kk = 0; kk < 4; ++kk) {
        float ps = 0.f;
#pragma unroll
        for (int e = 0; e < 2; ++e) { f32x4 pv;
#pragma unroll
            for (int r = 0; r < 4; ++r) { pv[r] = __expf(s[2 * kk + e][r] - mx); ps += pv[r]; }
            *(u32x2*)(pw + e * 16) = pack4(pv); }
        st.l += ps;
        WAVE_LDS_SYNC();
        const bf16x8 pf = *(const bf16x8*)pr;
#pragma unroll
        for (int a = 0; a < 4; ++a) {
            const s16x4 lo = __builtin_amdgcn_ds_read_tr16_b64_v4i16((LAS s16x4*)(vb0 + kk * KSTRIDE * 64 + (((2 * a + c1) ^ vs0) << 3)));
            const s16x4 hi = __builtin_amdgcn_ds_read_tr16_b64_v4i16((LAS s16x4*)(vb1 + kk * KSTRIDE * 64 + (((2 * a + c1) ^ vs1) << 3)));
            bf16x8 vf; vf[0] = lo[0]; vf[1] = lo[1]; vf[2] = lo[2]; vf[3] = lo[3]; vf[4] = hi[0]; vf[5] = hi[1]; vf[6] = hi[2]; vf[7] = hi[3];
            st.o[a] = mfma16(vf, pf, st.o[a]);
        }
        WAVE_LDS_SYNC();
    }
}

__device__ __forceinline__ void attn_phase(const Params& p, bf16_t* Q, const bf16_t* Z, const bf16_t* Kl, const bf16_t* Vl, char* smem) {
    const int tid = threadIdx.x, lane = tid & 63, wid = tid >> 6;
    bf16_t* Kt = (bf16_t*)smem;
    bf16_t* Vt = Kt + 512 * 64;
    bf16_t* Pbuf = Vt + 512 * 64 + wid * 640;
    float* rpbs = (float*)(smem + 131072 + 10240);
    float* mrg = (float*)smem;
    const float* ck = p.out + OUT_CK; const float* cv = p.out + OUT_CV;
    for (int item = blockIdx.x; item < 4096; item += gridDim.x) {
        __syncthreads();
        if (item < 2048) {
            const int b = item >> 6, h = (item >> 1) & 31, qh = item & 1;
            const float* ksrc = ck + ((size_t)(b * 32 + h)) * 256 * 64; const float* vsrc = cv + ((size_t)(b * 32 + h)) * 256 * 64;
#pragma unroll
            for (int j = 0; j < 8; ++j) { const int q = tid + NT * j, key = q >> 4, c4 = q & 15;
                *(u32x2*)(Kt + sw64(key, c4 * 4)) = pack4(*(const f32x4*)(ksrc + key * 64 + c4 * 4));
                *(u32x2*)(Vt + sw64(key, c4 * 4)) = pack4(*(const f32x4*)(vsrc + key * 64 + c4 * 4)); }
            const size_t tq = (size_t)(b * 256 + qh * 128 + 16 * wid + (lane & 15));
            bf16x8 qf[2];
            qf[0] = *(const bf16x8*)(Q + tq * 2048 + h * 64 + 8 * (lane >> 4)); qf[1] = *(const bf16x8*)(Q + tq * 2048 + h * 64 + 32 + 8 * (lane >> 4));
            __syncthreads();
            AttnState st; st.m = -1e30f; st.l = 0.f;
#pragma unroll
            for (int a = 0; a < 4; ++a) st.o[a] = (f32x4){0.f, 0.f, 0.f, 0.f};
            attend128<false, 32>(st, qf, Kt, Vt, 0, Pbuf, lane, nullptr, 0, 0, 0);
            attend128<false, 32>(st, qf, Kt, Vt, 128, Pbuf, lane, nullptr, 0, 0, 0);
            float l = st.l; l += __shfl_xor(l, 16); l += __shfl_xor(l, 32);
            const float inv = 1.f / l;
#pragma unroll
            for (int a = 0; a < 4; ++a) { const int col = h * 64 + a * 16 + (lane >> 4) * 4;
                const f32x4 sz = unpack4(*(const u32x2*)(Z + tq * 2048 + col));
                *(u32x2*)(Q + tq * 2048 + col) = pack4(st.o[a] * inv * sz); }
        } else {
            const int it = item - 2048, b = it >> 10, h = (it >> 5) & 31, r = it & 31, rs = min(max(r - 4, 0), 24);
            const bf16_t* ksrc = Kl + ((size_t)(b * 2048 + rs * 64)) * 2048 + h * 64; const bf16_t* vsrc = Vl + ((size_t)(b * 2048 + rs * 64)) * 2048 + h * 64;
#pragma unroll
            for (int j = 0; j < 8; ++j) { const int q = tid + NT * j, key = q >> 3, c = q & 7;
                *(u32x4*)(Kt + sw64(key, c * 8)) = *(const u32x4*)(ksrc + (size_t)key * 2048 + c * 8);
                *(u32x4*)(Vt + sw64(key, c * 8)) = *(const u32x4*)(vsrc + (size_t)key * 2048 + c * 8); }
            if (tid < 465) rpbs[tid] = p.in[37][h * 465 + tid];
            const int qt = wid & 3, hf = wid >> 2;
            const int qc = 16 * qt + (lane & 15);
            const size_t tq = (size_t)(TOKC + b * 2048 + r * 64 + qc);
            bf16x8 qf[2];
            qf[0] = *(const bf16x8*)(Q + tq * 2048 + h * 64 + 8 * (lane >> 4)); qf[1] = *(const bf16x8*)(Q + tq * 2048 + h * 64 + 32 + 8 * (lane >> 4));
            const int off = qt == 0 ? 0 : (qt == 1 ? 8 : (qt == 2 ? 24 : 32));
            __syncthreads();
            AttnState st; st.m = -1e30f; st.l = 0.f;
#pragma unroll
            for (int a = 0; a < 4; ++a) st.o[a] = (f32x4){0.f, 0.f, 0.f, 0.f};
            attend128<true, 64>(st, qf, Kt, Vt, hf * 256 + off, Pbuf, lane, rpbs, qc, off, rs + 4 * hf - r + 7);
            __syncthreads();
            const float* k2 = p.in[4] + ((size_t)(b * 32 + h)) * 256 * 64; const float* v2 = p.in[5] + ((size_t)(b * 32 + h)) * 256 * 64;
#pragma unroll
            for (int j = 0; j < 8; ++j) { const int q = tid + NT * j, key = q >> 4, c4 = q & 15;
                *(u32x2*)(Kt + sw64(key, c4 * 4)) = pack4(*(const f32x4*)(k2 + key * 64 + c4 * 4));
                *(u32x2*)(Vt + sw64(key, c4 * 4)) = pack4(*(const f32x4*)(v2 + key * 64 + c4 * 4)); }
            __syncthreads();
            attend128<false, 32>(st, qf, Kt, Vt, hf * 128, Pbuf, lane, nullptr, 0, 0, 0);
            float l = st.l; l += __shfl_xor(l, 16); l += __shfl_xor(l, 32);
            __syncthreads();
            if (hf == 1) { float* mp = mrg + qt * 18 * 64 + lane; mp[0] = st.m; mp[64] = l;
#pragma unroll
                for (int a = 0; a < 4; ++a)
#pragma unroll
                    for (int i = 0; i < 4; ++i) mp[(2 + a * 4 + i) * 64] = st.o[a][i]; }
            __syncthreads();
            if (hf == 0) { const float* mp = mrg + qt * 18 * 64 + lane; const float m2 = mp[0], l2 = mp[64];
                const float mm = fmaxf(st.m, m2), e1 = __expf(st.m - mm), e2 = __expf(m2 - mm);
                const float inv = 1.f / (l * e1 + l2 * e2);
#pragma unroll
                for (int a = 0; a < 4; ++a) { f32x4 o2;
#pragma unroll
                    for (int i = 0; i < 4; ++i) o2[i] = mp[(2 + a * 4 + i) * 64];
                    const int col = h * 64 + a * 16 + (lane >> 4) * 4;
                    const f32x4 sz = unpack4(*(const u32x2*)(Z + tq * 2048 + col));
                    *(u32x2*)(Q + tq * 2048 + col) = pack4((st.o[a] * e1 + o2 * e2) * inv * sz); }
            }
        }
    }
}

__global__ void __launch_bounds__(NT) fwd_megakernel(Params p) {
    extern __shared__ __attribute__((aligned(16))) char smem[];
    cg::grid_group grid = cg::this_grid();
    char* ws = p.ws;
    bf16_t* H = (bf16_t*)(ws + WS_H);
    float* MOD = (float*)(ws + WS_MOD);
    bf16_t* U = (bf16_t*)(ws + WS_U);
    bf16_t* SCR = (bf16_t*)(p.out + OUT_CK);
    const bf16_t* WtOut = (const bf16_t*)(ws + WS_WT_OUT);
#define GSYNC() grid.sync()
    prep_phase(p, smem);
    GSYNC();
    norm_phase(p, 0);
    GSYNC();
    {
        bf16_t* Uz = U; bf16_t* Uxbc = U + (size_t)TOK * 2048; bf16_t* SB = Uxbc; bf16_t* XBC = SCR;
        { EpiSSD e{Uz, Uxbc, (float*)(ws + WS_DT), p.in[16]}; gemm_phase<4>(H, 1024, (const bf16_t*)(ws + WS_WT_SSD), TOK, 6272, 1024, e, smem); }
        GSYNC();
        ssd_conv_phase(p, Uxbc, XBC);
        GSYNC();
        ssd_state_phase(p, XBC, SB, smem);
        GSYNC();
        ssd_scan_phase(p, SB);
        GSYNC();
        ssd_out_phase(p, XBC, SB, Uz, smem);
        GSYNC();
        { EpiOut e{p.in[0], p.in[1], p.out, MOD + 0 * 3 * 3072, (const float*)(ws + WS_SSQ), 1}; gemm_phase<2>(Uz, 2048, WtOut, TOK, 1024, 2048, e, smem); }
        GSYNC();
    }
    norm_phase(p, 1);
    GSYNC();
    {
        { EpiMLP e{U}; gemm_phase<4>(H, 1024, (const bf16_t*)(ws + WS_WT_MLP), TOK, 6144, 1024, e, smem); }
        GSYNC();
        mlp_stats_phase(p, U);
        GSYNC();
        mlp_mix_phase(p, U, smem);
        GSYNC();
        { EpiOut e{p.in[0], p.in[1], p.out, MOD + 1 * 3 * 3072, nullptr, 0}; gemm_phase<2>(U, 6144, WtOut + (size_t)1 * 1024 * 2048, TOK, 1024, 2048, e, smem); }
        GSYNC();
    }
    norm_phase(p, 2);
    GSYNC();
    {
        bf16_t* Uu = U; bf16_t* Uz = U + (size_t)TOK * 2048; bf16_t* Ydir = SCR;
        { EpiS5 e{Uu, Uz}; gemm_phase<4>(H, 1024, (const bf16_t*)(ws + WS_WT_S5), TOK, 4096, 1024, e, smem); }
        GSYNC();
        s5_scan_phase(p, Uu, Ydir, smem);
        GSYNC();
        s5_post_phase(p, Uu, Ydir);
        GSYNC();
        { EpiGLU e{Ydir, Uz, p.in[35]}; gemm_phase<4>(Ydir, 2048, (const bf16_t*)(ws + WS_WT_GLU), TOK, 2048, 2048, e, smem); }
        GSYNC();
        { EpiOut e{p.in[0], p.in[1], p.out, MOD + 2 * 3 * 3072, nullptr, 0}; gemm_phase<2>(Uz, 2048, WtOut + (size_t)2 * 1024 * 2048, TOK, 1024, 2048, e, smem); }
        GSYNC();
    }
    norm_phase(p, 3);
    GSYNC();
    {
        bf16_t* Q = U; bf16_t* Z = U + (size_t)TOK * 2048; bf16_t* Kl = U + (size_t)TOK * 4096; bf16_t* Vl = Kl + (size_t)4096 * 2048;
        { EpiNAT e{Q, Z, Kl, Vl, p.out + OUT_CK, p.out + OUT_CV}; gemm_phase<4>(H, 1024, (const bf16_t*)(ws + WS_WT_NAT), TOK, 8192, 1024, e, smem); }
        GSYNC();
        attn_phase(p, Q, Z, Kl, Vl, smem);
        GSYNC();
        { EpiOut e{p.in[0], p.in[1], p.out, MOD + 3 * 3 * 3072, nullptr, 0}; gemm_phase<2>(Q, 2048, WtOut + (size_t)3 * 1024 * 2048, TOK, 1024, 2048, e, smem); }
        GSYNC();
    }
    final_phase(p);
}

extern "C" void kernel_launch(void* const* d_in, const int* in_sizes, int n_in, void* d_out, int out_size, void* d_ws, size_t ws_size,
                              hipStream_t stream) {
    static int grid_blocks = 0;
    if (grid_blocks == 0) {
        int dev = 0, cus = 0, per_cu = 0;
        hipGetDevice(&dev);
        hipDeviceGetAttribute(&cus, hipDeviceAttributeMultiprocessorCount, dev);
        if (hipFuncSetAttribute((const void*)fwd_megakernel, hipFuncAttributeMaxDynamicSharedMemorySize, LDS_BYTES) != hipSuccess) { fprintf(stderr, "hipFuncSetAttribute failed\n"); }
        if (hipOccupancyMaxActiveBlocksPerMultiprocessor(&per_cu, (const void*)fwd_megakernel, NT, LDS_BYTES) != hipSuccess || per_cu < 1) { fprintf(stderr, "occupancy query failed (%d)\n", per_cu); per_cu = 1; }
        (void)hipGetLastError();
        grid_blocks = cus;
        if (ws_size < WS_END) { fprintf(stderr, "workspace too small: %zu < %zu\n", ws_size, (size_t)WS_END); grid_blocks = -1; }
        if (n_in != 38) { fprintf(stderr, "expected 38 inputs, got %d\n", n_in); grid_blocks = -1; }
    }
    if (grid_blocks < 0) return;
    Params p;
    memset(&p, 0, sizeof(p));
    for (int i = 0; i < 38; ++i) p.in[i] = (const float*)d_in[i];
    p.out = (float*)d_out; p.ws = (char*)d_ws;
    char* ws = (char*)d_ws;
    int t0 = 0;
    auto job = [&](int i, const float* src, size_t off, int K, int N, int Npad) {
        p.jobs[i].src = src; p.jobs[i].dst = (bf16_t*)(ws + off); p.jobs[i].K = K; p.jobs[i].N = N; p.jobs[i].Npad = Npad; p.jobs[i].tile0 = t0; t0 += (K / 64) * (Npad / 64);
    };
    job(0, p.in[13], WS_WT_SSD, 1024, 6208, 6272);
    job(1, p.in[20], WS_WT_MLP, 1024, 6144, 6144);
    job(2, p.in[25], WS_WT_S5, 1024, 4096, 4096);
    job(3, p.in[36], WS_WT_NAT, 1024, 8192, 8192);
    job(4, p.in[34], WS_WT_GLU, 2048, 2048, 2048);
    for (int l = 0; l < 4; ++l) job(5 + l, p.in[11] + (size_t)l * 2048 * 1024, WS_WT_OUT + (size_t)l * 1024 * 2048 * 2, 2048, 1024, 1024);
    p.total_tiles = t0;
    void* args[] = {&p};
    hipError_t e = hipLaunchCooperativeKernel((const void*)fwd_megakernel, dim3(grid_blocks), dim3(NT), args, LDS_BYTES, stream);
    if (e != hipSuccess) fprintf(stderr, "cooperative launch failed: %s (grid %d)\n", hipGetErrorString(e), grid_blocks);
}
```

```cpp
#include <hip/hip_runtime.h>
#include <hip/hip_cooperative_groups.h>
#include <cstdio>
#include <cstdint>
#include <cstring>
namespace cg = cooperative_groups;

typedef unsigned short bf16_t;
typedef short bf16x8 __attribute__((ext_vector_type(8)));
typedef short s16x4 __attribute__((ext_vector_type(4)));
typedef float f32x4 __attribute__((ext_vector_type(4)));
typedef float f32x2 __attribute__((ext_vector_type(2)));
typedef unsigned u32x4 __attribute__((ext_vector_type(4)));
typedef unsigned u32x2 __attribute__((ext_vector_type(2)));
#define LAS __attribute__((address_space(3)))
#define WAVE_LDS_SYNC() do { asm volatile("s_waitcnt lgkmcnt(0)" ::: "memory"); __builtin_amdgcn_wave_barrier(); } while (0)

constexpr int NT = 512;
constexpr int DM = 1024, EE = 2048;
constexpr int TOK = 12288, TOKC = 8192;
constexpr int NCHUNK = 96;
constexpr float EPSN = 1e-6f;
constexpr int LDS_BYTES = 147456;

constexpr size_t WS_WT_SSD = 0;
constexpr size_t WS_WT_MLP = WS_WT_SSD + (size_t)6272 * 1024 * 2;
constexpr size_t WS_WT_S5  = WS_WT_MLP + (size_t)6144 * 1024 * 2;
constexpr size_t WS_WT_NAT = WS_WT_S5 + (size_t)4096 * 1024 * 2;
constexpr size_t WS_WT_GLU = WS_WT_NAT + (size_t)8192 * 1024 * 2;
constexpr size_t WS_WT_OUT = WS_WT_GLU + (size_t)2048 * 2048 * 2;
constexpr size_t WS_H      = WS_WT_OUT + (size_t)4 * 1024 * 2048 * 2;
constexpr size_t WS_MOD    = WS_H + (size_t)TOK * 1024 * 2;
constexpr size_t WS_DT     = WS_MOD + 147456;
constexpr size_t WS_ACUM   = WS_DT + (size_t)TOK * 64 * 4;
constexpr size_t WS_SSQ    = WS_ACUM + (size_t)TOK * 64 * 4;
constexpr size_t WS_STATS  = WS_SSQ + (size_t)TOK * 32 * 4;
constexpr size_t WS_BAR    = WS_STATS + (size_t)TOK * 8;
constexpr size_t WS_U      = WS_H + (size_t)TOK * 1024 * 2 + 8388608;
constexpr size_t WS_END    = WS_U + (size_t)TOK * 6144 * 2;
static_assert(WS_BAR + 16384 <= WS_U, "small region overflow");
static_assert(WS_END <= 268435456, "workspace over 256 MiB");

constexpr size_t OUT_SSD = (size_t)TOK * 1024;
constexpr size_t OUT_S5  = OUT_SSD + (size_t)32 * 2 * 32 * 64 * 128;
constexpr size_t OUT_CK  = OUT_S5 + (size_t)32 * 2 * 2 * 128 * 64;
constexpr size_t OUT_CV  = OUT_CK + (size_t)32 * 32 * 256 * 64;

struct TJob { const float* src; bf16_t* dst; int K, N, Npad, tile0; };
struct Params {
    const float* in[38];
    float* out;
    char* ws;
    TJob jobs[9];
    int total_tiles, pad;
};

__device__ __forceinline__ float bf2f(unsigned h) { return __uint_as_float(h << 16); }
__device__ __forceinline__ float bflo(unsigned u) { return __uint_as_float(u << 16); }
__device__ __forceinline__ float bfhi(unsigned u) { return __uint_as_float(u & 0xffff0000u); }
__device__ __forceinline__ unsigned f2bf(float f) { unsigned u = __float_as_uint(f); u += 0x7fffu + ((u >> 16) & 1u); return u >> 16; }
__device__ __forceinline__ unsigned pack2(float a, float b) { return f2bf(a) | (f2bf(b) << 16); }
__device__ __forceinline__ u32x2 pack4(f32x4 v) { u32x2 r; r.x = pack2(v[0], v[1]); r.y = pack2(v[2], v[3]); return r; }
__device__ __forceinline__ f32x4 unpack4(u32x2 u) { f32x4 r; r[0] = bflo(u.x); r[1] = bfhi(u.x); r[2] = bflo(u.y); r[3] = bfhi(u.y); return r; }
__device__ __forceinline__ void unpack8(u32x4 u, float* f) {
    f[0] = bflo(u.x); f[1] = bfhi(u.x); f[2] = bflo(u.y); f[3] = bfhi(u.y); f[4] = bflo(u.z); f[5] = bfhi(u.z); f[6] = bflo(u.w); f[7] = bfhi(u.w);
}
__device__ __forceinline__ u32x4 pack8(const float* f) { u32x4 r; r.x = pack2(f[0], f[1]); r.y = pack2(f[2], f[3]); r.z = pack2(f[4], f[5]); r.w = pack2(f[6], f[7]); return r; }
__device__ __forceinline__ float siluf(float x) { return x / (1.f + __expf(-x)); }
__device__ __forceinline__ float sigmf(float x) { return 1.f / (1.f + __expf(-x)); }
__device__ __forceinline__ float geluf(float x) {
    const float y = 0.7978845608028654f * (x + 0.044715f * x * x * x);
    const float t = 1.f - 2.f / (__expf(2.f * y) + 1.f);
    return 0.5f * x * (1.f + t);
}
__device__ __forceinline__ float softplusf(float x) { return x > 20.f ? x : log1pf(__expf(x)); }
__device__ __forceinline__ float wave_sum(float v) {
#pragma unroll
    for (int o = 32; o > 0; o >>= 1) v += __shfl_xor(v, o);
    return v;
}
__device__ __forceinline__ int cond_idx(int t) { return t < TOKC ? 0 : 1 + ((t - TOKC) >> 11); }
__device__ __forceinline__ f32x4 mfma16(bf16x8 a, bf16x8 b, f32x4 c) { return __builtin_amdgcn_mfma_f32_16x16x32_bf16(a, b, c, 0, 0, 0); }
__device__ __forceinline__ bf16x8 as_frag(u32x4 u) { union { u32x4 a; bf16x8 b; } x; x.a = u; return x.b; }

__device__ __forceinline__ bf16x8 frag_rm(const bf16_t* tile, int stride, int row0, int k0, int lane) {
    return *(const bf16x8*)(tile + (row0 + (lane & 15)) * stride + k0 + 8 * (lane >> 4));
}
__device__ __forceinline__ bf16x8 frag_tr(const bf16_t* tile, int stride, int k0, int c0, int lane) {
    const bf16_t* p = tile + (k0 + 8 * (lane >> 4) + ((lane >> 2) & 3)) * stride + c0 + 4 * (lane & 3);
    s16x4 lo = __builtin_amdgcn_ds_read_tr16_b64_v4i16((LAS s16x4*)p);
    s16x4 hi = __builtin_amdgcn_ds_read_tr16_b64_v4i16((LAS s16x4*)(p + 4 * stride));
    bf16x8 r; r[0] = lo[0]; r[1] = lo[1]; r[2] = lo[2]; r[3] = lo[3]; r[4] = hi[0]; r[5] = hi[1]; r[6] = hi[2]; r[7] = hi[3];
    return r;
}
__device__ __forceinline__ int sw64(int row, int col) { return row * 64 + ((((col >> 3) ^ (row >> 1)) & 7) << 3) + (col & 7); }
__device__ __forceinline__ bf16x8 frag_rm_sw(const bf16_t* tile, int row0, int k0, int lane) {
    const int row = row0 + (lane & 15);
    return *(const bf16x8*)(tile + sw64(row, k0 + 8 * (lane >> 4)));
}
__device__ __forceinline__ bf16x8 frag_tr_sw(const bf16_t* tile, int k0, int c0, int lane) {
    const int row = k0 + 8 * (lane >> 4) + ((lane >> 2) & 3), col = c0 + 4 * (lane & 3);
    s16x4 lo = __builtin_amdgcn_ds_read_tr16_b64_v4i16((LAS s16x4*)(tile + sw64(row, col)));
    s16x4 hi = __builtin_amdgcn_ds_read_tr16_b64_v4i16((LAS s16x4*)(tile + sw64(row + 4, col)));
    bf16x8 r; r[0] = lo[0]; r[1] = lo[1]; r[2] = lo[2]; r[3] = lo[3]; r[4] = hi[0]; r[5] = hi[1]; r[6] = hi[2]; r[7] = hi[3];
    return r;
}

template <int MI, class Epi>
__device__ __forceinline__ void gemm_phase(const bf16_t* __restrict__ A, int lda, const bf16_t* __restrict__ Bt, int M, int Npad, int K,
                                           const Epi& epi, char* smem) {
    constexpr int BM = 64 * MI, BN = 128, BK = 64;
    constexpr int BUF = (BM + BN) * 128;
    const int tid = threadIdx.x, lane = tid & 63, wid = tid >> 6, wm = wid & 3, wn = wid >> 2;
    const int nM = M / BM, nN = Npad / BN, nk = K / BK;
    const int G = gridDim.x, bid = blockIdx.x;
    const bool xmap = ((G & 7) == 0) && ((nM & 7) == 0);
    const int tmPerX = nM >> 3, perX = tmPerX * nN;
    const int jstart = xmap ? (bid >> 3) : bid, jstep = xmap ? (G >> 3) : G, jend = xmap ? perX : nM * nN;
    const int srow = tid >> 3, sc = tid & 7;
    const int soff = srow * 128 + ((sc ^ ((srow >> 1) & 7)) << 4);
    const int fsw = (lane >> 1) & 7;
    for (int j = jstart; j < jend; j += jstep) {
        int tm, tn;
        if (xmap) { tn = j / tmPerX; tm = (bid & 7) * tmPerX + (j - tn * tmPerX); } else { tm = j % nM; tn = j / nM; }
        const int m0 = tm * BM, n0 = tn * BN;
        const bf16_t* ag = A + (size_t)(m0 + srow) * lda + sc * 8;
        const bf16_t* bg = Bt + (size_t)(n0 + srow) * K + sc * 8;
        f32x4 acc[MI][4];
#pragma unroll
        for (int a = 0; a < MI; ++a)
#pragma unroll
            for (int b = 0; b < 4; ++b) acc[a][b] = (f32x4){0.f, 0.f, 0.f, 0.f};
        u32x4 ra[MI], rb[2];
#pragma unroll
        for (int a = 0; a < MI; ++a) ra[a] = *(const u32x4*)(ag + (size_t)a * 64 * lda);
#pragma unroll
        for (int b = 0; b < 2; ++b) rb[b] = *(const u32x4*)(bg + (size_t)b * 64 * K);
#pragma unroll
        for (int a = 0; a < MI; ++a) *(u32x4*)(smem + soff + a * 8192) = ra[a];
#pragma unroll
        for (int b = 0; b < 2; ++b) *(u32x4*)(smem + BM * 128 + soff + b * 8192) = rb[b];
        __syncthreads();
        for (int kt = 0; kt < nk; ++kt) {
            const char* cur = smem + (kt & 1) * BUF;
            char* nxt = smem + ((kt + 1) & 1) * BUF;
            if (kt + 1 < nk) {
#pragma unroll
                for (int a = 0; a < MI; ++a) ra[a] = *(const u32x4*)(ag + (size_t)a * 64 * lda + (kt + 1) * BK);
#pragma unroll
                for (int b = 0; b < 2; ++b) rb[b] = *(const u32x4*)(bg + (size_t)b * 64 * K + (kt + 1) * BK);
            }
#pragma unroll
            for (int ks = 0; ks < 2; ++ks) {
                bf16x8 af[MI], bfr[4];
                const int ch = (((ks * 4 + (lane >> 4)) ^ fsw) << 4);
#pragma unroll
                for (int a = 0; a < MI; ++a) af[a] = *(const bf16x8*)(cur + (wm * 16 * MI + a * 16 + (lane & 15)) * 128 + ch);
#pragma unroll
                for (int b = 0; b < 4; ++b) bfr[b] = *(const bf16x8*)(cur + BM * 128 + (wn * 64 + b * 16 + (lane & 15)) * 128 + ch);
#pragma unroll
                for (int a = 0; a < MI; ++a)
#pragma unroll
                    for (int b = 0; b < 4; ++b) acc[a][b] = mfma16(bfr[b], af[a], acc[a][b]);
            }
            if (kt + 1 < nk) {
#pragma unroll
                for (int a = 0; a < MI; ++a) *(u32x4*)(nxt + soff + a * 8192) = ra[a];
#pragma unroll
                for (int b = 0; b < 2; ++b) *(u32x4*)(nxt + BM * 128 + soff + b * 8192) = rb[b];
            }
            __syncthreads();
        }
#pragma unroll
        for (int a = 0; a < MI; ++a) {
            const int row = m0 + wm * 16 * MI + a * 16 + (lane & 15);
            const float rs = epi.rowscale(row);
#pragma unroll
            for (int b = 0; b < 4; ++b) epi(row, n0 + wn * 64 + b * 16 + (lane >> 4) * 4, acc[a][b], rs);
        }
    }
}

struct EpiSSD {
    bf16_t* Uz; bf16_t* Uxbc; float* DT; const float* dt_bias;
    __device__ __forceinline__ float rowscale(int) const { return 1.f; }
    __device__ __forceinline__ void operator()(int row, int col, f32x4 v, float) const {
        if (col < 2048) { f32x4 s; for (int i = 0; i < 4; ++i) s[i] = siluf(v[i]); *(u32x2*)(Uz + (size_t)row * 2048 + col) = pack4(s); }
        else if (col < 6144) { *(u32x2*)(Uxbc + (size_t)row * 4096 + (col - 2048)) = pack4(v); }
        else if (col < 6208) { const int c = col - 6144; f32x4 s; for (int i = 0; i < 4; ++i) s[i] = softplusf(v[i] + dt_bias[c + i]); *(f32x4*)(DT + (size_t)row * 64 + c) = s; }
    }
};
struct EpiMLP {
    bf16_t* U;
    __device__ __forceinline__ float rowscale(int) const { return 1.f; }
    __device__ __forceinline__ void operator()(int row, int col, f32x4 v, float) const {
        f32x4 s;
        if (col < 4096) { for (int i = 0; i < 4; ++i) s[i] = geluf(v[i]); } else { for (int i = 0; i < 4; ++i) s[i] = siluf(v[i]); }
        *(u32x2*)(U + (size_t)row * 6144 + col) = pack4(s);
    }
};
struct EpiS5 {
    bf16_t* Uu; bf16_t* Uz;
    __device__ __forceinline__ float rowscale(int) const { return 1.f; }
    __device__ __forceinline__ void operator()(int row, int col, f32x4 v, float) const {
        if (col < 2048) *(u32x2*)(Uu + (size_t)row * 2048 + col) = pack4(v);
        else { f32x4 s; for (int i = 0; i < 4; ++i) s[i] = siluf(v[i]); *(u32x2*)(Uz + (size_t)row * 2048 + (col - 2048)) = pack4(s); }
    }
};
struct EpiNAT {
    bf16_t* Q; bf16_t* Z; bf16_t* Kl; bf16_t* Vl; float* ck; float* cv;
    __device__ __forceinline__ float rowscale(int) const { return 1.f; }
    __device__ __forceinline__ void operator()(int row, int col, f32x4 v, float) const {
        if (col < 2048) { *(u32x2*)(Q + (size_t)row * 2048 + col) = pack4(v * 0.125f); }
        else if (col < 6144) {
            const bool isv = col >= 4096; const int c = col - (isv ? 4096 : 2048);
            if (row < TOKC) { const int b = row >> 8, s = row & 255, h = c >> 6, d = c & 63; float* dst = (isv ? cv : ck) + ((size_t)((b * 32 + h) * 256 + s)) * 64 + d; *(f32x4*)dst = v; }
            else { bf16_t* dst = (isv ? Vl : Kl) + (size_t)(row - TOKC) * 2048 + c; *(u32x2*)dst = pack4(v); }
        } else { f32x4 s; for (int i = 0; i < 4; ++i) s[i] = siluf(v[i]); *(u32x2*)(Z + (size_t)row * 2048 + (col - 6144)) = pack4(s); }
    }
};
struct EpiOut {
    const float* xp; const float* xs; float* X; const float* modl; const float* ssq; int first;
    __device__ __forceinline__ float rowscale(int row) const {
        if (!ssq) return 1.f;
        const f32x4* p = (const f32x4*)(ssq + (size_t)row * 32); float s = 0.f;
#pragma unroll
        for (int i = 0; i < 8; ++i) { f32x4 v = p[i]; s += (v[0] + v[1]) + (v[2] + v[3]); }
        return rsqrtf(s * (1.f / 2048.f) + EPSN);
    }
    __device__ __forceinline__ void operator()(int row, int col, f32x4 v, float rs) const {
        const f32x4 g = *(const f32x4*)(modl + cond_idx(row) * 3072 + 2048 + col);
        const float* xin = first ? (row < TOKC ? xp + (size_t)row * 1024 : xs + (size_t)(row - TOKC) * 1024) : X + (size_t)row * 1024;
        const f32x4 x = *(const f32x4*)(xin + col);
        *(f32x4*)(X + (size_t)row * 1024 + col) = x + g * (v * rs);
    }
};
struct EpiGLU {
    const bf16_t* Yb; bf16_t* Uz; const float* bglu;
    __device__ __forceinline__ float rowscale(int) const { return 1.f; }
    __device__ __forceinline__ void operator()(int row, int col, f32x4 v, float) const {
        const f32x4 y = unpack4(*(const u32x2*)(Yb + (size_t)row * 2048 + col));
        const f32x4 z = unpack4(*(const u32x2*)(Uz + (size_t)row * 2048 + col));
        const f32x4 b = *(const f32x4*)(bglu + col);
        f32x4 o; for (int i = 0; i < 4; ++i) o[i] = y[i] * sigmf(v[i] + b[i]) * z[i];
        *(u32x2*)(Uz + (size_t)row * 2048 + col) = pack4(o);
    }
};

__device__ __forceinline__ void prep_phase(const Params& p, char* smem) {
    const int tid = threadIdx.x, lane = tid & 63, wid = tid >> 6;
    float* tile = (float*)smem;
    for (int T = blockIdx.x; T < p.total_tiles; T += gridDim.x) {
        int j = 0;
#pragma unroll
        for (int q = 1; q < 9; ++q) if (T >= p.jobs[q].tile0) j = q;
        const float* src = p.jobs[j].src; bf16_t* dst = p.jobs[j].dst; const int K = p.jobs[j].K, N = p.jobs[j].N;
        const int local = T - p.jobs[j].tile0, nkt = K >> 6, kt = local % nkt, nt = local / nkt, k0 = kt * 64, n0 = nt * 64;
        __syncthreads();
        if (n0 < N) {
#pragma unroll
            for (int q = tid; q < 1024; q += NT) { const int r = q >> 4, c4 = q & 15; const f32x4 v = *(const f32x4*)(src + (size_t)(k0 + r) * N + n0 + c4 * 4);
                tile[r * 65 + c4 * 4 + 0] = v[0]; tile[r * 65 + c4 * 4 + 1] = v[1]; tile[r * 65 + c4 * 4 + 2] = v[2]; tile[r * 65 + c4 * 4 + 3] = v[3]; }
        }
        __syncthreads();
        {
            const int nn = tid >> 3, kc = tid & 7; float f[8];
#pragma unroll
            for (int i = 0; i < 8; ++i) f[i] = (n0 < N) ? tile[(kc * 8 + i) * 65 + nn] : 0.f;
            *(u32x4*)(dst + (size_t)(n0 + nn) * K + k0 + kc * 8) = pack8(f);
        }
    }
    __syncthreads();
    float* sc = (float*)smem;
    float* part = (float*)smem + 3072;
    for (int q = tid; q < 3072; q += NT) { const int ci = q >> 10, k = q & 1023; const float cv = ci == 0 ? p.in[7][k] : p.in[6][(ci - 1) * 1024 + k]; sc[q] = siluf(cv); }
    __syncthreads();
    float* MOD = (float*)(p.ws + WS_MOD);
    for (int it = blockIdx.x; it < 192; it += gridDim.x) {
        const int layer = it / 48, cg0 = (it % 48) * 64, col = cg0 + lane;
        const float* w = p.in[9] + (size_t)layer * 1024 * 3072 + col;
        float a0 = 0.f, a1 = 0.f, a2 = 0.f;
        for (int k = wid * 128; k < wid * 128 + 128; ++k) { const float wv = w[(size_t)k * 3072]; a0 += sc[k] * wv; a1 += sc[1024 + k] * wv; a2 += sc[2048 + k] * wv; }
        part[(wid * 3 + 0) * 64 + lane] = a0; part[(wid * 3 + 1) * 64 + lane] = a1; part[(wid * 3 + 2) * 64 + lane] = a2;
        __syncthreads();
        if (tid < 192) { const int ci = tid >> 6, l = tid & 63; float s = p.in[10][layer * 3072 + cg0 + l];
#pragma unroll
            for (int w8 = 0; w8 < 8; ++w8) s += part[(w8 * 3 + ci) * 64 + l];
            MOD[(layer * 3 + ci) * 3072 + cg0 + l] = s; }
        __syncthreads();
    }
}

__device__ __forceinline__ void norm_phase(const Params& p, int layer) {
    const int lane = threadIdx.x & 63, gw = blockIdx.x * 8 + (threadIdx.x >> 6), nw = gridDim.x * 8;
    const float* g = p.in[8] + layer * 1024;
    const float* MOD = (const float*)(p.ws + WS_MOD) + layer * 3 * 3072;
    bf16_t* H = (bf16_t*)(p.ws + WS_H);
    for (int t = gw; t < TOK; t += nw) {
        const float* xr = layer == 0 ? (t < TOKC ? p.in[0] + (size_t)t * 1024 : p.in[1] + (size_t)(t - TOKC) * 1024) : p.out + (size_t)t * 1024;
        f32x4 v[4]; float ss = 0.f;
#pragma unroll
        for (int j = 0; j < 4; ++j) { v[j] = *(const f32x4*)(xr + j * 256 + lane * 4); ss += v[j][0] * v[j][0] + v[j][1] * v[j][1] + v[j][2] * v[j][2] + v[j][3] * v[j][3]; }
        ss = wave_sum(ss);
        const float rstd = rsqrtf(ss * (1.f / 1024.f) + EPSN);
        const float* md = MOD + cond_idx(t) * 3072;
#pragma unroll
        for (int j = 0; j < 4; ++j) {
            const int c = j * 256 + lane * 4;
            const f32x4 gg = *(const f32x4*)(g + c), sh = *(const f32x4*)(md + c), scl = *(const f32x4*)(md + 1024 + c);
            f32x4 h; for (int i = 0; i < 4; ++i) h[i] = v[j][i] * rstd * gg[i] * (1.f + scl[i]) + sh[i];
            *(u32x2*)(H + (size_t)t * 1024 + c) = pack4(h);
        }
    }
}
__device__ __forceinline__ void final_phase(const Params& p) {
    const int lane = threadIdx.x & 63, gw = blockIdx.x * 8 + (threadIdx.x >> 6), nw = gridDim.x * 8;
    const float* g = p.in[12];
    for (int t = gw; t < TOK; t += nw) {
        float* xr = p.out + (size_t)t * 1024;
        f32x4 v[4]; float ss = 0.f;
#pragma unroll
        for (int j = 0; j < 4; ++j) { v[j] = *(const f32x4*)(xr + j * 256 + lane * 4); ss += v[j][0] * v[j][0] + v[j][1] * v[j][1] + v[j][2] * v[j][2] + v[j][3] * v[j][3]; }
        ss = wave_sum(ss);
        const float rstd = rsqrtf(ss * (1.f / 1024.f) + EPSN);
#pragma unroll
        for (int j = 0; j < 4; ++j) { const int c = j * 256 + lane * 4; const f32x4 gg = *(const f32x4*)(g + c); *(f32x4*)(xr + c) = v[j] * rstd * gg; }
    }
}


__device__ __forceinline__ void ssd_conv_phase(const Params& p, const bf16_t* Uxbc, bf16_t* XBC) {
    const int tid = threadIdx.x, lane = tid & 63, wid = tid >> 6;
    const float* DT = (const float*)(p.ws + WS_DT);
    float* ACUM = (float*)(p.ws + WS_ACUM);
    for (int ch = blockIdx.x * 8 + wid; ch < NCHUNK; ch += gridDim.x * 8) {
        const int t0 = ch * 128, d = lane >> 5;
        const float a = -__expf(p.in[17][lane]);
        float acc = 0.f;
        for (int i = 0; i < 128; ++i) { const int l = d ? 127 - i : i; acc += DT[(size_t)(t0 + l) * 64 + lane] * a; ACUM[(size_t)(t0 + l) * 64 + lane] = acc; }
    }
    const int chn = tid * 8;
    float w[5][8], bias[8];
#pragma unroll
    for (int j = 0; j < 5; ++j) { const f32x4 a = *(const f32x4*)(p.in[14] + j * 4096 + chn), b = *(const f32x4*)(p.in[14] + j * 4096 + chn + 4);
        w[j][0] = a[0]; w[j][1] = a[1]; w[j][2] = a[2]; w[j][3] = a[3]; w[j][4] = b[0]; w[j][5] = b[1]; w[j][6] = b[2]; w[j][7] = b[3]; }
    { const f32x4 a = *(const f32x4*)(p.in[15] + chn), b = *(const f32x4*)(p.in[15] + chn + 4);
      bias[0] = a[0]; bias[1] = a[1]; bias[2] = a[2]; bias[3] = a[3]; bias[4] = b[0]; bias[5] = b[1]; bias[6] = b[2]; bias[7] = b[3]; }
    const int rpb = (TOK + gridDim.x - 1) / gridDim.x;
    const int r0 = blockIdx.x * rpb, r1 = min(TOK, r0 + rpb);
    for (int t = r0; t < r1; ++t) {
        int s0, s1;
        if (t < TOKC) { s0 = t & ~255; s1 = s0 + 256; } else { s0 = TOKC + ((t - TOKC) & ~2047); s1 = s0 + 2048; }
        float acc[8];
#pragma unroll
        for (int i = 0; i < 8; ++i) acc[i] = bias[i];
#pragma unroll
        for (int j = 0; j < 5; ++j) {
            const int tt = t + j - 2;
            if (tt >= s0 && tt < s1) {
                float f[8]; unpack8(*(const u32x4*)(Uxbc + (size_t)tt * 4096 + chn), f);
#pragma unroll
                for (int i = 0; i < 8; ++i) acc[i] += w[j][i] * f[i];
            }
        }
#pragma unroll
        for (int i = 0; i < 8; ++i) acc[i] = siluf(acc[i]);
        *(u32x4*)(XBC + (size_t)t * 4096 + chn) = pack8(acc);
    }
}

__device__ __forceinline__ void ssd_state_phase(const Params& p, const bf16_t* XBC, bf16_t* SB, char* smem) {
    const int tid = threadIdx.x, lane = tid & 63, wid = tid >> 6;
    const float* DT = (const float*)(p.ws + WS_DT);
    const float* ACUM = (const float*)(p.ws + WS_ACUM);
    bf16_t* Bt = (bf16_t*)smem;
    bf16_t* Xf = Bt + 128 * 136;
    bf16_t* Xb = Xf + 128 * 72;
    for (int item = blockIdx.x; item < NCHUNK * 8; item += gridDim.x) {
        const int ch = item >> 3, g = item & 7, t0 = ch * 128;
        __syncthreads();
#pragma unroll
        for (int j = 0; j < 4; ++j) { const int q = tid + NT * j, row = q >> 4, c = q & 15;
            *(u32x4*)(Bt + row * 136 + c * 8) = *(const u32x4*)(XBC + (size_t)(t0 + row) * 4096 + 2048 + g * 128 + c * 8); }
        for (int hh = 0; hh < 4; ++hh) {
            const int h = g * 4 + hh;
            __syncthreads();
            const float af_last = ACUM[(size_t)(t0 + 127) * 64 + h], sb_first = ACUM[(size_t)t0 * 64 + 32 + h];
#pragma unroll
            for (int j = 0; j < 2; ++j) { const int q = tid + NT * j, row = q >> 3, c = q & 7; const size_t tr = (size_t)(t0 + row);
                const float wf = __expf(af_last - ACUM[tr * 64 + h]) * DT[tr * 64 + h];
                const float wb = __expf(sb_first - ACUM[tr * 64 + 32 + h]) * DT[tr * 64 + 32 + h];
                float f[8], o[8]; unpack8(*(const u32x4*)(XBC + tr * 4096 + h * 64 + c * 8), f);
#pragma unroll
                for (int i = 0; i < 8; ++i) o[i] = f[i] * wf;
                *(u32x4*)(Xf + row * 72 + c * 8) = pack8(o);
#pragma unroll
                for (int i = 0; i < 8; ++i) o[i] = f[i] * wb;
                *(u32x4*)(Xb + row * 72 + c * 8) = pack8(o); }
            __syncthreads();
            const int dir = wid >> 2, nq = wid & 3;
            const bf16_t* Xd = dir ? Xb : Xf;
            f32x4 acc[4][2];
#pragma unroll
            for (int a = 0; a < 4; ++a) { acc[a][0] = (f32x4){0.f, 0.f, 0.f, 0.f}; acc[a][1] = (f32x4){0.f, 0.f, 0.f, 0.f}; }
#pragma unroll
            for (int ks = 0; ks < 4; ++ks) {
                bf16x8 xa[4], bb[2];
#pragma unroll
                for (int a = 0; a < 4; ++a) xa[a] = frag_tr(Xd, 72, ks * 32, a * 16, lane);
#pragma unroll
                for (int b = 0; b < 2; ++b) bb[b] = frag_tr(Bt, 136, ks * 32, nq * 32 + b * 16, lane);
#pragma unroll
                for (int a = 0; a < 4; ++a)
#pragma unroll
                    for (int b = 0; b < 2; ++b) acc[a][b] = mfma16(bb[b], xa[a], acc[a][b]);
            }
            bf16_t* dst = SB + ((size_t)((ch * 2 + dir) * 32 + h)) * 8192;
#pragma unroll
            for (int a = 0; a < 4; ++a)
#pragma unroll
                for (int b = 0; b < 2; ++b) { const int pp = a * 16 + (lane & 15), n = nq * 32 + b * 16 + (lane >> 4) * 4;
                    *(u32x2*)(dst + pp * 128 + n) = pack4(acc[a][b]); }
        }
    }
}

__device__ __forceinline__ void ssd_scan_phase(const Params& p, bf16_t* SB) {
    const int tid = threadIdx.x;
    const float* ACUM = (const float*)(p.ws + WS_ACUM);
    for (int item = blockIdx.x; item < 34 * 64; item += gridDim.x) {
        const int seq = item >> 6, d = (item >> 5) & 1, h = item & 31;
        const int nc = seq < 32 ? 2 : 16, ch0 = seq < 32 ? seq * 2 : 64 + (seq - 32) * 16;
#pragma unroll
        for (int j = 0; j < 2; ++j) {
            const int e = (tid + NT * j) * 8;
            float st[8];
            if (seq >= 32) { const float* h0 = p.in[2] + ((size_t)(((seq - 32) * 2 + d) * 32 + h)) * 8192 + e; const f32x4 a = *(const f32x4*)h0, b = *(const f32x4*)(h0 + 4);
                st[0] = a[0]; st[1] = a[1]; st[2] = a[2]; st[3] = a[3]; st[4] = b[0]; st[5] = b[1]; st[6] = b[2]; st[7] = b[3]; }
            else {
#pragma unroll
                for (int i = 0; i < 8; ++i) st[i] = 0.f; }
            for (int ci = 0; ci < nc; ++ci) {
                const int c = d ? nc - 1 - ci : ci, ch = ch0 + c, t0 = ch * 128;
                const float tot = d ? ACUM[(size_t)t0 * 64 + 32 + h] : ACUM[(size_t)(t0 + 127) * 64 + h];
                bf16_t* ptr = SB + ((size_t)((ch * 2 + d) * 32 + h)) * 8192 + e;
                float s[8]; unpack8(*(const u32x4*)ptr, s);
                *(u32x4*)ptr = pack8(st);
                const float dec = __expf(tot);
#pragma unroll
                for (int i = 0; i < 8; ++i) st[i] = dec * st[i] + s[i];
            }
            if (seq < 32) { float* o = p.out + OUT_SSD + ((size_t)((seq * 2 + d) * 32 + h)) * 8192 + e;
                *(f32x4*)o = (f32x4){st[0], st[1], st[2], st[3]}; *(f32x4*)(o + 4) = (f32x4){st[4], st[5], st[6], st[7]}; }
        }
    }
}

__device__ __forceinline__ void ssd_out_phase(const Params& p, const bf16_t* XBC, const bf16_t* SB, bf16_t* Uz, char* smem) {
    const int tid = threadIdx.x, lane = tid & 63, wid = tid >> 6;
    const float* DT = (const float*)(p.ws + WS_DT);
    const float* ACUM = (const float*)(p.ws + WS_ACUM);
    float* SSQ = (float*)(p.ws + WS_SSQ);
    bf16_t* Ct = (bf16_t*)smem;
    bf16_t* R1 = Ct + 128 * 136;
    bf16_t* Mt = R1 + 128 * 136;
    bf16_t* Xt = Mt + 128 * 136;
    float* vec = (float*)(Xt + 128 * 72);
    for (int item = blockIdx.x; item < NCHUNK * 8; item += gridDim.x) {
        const int ch = item >> 3, g = item & 7, t0 = ch * 128;
        __syncthreads();
#pragma unroll
        for (int j = 0; j < 4; ++j) { const int q = tid + NT * j, row = q >> 4, c = q & 15; const bf16_t* src = XBC + (size_t)(t0 + row) * 4096 + g * 128 + c * 8;
            *(u32x4*)(R1 + row * 136 + c * 8) = *(const u32x4*)(src + 2048);
            *(u32x4*)(Ct + row * 136 + c * 8) = *(const u32x4*)(src + 3072); }
#pragma unroll
        for (int j = 0; j < 4; ++j) { const int idx = tid + NT * j, kind = idx >> 9, hh = (idx >> 7) & 3, l = idx & 127; const int h = g * 4 + hh;
            const float* srcp = (kind < 2 ? ACUM : DT) + (size_t)(t0 + l) * 64 + (kind & 1) * 32 + h;
            vec[idx] = *srcp; }
        __syncthreads();
        f32x4 gacc[8];
#pragma unroll
        for (int st = 0; st < 8; ++st) gacc[st] = (f32x4){0.f, 0.f, 0.f, 0.f};
#pragma unroll
        for (int ks = 0; ks < 4; ++ks) {
            const bf16x8 cf = frag_rm(Ct, 136, 16 * wid, ks * 32, lane);
#pragma unroll
            for (int st = 0; st < 8; ++st) gacc[st] = mfma16(frag_rm(R1, 136, st * 16, ks * 32, lane), cf, gacc[st]);
        }
        const int l = 16 * wid + (lane & 15);
        for (int hh = 0; hh < 4; ++hh) {
            const int h = g * 4 + hh;
            const float* Af = vec + hh * 128; const float* Sb = vec + 512 + hh * 128; const float* dtf = vec + 1024 + hh * 128; const float* dtb = vec + 1536 + hh * 128;
            __syncthreads();
#pragma unroll
            for (int j = 0; j < 2; ++j) { const int q = tid + NT * j, row = q >> 3, c = q & 7;
                *(u32x4*)(Xt + row * 72 + c * 8) = *(const u32x4*)(XBC + (size_t)(t0 + row) * 4096 + h * 64 + c * 8); }
#pragma unroll
            for (int j = 0; j < 4; ++j) { const int q = tid + NT * j, dd = q >> 10, row = (q >> 4) & 63, c = q & 15;
                *(u32x4*)(R1 + (dd * 64 + row) * 136 + c * 8) = *(const u32x4*)(SB + ((size_t)((ch * 2 + dd) * 32 + h)) * 8192 + row * 128 + c * 8); }
            {
                const float afl = Af[l], sbl = Sb[l];
#pragma unroll
                for (int st = 0; st < 8; ++st) {
                    f32x4 m;
#pragma unroll
                    for (int r = 0; r < 4; ++r) { const int s = st * 16 + (lane >> 4) * 4 + r;
                        float wgt = 0.f;
                        if (s <= l) wgt += __expf(afl - Af[s]) * dtf[s];
                        if (s >= l) wgt += __expf(sbl - Sb[s]) * dtb[s];
                        m[r] = gacc[st][r] * wgt; }
                    *(u32x2*)(Mt + l * 136 + st * 16 + (lane >> 4) * 4) = pack4(m);
                }
            }
            __syncthreads();
            f32x4 ad[4], af[4], ab[4];
#pragma unroll
            for (int a = 0; a < 4; ++a) { ad[a] = (f32x4){0.f, 0.f, 0.f, 0.f}; af[a] = ad[a]; ab[a] = ad[a]; }
#pragma unroll
            for (int ks = 0; ks < 4; ++ks) {
                const bf16x8 mf = frag_rm(Mt, 136, 16 * wid, ks * 32, lane);
                const bf16x8 cf = frag_rm(Ct, 136, 16 * wid, ks * 32, lane);
#pragma unroll
                for (int a = 0; a < 4; ++a) {
                    ad[a] = mfma16(frag_tr(Xt, 72, ks * 32, a * 16, lane), mf, ad[a]);
                    af[a] = mfma16(frag_rm(R1, 136, a * 16, ks * 32, lane), cf, af[a]);
                    ab[a] = mfma16(frag_rm(R1 + 64 * 136, 136, a * 16, ks * 32, lane), cf, ab[a]);
                }
            }
            const float ef = __expf(Af[l]), eb = __expf(Sb[l]), Dh = p.in[18][h];
            const size_t t = (size_t)(t0 + l);
            float ssq = 0.f;
#pragma unroll
            for (int a = 0; a < 4; ++a) {
                const int pp = a * 16 + (lane >> 4) * 4, col = h * 64 + pp;
                const f32x4 x = unpack4(*(const u32x2*)(Xt + l * 72 + pp));
                const f32x4 sz = unpack4(*(const u32x2*)(Uz + t * 2048 + col));
                const f32x4 ng = *(const f32x4*)(p.in[19] + col);
                f32x4 y = (ad[a] + af[a] * ef + ab[a] * eb + x * Dh) * sz;
                ssq += y[0] * y[0] + y[1] * y[1] + y[2] * y[2] + y[3] * y[3];
                *(u32x2*)(Uz + t * 2048 + col) = pack4(y * ng);
            }
            ssq += __shfl_xor(ssq, 16); ssq += __shfl_xor(ssq, 32);
            if (lane < 16) SSQ[t * 32 + h] = ssq;
        }
    }
}


__device__ __forceinline__ void mlp_stats_phase(const Params& p, const bf16_t* U) {
    const int lane = threadIdx.x & 63, gw = blockIdx.x * 8 + (threadIdx.x >> 6), nw = gridDim.x * 8;
    float* STATS = (float*)(p.ws + WS_STATS);
    for (int t = gw; t < TOK; t += nw) {
        float f[32]; float s = 0.f;
#pragma unroll
        for (int j = 0; j < 4; ++j) { unpack8(*(const u32x4*)(U + (size_t)t * 6144 + 2048 + j * 512 + lane * 8), f + j * 8); }
#pragma unroll
        for (int i = 0; i < 32; ++i) s += f[i];
        s = wave_sum(s);
        const float mean = s * (1.f / 2048.f);
        float q = 0.f;
#pragma unroll
        for (int i = 0; i < 32; ++i) { const float d = f[i] - mean; q += d * d; }
        q = wave_sum(q);
        if (lane == 0) { STATS[(size_t)t * 2] = mean; STATS[(size_t)t * 2 + 1] = rsqrtf(q * (1.f / 2048.f) + EPSN); }
    }
}
__device__ __forceinline__ void mlp_mix_phase(const Params& p, bf16_t* U, char* smem) {
    const int tid = threadIdx.x, lane = tid & 63, wid = tid >> 6;
    const float* STATS = (const float*)(p.ws + WS_STATS);
    bf16_t* Wt = (bf16_t*)smem;
    bf16_t* Vt = Wt + 128 * 136;
    for (int item = blockIdx.x; item < NCHUNK * 16; item += gridDim.x) {
        const int ch = item >> 4, ct = item & 15, g = ct >> 1, c0 = ct * 128, t0 = ch * 128;
        __syncthreads();
#pragma unroll
        for (int jj = 0; jj < 8; ++jj) { const int q = tid + NT * jj, i = q >> 5, j4 = q & 31;
            const f32x4 w = *(const f32x4*)(p.in[23] + ((size_t)(g * 128 + i)) * 128 + j4 * 4);
            *(u32x2*)(Wt + i * 136 + j4 * 4) = pack4(w); }
#pragma unroll
        for (int jj = 0; jj < 4; ++jj) { const int q = tid + NT * jj, j = q >> 4, c = q & 15; const size_t t = (size_t)(t0 + j);
            const float mean = STATS[t * 2], rstd = STATS[t * 2 + 1];
            float f[8]; unpack8(*(const u32x4*)(U + t * 6144 + 2048 + c0 + c * 8), f);
            const f32x4 g0 = *(const f32x4*)(p.in[21] + c0 + c * 8), g1 = *(const f32x4*)(p.in[21] + c0 + c * 8 + 4);
            const f32x4 b0 = *(const f32x4*)(p.in[22] + c0 + c * 8), b1 = *(const f32x4*)(p.in[22] + c0 + c * 8 + 4);
#pragma unroll
            for (int i = 0; i < 4; ++i) { f[i] = (f[i] - mean) * rstd * g0[i] + b0[i]; f[4 + i] = (f[4 + i] - mean) * rstd * g1[i] + b1[i]; }
            *(u32x4*)(Vt + j * 136 + c * 8) = pack8(f); }
        __syncthreads();
        f32x4 acc[8];
#pragma unroll
        for (int a = 0; a < 8; ++a) acc[a] = (f32x4){0.f, 0.f, 0.f, 0.f};
#pragma unroll
        for (int ks = 0; ks < 4; ++ks) {
            const bf16x8 wf = frag_rm(Wt, 136, 16 * wid, ks * 32, lane);
#pragma unroll
            for (int a = 0; a < 8; ++a) acc[a] = mfma16(frag_tr(Vt, 136, ks * 32, a * 16, lane), wf, acc[a]);
        }
        const int i = 16 * wid + (lane & 15); const size_t t = (size_t)(t0 + i);
        const float bs = p.in[24][g * 128 + i];
#pragma unroll
        for (int a = 0; a < 8; ++a) {
            const int col = c0 + a * 16 + (lane >> 4) * 4;
            const f32x4 gu = unpack4(*(const u32x2*)(U + t * 6144 + col));
            const f32x4 sz = unpack4(*(const u32x2*)(U + t * 6144 + 4096 + col));
            *(u32x2*)(U + t * 6144 + col) = pack4(gu * (acc[a] + bs) * sz);
        }
    }
}

__device__ __forceinline__ void s5_scan_phase(const Params& p, const bf16_t* Uu, bf16_t* Ydir, char* smem) {
    const int tid = threadIdx.x, lane = tid & 63, wid = tid >> 6;
    float* drv = (float*)(smem + wid * 12800);
    bf16_t* Sbuf = (bf16_t*)(smem + wid * 12800 + 8448);
    const int nwaves = gridDim.x * 8;
    for (int wi = blockIdx.x * 8 + wid; wi < 2048; wi += nwaves) {
        const int combo = wi >> 3, slot = wi & 7, d = combo >> 7, g = combo & 127;
        const int dg = d * 128 + g;
        const float step = __expf(p.in[28][dg]);
        float ar, ai;
        {
            const float lr = p.in[26][dg * 64 + lane], li = p.in[27][dg * 64 + lane];
            const float mag = __expf(lr * step), ang = li * step;
            const float kk = rintf(ang * 0.15915494309189535f);
            float rr = fmaf(-kk, 6.2831854820251465f, ang); rr = fmaf(-kk, -1.7484555e-7f, rr);
            ar = mag * __cosf(rr); ai = mag * __sinf(rr);
        }
        bf16x8 bfr[8];
#pragma unroll
        for (int tq = 0; tq < 4; ++tq) {
            const int n = tq * 16 + (lane & 15);
            const float lr = p.in[26][dg * 64 + n], li = p.in[27][dg * 64 + n];
            const float mag = __expf(lr * step), ang = li * step;
            const float kk = rintf(ang * 0.15915494309189535f);
            float rr = fmaf(-kk, 6.2831854820251465f, ang); rr = fmaf(-kk, -1.7484555e-7f, rr);
            const float abr = mag * __cosf(rr), abi = mag * __sinf(rr);
            const float den = lr * lr + li * li, nr = abr - 1.f;
            const float cr = (nr * lr + abi * li) / den, ci = (abi * lr - nr * li) / den;
            float fr[8], fi[8];
            if ((lane >> 4) < 2) {
                const float* pr = p.in[29] + ((size_t)(dg * 64 + n)) * 16 + 8 * (lane >> 4);
                const float* pi = p.in[30] + ((size_t)(dg * 64 + n)) * 16 + 8 * (lane >> 4);
#pragma unroll
                for (int j = 0; j < 8; ++j) { const float br = pr[j], bi = pi[j]; fr[j] = cr * br - ci * bi; fi[j] = cr * bi + ci * br; }
            } else {
#pragma unroll
                for (int j = 0; j < 8; ++j) { fr[j] = 0.f; fi[j] = 0.f; }
            }
            bfr[tq] = as_frag(pack8(fr)); bfr[4 + tq] = as_frag(pack8(fi));
        }
        bf16x8 cfr[4];
#pragma unroll
        for (int ks = 0; ks < 4; ++ks) {
            const float* pc = (ks < 2 ? p.in[31] : p.in[32]) + ((size_t)(dg * 16 + (lane & 15))) * 64 + (ks & 1) * 32 + 8 * (lane >> 4);
            float f[8];
#pragma unroll
            for (int j = 0; j < 8; ++j) f[j] = ks < 2 ? pc[j] : -pc[j];
            cfr[ks] = as_frag(pack8(f));
        }
        const int nseq = slot < 2 ? 1 : (32 - (slot - 2) + 5) / 6;
        for (int si = 0; si < nseq; ++si) {
            const int seq = slot < 2 ? 32 + slot : (slot - 2) + 6 * si;
            const int L = seq < 32 ? 256 : 2048, tb = seq < 32 ? seq * 256 : TOKC + (seq - 32) * 2048, nchunks = L >> 4;
            float sr = 0.f, sim = 0.f;
            if (seq >= 32) { const float* h0 = p.in[3] + ((size_t)(((seq - 32) * 2 + d) * 2) * 128 + g) * 64 + lane; sr = h0[0]; sim = h0[128 * 64]; }
            u32x4 ucur = (u32x4){0u, 0u, 0u, 0u};
            { const int c = d ? nchunks - 1 : 0; if ((lane >> 4) < 2) ucur = *(const u32x4*)(Uu + (size_t)(tb + c * 16 + (lane & 15)) * 2048 + g * 16 + 8 * (lane >> 4)); }
            for (int ci = 0; ci < nchunks; ++ci) {
                const int c = d ? nchunks - 1 - ci : ci, tok0 = tb + c * 16;
                u32x4 unext = (u32x4){0u, 0u, 0u, 0u};
                if (ci + 1 < nchunks && (lane >> 4) < 2) { const int c2 = d ? c - 1 : c + 1; unext = *(const u32x4*)(Uu + (size_t)(tb + c2 * 16 + (lane & 15)) * 2048 + g * 16 + 8 * (lane >> 4)); }
                const bf16x8 uf = as_frag(ucur);
#pragma unroll
                for (int tl = 0; tl < 8; ++tl) {
                    const f32x4 dv = mfma16(bfr[tl], uf, (f32x4){0.f, 0.f, 0.f, 0.f});
                    *(f32x4*)(drv + (lane & 15) * 132 + tl * 16 + (lane >> 4) * 4) = dv;
                }
                WAVE_LDS_SYNC();
                float dre[16], dim[16];
#pragma unroll
                for (int i = 0; i < 16; ++i) { const int tt = d ? 15 - i : i; dre[i] = drv[tt * 132 + lane]; dim[i] = drv[tt * 132 + 64 + lane]; }
#pragma unroll
                for (int i = 0; i < 16; ++i) { const int tt = d ? 15 - i : i;
                    const float nr2 = ar * sr - ai * sim + dre[i], ni2 = ar * sim + ai * sr + dim[i];
                    sr = nr2; sim = ni2;
                    Sbuf[tt * 136 + lane] = (bf16_t)f2bf(sr); Sbuf[tt * 136 + 64 + lane] = (bf16_t)f2bf(sim); }
                WAVE_LDS_SYNC();
                f32x4 ya = (f32x4){0.f, 0.f, 0.f, 0.f};
#pragma unroll
                for (int ks = 0; ks < 4; ++ks) ya = mfma16(cfr[ks], frag_rm(Sbuf, 136, 0, ks * 32, lane), ya);
                *(u32x2*)(Ydir + ((size_t)d * TOK + tok0 + (lane & 15)) * 2048 + g * 16 + (lane >> 4) * 4) = pack4(ya);
                WAVE_LDS_SYNC();
                ucur = unext;
            }
            if (seq < 32) { float* o = p.out + OUT_S5 + ((size_t)((seq * 2 + d) * 2) * 128 + g) * 64 + lane; o[0] = sr; o[128 * 64] = sim; }
        }
    }
}
__device__ __forceinline__ void s5_post_phase(const Params& p, const bf16_t* Uu, bf16_t* Ydir) {
    const size_t nvec = (size_t)TOK * 2048 / 8;
    for (size_t v = (size_t)blockIdx.x * NT + threadIdx.x; v < nvec; v += (size_t)gridDim.x * NT) {
        const int col = (int)((v * 8) & 2047);
        float a[8], b[8], u[8];
        unpack8(*(const u32x4*)(Ydir + v * 8), a); unpack8(*(const u32x4*)(Ydir + (size_t)TOK * 2048 + v * 8), b); unpack8(*(const u32x4*)(Uu + v * 8), u);
        const f32x4 d0 = *(const f32x4*)(p.in[33] + col), d1 = *(const f32x4*)(p.in[33] + col + 4);
#pragma unroll
        for (int i = 0; i < 4; ++i) { a[i] = geluf(a[i] + b[i] + d0[i] * u[i]); a[4 + i] = geluf(a[4 + i] + b[4 + i] + d1[i] * u[4 + i]); }
        *(u32x4*)(Ydir + v * 8) = pack8(a);
    }
}

struct AttnState { float m, l; f32x4 o[4]; };
template <bool WIN, int KSTRIDE>
__device__ __forceinline__ void attend128(AttnState& st, const bf16x8 (&qf)[2], const bf16_t* Kt, const bf16_t* Vt, int krow0,
                                          bf16_t* Pbuf, int lane, const float* rpbh, int qc, int kcol0, int idxr0) {
    f32x4 s[8];
    {
        const int row = krow0 + (lane & 15), ksw = (row >> 1) & 7;
        const bf16_t* k0p = Kt + row * 64 + ((((lane >> 4)) ^ ksw) << 3);
        const bf16_t* k1p = Kt + row * 64 + (((4 + (lane >> 4)) ^ ksw) << 3);
#pragma unroll
        for (int kt = 0; kt < 8; ++kt) {
            const int ro = ((kt >> 1) * KSTRIDE + (kt & 1) * 16) * 64;
            s[kt] = mfma16(*(const bf16x8*)(k0p + ro), qf[0], (f32x4){0.f, 0.f, 0.f, 0.f});
            s[kt] = mfma16(*(const bf16x8*)(k1p + ro), qf[1], s[kt]);
        }
    }
    if (WIN) {
        const int cs = min(max(qc - 8, 0), 48);
#pragma unroll
        for (int kt = 0; kt < 8; ++kt) {
            const int ir = idxr0 + (kt >> 1);
#pragma unroll
            for (int r = 0; r < 4; ++r) { const int kc = kcol0 + (kt & 1) * 16 + (lane >> 4) * 4 + r;
                const bool ok = (kc >= cs) && (kc < cs + 16);
                const int ic = min(max(kc - qc + 15, 0), 30);
                s[kt][r] = ok ? s[kt][r] + rpbh[ir * 31 + ic] : -1e30f; }
        }
    }
    float mx = st.m;
#pragma unroll
    for (int kt = 0; kt < 8; ++kt) mx = fmaxf(mx, fmaxf(fmaxf(s[kt][0], s[kt][1]), fmaxf(s[kt][2], s[kt][3])));
    mx = fmaxf(mx, __shfl_xor(mx, 16)); mx = fmaxf(mx, __shfl_xor(mx, 32));
    const float alpha = __expf(st.m - mx);
    st.m = mx; st.l *= alpha;
#pragma unroll
    for (int a = 0; a < 4; ++a) st.o[a] = st.o[a] * alpha;
    const int vrow = krow0 + 8 * (lane >> 4) + ((lane >> 2) & 3);
    const int vs0 = (vrow >> 1) & 7, vs1 = ((vrow + 4) >> 1) & 7, c1 = (lane & 3) >> 1, cin = 4 * (lane & 1);
    const bf16_t* vb0 = Vt + vrow * 64 + cin;
    const bf16_t* vb1 = Vt + (vrow + 4) * 64 + cin;
    bf16_t* pw = Pbuf + (lane & 15) * 40 + (lane >> 4) * 4;
    const bf16_t* pr = Pbuf + (lane & 15) * 40 + 8 * (lane >> 4);
#pragma unroll
    for (int kk = 0; kk < 4; ++kk) {
        float ps = 0.f;
#pragma unroll
        for (int e = 0; e < 2; ++e) { f32x4 pv;
#pragma unroll
            for (int r = 0; r < 4; ++r) { pv[r] = __expf(s[2 * kk + e][r] - mx); ps += pv[r]; }
            *(u32x2*)(pw + e * 16) = pack4(pv); }
        st.l += ps;
        WAVE_LDS_SYNC();
        const bf16x8 pf = *(const bf16x8*)pr;
#pragma unroll
        for (int a = 0; a < 4; ++a) {
            const s16x4 lo = __builtin_amdgcn_ds_read_tr16_b64_v4i16((LAS s16x4*)(vb0 + kk * KSTRIDE * 64 + (((2 * a + c1) ^ vs0) << 3)));
            const s16x4 hi = __builtin_amdgcn_ds_read_tr16_b64_v4i16((LAS s16x4*)(vb1 + kk * KSTRIDE * 64 + (((2 * a + c1) ^ vs1) << 3)));
            bf16x8 vf; vf[0] = lo[0]; vf[1] = lo[1]; vf[2] = lo[2]; vf[3] = lo[3]; vf[4] = hi[0]; vf[5] = hi[1]; vf[6] = hi[2]; vf[7] = hi[3];
            st.o[a] = mfma16(vf, pf, st.o[a]);
        }
        WAVE_LDS_SYNC();
    }
}

__device__ __forceinline__ void attn_phase(const Params& p, bf16_t* Q, const bf16_t* Z, const bf16_t* Kl, const bf16_t* Vl, char* smem) {
    const int tid = threadIdx.x, lane = tid & 63, wid = tid >> 6;
    bf16_t* Kt = (bf16_t*)smem;
    bf16_t* Vt = Kt + 512 * 64;
    bf16_t* Pbuf = Vt + 512 * 64 + wid * 640;
    float* rpbs = (float*)(smem + 131072 + 10240);
    float* mrg = (float*)smem;
    const float* ck = p.out + OUT_CK; const float* cv = p.out + OUT_CV;
    for (int item = blockIdx.x; item < 4096; item += gridDim.x) {
        __syncthreads();
        if (item < 2048) {
            const int b = item >> 6, h = (item >> 1) & 31, qh = item & 1;
            const float* ksrc = ck + ((size_t)(b * 32 + h)) * 256 * 64; const float* vsrc = cv + ((size_t)(b * 32 + h)) * 256 * 64;
#pragma unroll
            for (int j = 0; j < 8; ++j) { const int q = tid + NT * j, key = q >> 4, c4 = q & 15;
                *(u32x2*)(Kt + sw64(key, c4 * 4)) = pack4(*(const f32x4*)(ksrc + key * 64 + c4 * 4));
                *(u32x2*)(Vt + sw64(key, c4 * 4)) = pack4(*(const f32x4*)(vsrc + key * 64 + c4 * 4)); }
            const size_t tq = (size_t)(b * 256 + qh * 128 + 16 * wid + (lane & 15));
            bf16x8 qf[2];
            qf[0] = *(const bf16x8*)(Q + tq * 2048 + h * 64 + 8 * (lane >> 4)); qf[1] = *(const bf16x8*)(Q + tq * 2048 + h * 64 + 32 + 8 * (lane >> 4));
            __syncthreads();
            AttnState st; st.m = -1e30f; st.l = 0.f;
#pragma unroll
            for (int a = 0; a < 4; ++a) st.o[a] = (f32x4){0.f, 0.f, 0.f, 0.f};
            attend128<false, 32>(st, qf, Kt, Vt, 0, Pbuf, lane, nullptr, 0, 0, 0);
            attend128<false, 32>(st, qf, Kt, Vt, 128, Pbuf, lane, nullptr, 0, 0, 0);
            float l = st.l; l += __shfl_xor(l, 16); l += __shfl_xor(l, 32);
            const float inv = 1.f / l;
#pragma unroll
            for (int a = 0; a < 4; ++a) { const int col = h * 64 + a * 16 + (lane >> 4) * 4;
                const f32x4 sz = unpack4(*(const u32x2*)(Z + tq * 2048 + col));
                *(u32x2*)(Q + tq * 2048 + col) = pack4(st.o[a] * inv * sz); }
        } else {
            const int it = item - 2048, b = it >> 10, h = (it >> 5) & 31, r = it & 31, rs = min(max(r - 4, 0), 24);
            const bf16_t* ksrc = Kl + ((size_t)(b * 2048 + rs * 64)) * 2048 + h * 64; const bf16_t* vsrc = Vl + ((size_t)(b * 2048 + rs * 64)) * 2048 + h * 64;
#pragma unroll
            for (int j = 0; j < 8; ++j) { const int q = tid + NT * j, key = q >> 3, c = q & 7;
                *(u32x4*)(Kt + sw64(key, c * 8)) = *(const u32x4*)(ksrc + (size_t)key * 2048 + c * 8);
                *(u32x4*)(Vt + sw64(key, c * 8)) = *(const u32x4*)(vsrc + (size_t)key * 2048 + c * 8); }
            if (tid < 465) rpbs[tid] = p.in[37][h * 465 + tid];
            const int qt = wid & 3, hf = wid >> 2;
            const int qc = 16 * qt + (lane & 15);
            const size_t tq = (size_t)(TOKC + b * 2048 + r * 64 + qc);
            bf16x8 qf[2];
            qf[0] = *(const bf16x8*)(Q + tq * 2048 + h * 64 + 8 * (lane >> 4)); qf[1] = *(const bf16x8*)(Q + tq * 2048 + h * 64 + 32 + 8 * (lane >> 4));
            const int off = qt == 0 ? 0 : (qt == 1 ? 8 : (qt == 2 ? 24 : 32));
            __syncthreads();
            AttnState st; st.m = -1e30f; st.l = 0.f;
#pragma unroll
            for (int a = 0; a < 4; ++a) st.o[a] = (f32x4){0.f, 0.f, 0.f, 0.f};
            attend128<true, 64>(st, qf, Kt, Vt, hf * 256 + off, Pbuf, lane, rpbs, qc, off, rs + 4 * hf - r + 7);
            __syncthreads();
            const float* k2 = p.in[4] + ((size_t)(b * 32 + h)) * 256 * 64; const float* v2 = p.in[5] + ((size_t)(b * 32 + h)) * 256 * 64;
#pragma unroll
            for (int j = 0; j < 8; ++j) { const int q = tid + NT * j, key = q >> 4, c4 = q & 15;
                *(u32x2*)(Kt + sw64(key, c4 * 4)) = pack4(*(const f32x4*)(k2 + key * 64 + c4 * 4));
                *(u32x2*)(Vt + sw64(key, c4 * 4)) = pack4(*(const f32x4*)(v2 + key * 64 + c4 * 4)); }
            __syncthreads();
            attend128<false, 32>(st, qf, Kt, Vt, hf * 128, Pbuf, lane, nullptr, 0, 0, 0);
            float l = st.l; l += __shfl_xor(l, 16); l += __shfl_xor(l, 32);
            __syncthreads();
            if (hf == 1) { float* mp = mrg + qt * 18 * 64 + lane; mp[0] = st.m; mp[64] = l;
#pragma unroll
                for (int a = 0; a < 4; ++a)
#pragma unroll
                    for (int i = 0; i < 4; ++i) mp[(2 + a * 4 + i) * 64] = st.o[a][i]; }
            __syncthreads();
            if (hf == 0) { const float* mp = mrg + qt * 18 * 64 + lane; const float m2 = mp[0], l2 = mp[64];
                const float mm = fmaxf(st.m, m2), e1 = __expf(st.m - mm), e2 = __expf(m2 - mm);
                const float inv = 1.f / (l * e1 + l2 * e2);
#pragma unroll
                for (int a = 0; a < 4; ++a) { f32x4 o2;
#pragma unroll
                    for (int i = 0; i < 4; ++i) o2[i] = mp[(2 + a * 4 + i) * 64];
                    const int col = h * 64 + a * 16 + (lane >> 4) * 4;
                    const f32x4 sz = unpack4(*(const u32x2*)(Z + tq * 2048 + col));
                    *(u32x2*)(Q + tq * 2048 + col) = pack4((st.o[a] * e1 + o2 * e2) * inv * sz); }
            }
        }
    }
}


#define XB_TMO      128
#define XB_XCNT(j)  (256  + 64 * (j))
#define XB_XSUB(j)  (1280 + 64 * (j))
#define XB_XGEN(j)  (2304 + 64 * (j))
#define XB_TOP      3328
#define XB_TOPGEN   3392
#define XCD_BAR_WORDS 3456
#define XB_SPIN_CAP (1u << 22)
__device__ __forceinline__ unsigned xb_ld(unsigned* p)              { return __hip_atomic_load(p, __ATOMIC_RELAXED, __HIP_MEMORY_SCOPE_AGENT); }
__device__ __forceinline__ unsigned xb_add(unsigned* p, unsigned v) { return __hip_atomic_fetch_add(p, v, __ATOMIC_RELAXED, __HIP_MEMORY_SCOPE_AGENT); }
__device__ __forceinline__ unsigned xb_xcc_id() { return (unsigned)__builtin_amdgcn_s_getreg((3 << 11) | 20) & 0xFu; }
#define XB_SPIN(cond, bar) do { unsigned _sp = 0; while (cond) { __builtin_amdgcn_s_sleep(1); \
    if ((++_sp & 255u) == 0u) { if (xb_ld(&(bar)[XB_TMO])) break; if (_sp > XB_SPIN_CAP) { atomicAdd(&(bar)[XB_TMO], 1u); break; } } } } while (0)
struct XcdBarrier { unsigned* bar; unsigned x; volatile LAS unsigned* st; };
__device__ __forceinline__ XcdBarrier xcd_barrier_post(unsigned* bar, volatile LAS unsigned* st) {
    XcdBarrier b; b.bar = bar; b.x = xb_xcc_id(); b.st = st;
    if (threadIdx.x == 0) (void)xb_add(&bar[XB_XCNT(b.x)], 1u);
    return b;
}
__device__ __forceinline__ void xcd_barrier_complete(unsigned* bar, unsigned x, unsigned& nloc, unsigned& nx) {
    const unsigned G = gridDim.x * gridDim.y * gridDim.z;
    unsigned sum, cnt, mine, sp = 0u;
    for (;;) {
        sum = 0u; cnt = 0u; mine = 0u;
#pragma unroll
        for (unsigned j = 0; j < 16; ++j) { const unsigned c = xb_ld(&bar[XB_XCNT(j)]); sum += c; cnt += (c > 0u) ? 1u : 0u; mine = (j == x) ? c : mine; }
        if (sum == G) break;
        __builtin_amdgcn_s_sleep(1);
        if ((++sp & 255u) == 0u) { if (xb_ld(&bar[XB_TMO])) break; if (sp > XB_SPIN_CAP) { atomicAdd(&bar[XB_TMO], 1u); break; } }
    }
    nloc = mine > 0u ? mine : 1u; nx = cnt > 0u ? cnt : 1u;
}
__device__ __forceinline__ void xcd_barrier(const XcdBarrier& b) {
    asm volatile("s_waitcnt vmcnt(0)" ::: "memory");
    __syncthreads();
    if (threadIdx.x == 0) {
        unsigned* bar = b.bar;
        __builtin_amdgcn_s_waitcnt(0);
        unsigned nloc = b.st[0], nx = b.st[1];
        if (nloc == 0u) { xcd_barrier_complete(bar, b.x, nloc, nx); b.st[0] = nloc; b.st[1] = nx; }
        const unsigned old = xb_add(&bar[XB_XSUB(b.x)], 1u);
        const unsigned gen = old / nloc;
        if (old + 1u == (gen + 1u) * nloc) {
            __builtin_amdgcn_fence(__ATOMIC_RELEASE, "agent");
            asm volatile("s_waitcnt vmcnt(0)" ::: "memory");
            const unsigned og = xb_add(&bar[XB_TOP], 1u);
            const unsigned tg = og / nx;
            if (og + 1u == (tg + 1u) * nx) xb_add(&bar[XB_TOPGEN], 1u);
            else XB_SPIN(xb_ld(&bar[XB_TOPGEN]) == tg, bar);
            __builtin_amdgcn_fence(__ATOMIC_ACQUIRE, "agent");
            xb_add(&bar[XB_XGEN(b.x)], 1u);
            asm volatile("s_waitcnt vmcnt(0)" ::: "memory");
        } else {
            XB_SPIN(xb_ld(&bar[XB_XGEN(b.x)]) == gen, bar);
            __builtin_amdgcn_fence(__ATOMIC_ACQUIRE, "agent");
            asm volatile("s_waitcnt vmcnt(0)" ::: "memory");
        }
    }
    __syncthreads();
}

__global__ void __launch_bounds__(NT) fwd_megakernel(Params p) {
    extern __shared__ __attribute__((aligned(16))) char smem[];
    cg::grid_group grid = cg::this_grid();
    char* ws = p.ws;
    bf16_t* H = (bf16_t*)(ws + WS_H);
    float* MOD = (float*)(ws + WS_MOD);
    bf16_t* U = (bf16_t*)(ws + WS_U);
    bf16_t* SCR = (bf16_t*)(p.out + OUT_CK);
    const bf16_t* WtOut = (const bf16_t*)(ws + WS_WT_OUT);
    volatile LAS unsigned* xbst = (volatile LAS unsigned*)(smem + LDS_BYTES - 16);
    if (threadIdx.x == 0) { xbst[0] = 0u; xbst[1] = 0u; xbst[2] = 0u; xbst[3] = 0u; }
    __syncthreads();
    const XcdBarrier xbar = xcd_barrier_post((unsigned*)(ws + WS_BAR), xbst);
    if (p.pad == 0x5eed) grid.sync();
#define GSYNC() xcd_barrier(xbar)
    prep_phase(p, smem);
    GSYNC();
    norm_phase(p, 0);
    GSYNC();
    {
        bf16_t* Uz = U; bf16_t* Uxbc = U + (size_t)TOK * 2048; bf16_t* SB = Uxbc; bf16_t* XBC = SCR;
        { EpiSSD e{Uz, Uxbc, (float*)(ws + WS_DT), p.in[16]}; gemm_phase<4>(H, 1024, (const bf16_t*)(ws + WS_WT_SSD), TOK, 6272, 1024, e, smem); }
        GSYNC();
        ssd_conv_phase(p, Uxbc, XBC);
        GSYNC();
        ssd_state_phase(p, XBC, SB, smem);
        GSYNC();
        ssd_scan_phase(p, SB);
        GSYNC();
        ssd_out_phase(p, XBC, SB, Uz, smem);
        GSYNC();
        { EpiOut e{p.in[0], p.in[1], p.out, MOD + 0 * 3 * 3072, (const float*)(ws + WS_SSQ), 1}; gemm_phase<2>(Uz, 2048, WtOut, TOK, 1024, 2048, e, smem); }
        GSYNC();
    }
    norm_phase(p, 1);
    GSYNC();
    {
        { EpiMLP e{U}; gemm_phase<4>(H, 1024, (const bf16_t*)(ws + WS_WT_MLP), TOK, 6144, 1024, e, smem); }
        GSYNC();
        mlp_stats_phase(p, U);
        GSYNC();
        mlp_mix_phase(p, U, smem);
        GSYNC();
        { EpiOut e{p.in[0], p.in[1], p.out, MOD + 1 * 3 * 3072, nullptr, 0}; gemm_phase<2>(U, 6144, WtOut + (size_t)1 * 1024 * 2048, TOK, 1024, 2048, e, smem); }
        GSYNC();
    }
    norm_phase(p, 2);
    GSYNC();
    {
        bf16_t* Uu = U; bf16_t* Uz = U + (size_t)TOK * 2048; bf16_t* Ydir = SCR;
        { EpiS5 e{Uu, Uz}; gemm_phase<4>(H, 1024, (const bf16_t*)(ws + WS_WT_S5), TOK, 4096, 1024, e, smem); }
        GSYNC();
        s5_scan_phase(p, Uu, Ydir, smem);
        GSYNC();
        s5_post_phase(p, Uu, Ydir);
        GSYNC();
        { EpiGLU e{Ydir, Uz, p.in[35]}; gemm_phase<4>(Ydir, 2048, (const bf16_t*)(ws + WS_WT_GLU), TOK, 2048, 2048, e, smem); }
        GSYNC();
        { EpiOut e{p.in[0], p.in[1], p.out, MOD + 2 * 3 * 3072, nullptr, 0}; gemm_phase<2>(Uz, 2048, WtOut + (size_t)2 * 1024 * 2048, TOK, 1024, 2048, e, smem); }
        GSYNC();
    }
    norm_phase(p, 3);
    GSYNC();
    {
        bf16_t* Q = U; bf16_t* Z = U + (size_t)TOK * 2048; bf16_t* Kl = U + (size_t)TOK * 4096; bf16_t* Vl = Kl + (size_t)4096 * 2048;
        { EpiNAT e{Q, Z, Kl, Vl, p.out + OUT_CK, p.out + OUT_CV}; gemm_phase<4>(H, 1024, (const bf16_t*)(ws + WS_WT_NAT), TOK, 8192, 1024, e, smem); }
        GSYNC();
        attn_phase(p, Q, Z, Kl, Vl, smem);
        GSYNC();
        { EpiOut e{p.in[0], p.in[1], p.out, MOD + 3 * 3 * 3072, nullptr, 0}; gemm_phase<2>(Q, 2048, WtOut + (size_t)3 * 1024 * 2048, TOK, 1024, 2048, e, smem); }
        GSYNC();
    }
    final_phase(p);
}

extern "C" void kernel_launch(void* const* d_in, const int* in_sizes, int n_in, void* d_out, int out_size, void* d_ws, size_t ws_size,
                              hipStream_t stream) {
    static int grid_blocks = 0;
    if (grid_blocks == 0) {
        int dev = 0, cus = 0, per_cu = 0;
        hipGetDevice(&dev);
        hipDeviceGetAttribute(&cus, hipDeviceAttributeMultiprocessorCount, dev);
        if (hipFuncSetAttribute((const void*)fwd_megakernel, hipFuncAttributeMaxDynamicSharedMemorySize, LDS_BYTES) != hipSuccess) { fprintf(stderr, "hipFuncSetAttribute failed\n"); }
        if (hipOccupancyMaxActiveBlocksPerMultiprocessor(&per_cu, (const void*)fwd_megakernel, NT, LDS_BYTES) != hipSuccess || per_cu < 1) { fprintf(stderr, "occupancy query failed (%d)\n", per_cu); per_cu = 1; }
        (void)hipGetLastError();
        grid_blocks = cus;
        if (ws_size < WS_END) { fprintf(stderr, "workspace too small: %zu < %zu\n", ws_size, (size_t)WS_END); grid_blocks = -1; }
        if (n_in != 38) { fprintf(stderr, "expected 38 inputs, got %d\n", n_in); grid_blocks = -1; }
    }
    if (grid_blocks < 0) return;
    Params p;
    memset(&p, 0, sizeof(p));
    for (int i = 0; i < 38; ++i) p.in[i] = (const float*)d_in[i];
    p.out = (float*)d_out; p.ws = (char*)d_ws;
    char* ws = (char*)d_ws;
    int t0 = 0;
    auto job = [&](int i, const float* src, size_t off, int K, int N, int Npad) {
        p.jobs[i].src = src; p.jobs[i].dst = (bf16_t*)(ws + off); p.jobs[i].K = K; p.jobs[i].N = N; p.jobs[i].Npad = Npad; p.jobs[i].tile0 = t0; t0 += (K / 64) * (Npad / 64);
    };
    job(0, p.in[13], WS_WT_SSD, 1024, 6208, 6272);
    job(1, p.in[20], WS_WT_MLP, 1024, 6144, 6144);
    job(2, p.in[25], WS_WT_S5, 1024, 4096, 4096);
    job(3, p.in[36], WS_WT_NAT, 1024, 8192, 8192);
    job(4, p.in[34], WS_WT_GLU, 2048, 2048, 2048);
    for (int l = 0; l < 4; ++l) job(5 + l, p.in[11] + (size_t)l * 2048 * 1024, WS_WT_OUT + (size_t)l * 1024 * 2048 * 2, 2048, 1024, 1024);
    p.total_tiles = t0;
    if (hipMemsetAsync(ws + WS_BAR, 0, XCD_BAR_WORDS * 4, stream) != hipSuccess) { fprintf(stderr, "memset of barrier words failed\n"); return; }
    void* args[] = {&p};
    hipError_t e = hipLaunchCooperativeKernel((const void*)fwd_megakernel, dim3(grid_blocks), dim3(NT), args, LDS_BYTES, stream);
    if (e != hipSuccess) fprintf(stderr, "cooperative launch failed: %s (grid %d)\n", hipGetErrorString(e), grid_blocks);
}
```

```cpp
#include <hip/hip_runtime.h>
#include <hip/hip_cooperative_groups.h>
#include <cstdio>
#include <cstdint>
#include <cstring>
namespace cg = cooperative_groups;

typedef unsigned short bf16_t;
typedef short bf16x8 __attribute__((ext_vector_type(8)));
typedef short s16x4 __attribute__((ext_vector_type(4)));
typedef float f32x4 __attribute__((ext_vector_type(4)));
typedef float f32x2 __attribute__((ext_vector_type(2)));
typedef unsigned u32x4 __attribute__((ext_vector_type(4)));
typedef unsigned u32x2 __attribute__((ext_vector_type(2)));
#define LAS __attribute__((address_space(3)))
#define WAVE_LDS_SYNC() do { asm volatile("s_waitcnt lgkmcnt(0)" ::: "memory"); __builtin_amdgcn_wave_barrier(); } while (0)

#define PROBE 0
constexpr int NT = 512;
constexpr int DM = 1024, EE = 2048;
constexpr int TOK = 12288, TOKC = 8192;
constexpr int NCHUNK = 96;
constexpr float EPSN = 1e-6f;
constexpr int LDS_BYTES = 147456;

constexpr size_t WS_WT_SSD = 0;
constexpr size_t WS_WT_MLP = WS_WT_SSD + (size_t)6400 * 1024 * 2;
constexpr size_t WS_WT_S5  = WS_WT_MLP + (size_t)6144 * 1024 * 2;
constexpr size_t WS_WT_NAT = WS_WT_S5 + (size_t)4096 * 1024 * 2;
constexpr size_t WS_WT_GLU = WS_WT_NAT + (size_t)8192 * 1024 * 2;
constexpr size_t WS_WT_OUT = WS_WT_GLU + (size_t)2048 * 2048 * 2;
constexpr size_t WS_H      = WS_WT_OUT + (size_t)4 * 1024 * 2048 * 2;
constexpr size_t WS_MOD    = WS_H + (size_t)TOK * 1024 * 2;
constexpr size_t WS_DT     = WS_MOD + 147456;
constexpr size_t WS_ACUM   = WS_DT + (size_t)TOK * 64 * 4;
constexpr size_t WS_SSQ    = WS_ACUM + (size_t)TOK * 64 * 4;
constexpr size_t WS_STATS  = WS_SSQ + (size_t)TOK * 32 * 4;
constexpr size_t WS_BAR    = WS_STATS + (size_t)TOK * 8;
constexpr size_t WS_U      = WS_H + (size_t)TOK * 1024 * 2 + 8388608;
constexpr size_t WS_END    = WS_U + (size_t)TOK * 6144 * 2;
static_assert(WS_BAR + 16384 <= WS_U, "small region overflow");
static_assert(WS_END <= 268435456, "workspace over 256 MiB");

constexpr size_t OUT_SSD = (size_t)TOK * 1024;
constexpr size_t OUT_S5  = OUT_SSD + (size_t)32 * 2 * 32 * 64 * 128;
constexpr size_t OUT_CK  = OUT_S5 + (size_t)32 * 2 * 2 * 128 * 64;
constexpr size_t OUT_CV  = OUT_CK + (size_t)32 * 32 * 256 * 64;

struct TJob { const float* src; bf16_t* dst; int K, N, Npad, tile0; };
struct Params {
    const float* in[38];
    float* out;
    char* ws;
    TJob jobs[9];
    int total_tiles, pad;
};

__device__ __forceinline__ float bf2f(unsigned h) { return __uint_as_float(h << 16); }
__device__ __forceinline__ float bflo(unsigned u) { return __uint_as_float(u << 16); }
__device__ __forceinline__ float bfhi(unsigned u) { return __uint_as_float(u & 0xffff0000u); }
__device__ __forceinline__ unsigned f2bf(float f) { unsigned u = __float_as_uint(f); u += 0x7fffu + ((u >> 16) & 1u); return u >> 16; }
__device__ __forceinline__ unsigned pack2(float a, float b) { return f2bf(a) | (f2bf(b) << 16); }
__device__ __forceinline__ u32x2 pack4(f32x4 v) { u32x2 r; r.x = pack2(v[0], v[1]); r.y = pack2(v[2], v[3]); return r; }
__device__ __forceinline__ f32x4 unpack4(u32x2 u) { f32x4 r; r[0] = bflo(u.x); r[1] = bfhi(u.x); r[2] = bflo(u.y); r[3] = bfhi(u.y); return r; }
__device__ __forceinline__ void unpack8(u32x4 u, float* f) {
    f[0] = bflo(u.x); f[1] = bfhi(u.x); f[2] = bflo(u.y); f[3] = bfhi(u.y); f[4] = bflo(u.z); f[5] = bfhi(u.z); f[6] = bflo(u.w); f[7] = bfhi(u.w);
}
__device__ __forceinline__ u32x4 pack8(const float* f) { u32x4 r; r.x = pack2(f[0], f[1]); r.y = pack2(f[2], f[3]); r.z = pack2(f[4], f[5]); r.w = pack2(f[6], f[7]); return r; }
__device__ __forceinline__ float siluf(float x) { return x / (1.f + __expf(-x)); }
__device__ __forceinline__ float sigmf(float x) { return 1.f / (1.f + __expf(-x)); }
__device__ __forceinline__ float geluf(float x) {
    const float y = 0.7978845608028654f * (x + 0.044715f * x * x * x);
    const float t = 1.f - 2.f / (__expf(2.f * y) + 1.f);
    return 0.5f * x * (1.f + t);
}
__device__ __forceinline__ float softplusf(float x) { return x > 20.f ? x : log1pf(__expf(x)); }
__device__ __forceinline__ float wave_sum(float v) {
#pragma unroll
    for (int o = 32; o > 0; o >>= 1) v += __shfl_xor(v, o);
    return v;
}
__device__ __forceinline__ int cond_idx(int t) { return t < TOKC ? 0 : 1 + ((t - TOKC) >> 11); }
__device__ __forceinline__ f32x4 mfma16(bf16x8 a, bf16x8 b, f32x4 c) { return __builtin_amdgcn_mfma_f32_16x16x32_bf16(a, b, c, 0, 0, 0); }
__device__ __forceinline__ bf16x8 as_frag(u32x4 u) { union { u32x4 a; bf16x8 b; } x; x.a = u; return x.b; }

__device__ __forceinline__ bf16x8 frag_rm(const bf16_t* tile, int stride, int row0, int k0, int lane) {
    return *(const bf16x8*)(tile + (row0 + (lane & 15)) * stride + k0 + 8 * (lane >> 4));
}
__device__ __forceinline__ bf16x8 frag_tr(const bf16_t* tile, int stride, int k0, int c0, int lane) {
    const bf16_t* p = tile + (k0 + 8 * (lane >> 4) + ((lane >> 2) & 3)) * stride + c0 + 4 * (lane & 3);
    s16x4 lo = __builtin_amdgcn_ds_read_tr16_b64_v4i16((LAS s16x4*)p);
    s16x4 hi = __builtin_amdgcn_ds_read_tr16_b64_v4i16((LAS s16x4*)(p + 4 * stride));
    bf16x8 r; r[0] = lo[0]; r[1] = lo[1]; r[2] = lo[2]; r[3] = lo[3]; r[4] = hi[0]; r[5] = hi[1]; r[6] = hi[2]; r[7] = hi[3];
    return r;
}
__device__ __forceinline__ int sw64(int row, int col) { return row * 64 + ((((col >> 3) ^ (row >> 1)) & 7) << 3) + (col & 7); }
__device__ __forceinline__ bf16x8 frag_rm_sw(const bf16_t* tile, int row0, int k0, int lane) {
    const int row = row0 + (lane & 15);
    return *(const bf16x8*)(tile + sw64(row, k0 + 8 * (lane >> 4)));
}
__device__ __forceinline__ bf16x8 frag_tr_sw(const bf16_t* tile, int k0, int c0, int lane) {
    const int row = k0 + 8 * (lane >> 4) + ((lane >> 2) & 3), col = c0 + 4 * (lane & 3);
    s16x4 lo = __builtin_amdgcn_ds_read_tr16_b64_v4i16((LAS s16x4*)(tile + sw64(row, col)));
    s16x4 hi = __builtin_amdgcn_ds_read_tr16_b64_v4i16((LAS s16x4*)(tile + sw64(row + 4, col)));
    bf16x8 r; r[0] = lo[0]; r[1] = lo[1]; r[2] = lo[2]; r[3] = lo[3]; r[4] = hi[0]; r[5] = hi[1]; r[6] = hi[2]; r[7] = hi[3];
    return r;
}


namespace pg8 {
#define PG8_LAS __attribute__((address_space(3)))
constexpr int BM = 256, BK = 64, HALF = 128, HTB = HALF * BK * 2  , STAGE_BYTES = 8 * HTB, NXCD = 8, WGM = 8;

__host__ __device__ __forceinline__ int lds_byte(int r, int c) { const int st = (r >> 4) * 2 + (c >> 5), rr = r & 15, cc = c & 31, ob = rr * 64 + cc * 2; return st * 1024 + (ob ^ (((ob >> 9) & 1) << 5)); }
__host__ __device__ __forceinline__ void stage_rc(int b, int& R, int& C) { const int st = b / 1024, sb = b % 1024, swz = sb ^ (((sb >> 9) & 1) << 5); R = (st >> 1) * 16 + swz / 64; C = (st & 1) * 32 + (swz % 64) / 2; }
__host__ __device__ __forceinline__ int perm32(int rho) { const int n = rho >> 4, i = rho & 15; return 8 * (i >> 2) + 4 * n + (i & 3); }
struct Unit { int pm, pn; };
struct Gemm { const bf16_t* A; const bf16_t* Bt; int M, N, K, lda; };
struct StaticOrder {
    int nM, nN, nwg, G, c;
    __host__ __device__ void init(int M, int N, int G_, int c_) { nM = M / BM; nN = N / BM; nwg = nM * nN; G = G_; c = c_; }
    __host__ __device__ bool next(int i, Unit& u) const {
        const long L = (long)i * G + c; if (L >= nwg) return false;
        int wgid = (int)L; { const int q = nwg / NXCD, r = nwg % NXCD, xcd = wgid % NXCD, off = wgid / NXCD; wgid = (xcd < r ? xcd * (q + 1) : r * (q + 1) + (xcd - r) * q) + off; }
        const int nig = WGM * nN, gid = wgid / nig, fm = gid * WGM, gsz = (nM - fm) < WGM ? (nM - fm) : WGM;
        u.pm = fm + ((wgid % nig) % gsz); u.pn = (wgid % nig) / gsz; return true;
    }
    __device__ __forceinline__ void a_ready(const Unit&) const {}
    __device__ __forceinline__ void done(const Unit&) const {}
};
template <class Epi, class Sched, bool ALIGN_EPI = false, bool SP2 = false>
__device__ __forceinline__ void gemm_phase(PG8_LAS unsigned char* lds, const Gemm g, const Sched& S, const Epi& E) {
    int tid_ = threadIdx.x; asm volatile("" : "+v"(tid_));
    const int tid = tid_, wid = __builtin_amdgcn_readfirstlane(tid >> 6), lane = tid & 63, wr = wid >> 2, wc = wid & 3, fr = lane & 15, fq = lane >> 4;
    const int K = g.K, nt = K / BK;
    unsigned voffA[2], voffB[2];
#pragma unroll
    for (int i = 0; i < 2; ++i) { int R, C; stage_rc(tid * 16 + i * 8192, R, C); const int Rb = Epi::PERM ? ((R & ~31) + perm32(R & 31)) : R;
        voffA[i] = (unsigned)(R * g.lda + C) * 2u; voffB[i] = (unsigned)(Rb * K + C) * 2u; }
    const size_t kstep = (size_t)(BK * 2);
    const size_t hstep = (size_t)HALF * K * 2;
    const size_t tstep = 2 * hstep;
    const size_t hstepA = (size_t)HALF * g.lda * 2, tstepA = 2 * hstepA;
    const unsigned ldsw = (unsigned)wid * 1024u;
    const int aoff = lds_byte(wr * 64 + fr, fq * 8), boff = lds_byte(wc * 32 + fr, fq * 8);
#define PG8_SA(b, h) (((b) * 2 + (h)) * HTB)
#define PG8_SB(b, h) ((4 + (b) * 2 + (h)) * HTB)
#define PG8_STAGE(bufoff, gbase, voff) do { _Pragma("unroll") for (int _i = 0; _i < 2; ++_i) \
        __builtin_amdgcn_global_load_lds((const unsigned*)((const char*)(gbase) + (voff)[_i]), (PG8_LAS unsigned*)(lds + (bufoff) + ldsw + _i * 8192), 16, 0, 0); } while (0)
#define PG8_LDA(dst, b, h) do { _Pragma("unroll") for (int m = 0; m < 4; ++m) _Pragma("unroll") for (int k = 0; k < 2; ++k) dst[m][k] = *(const PG8_LAS bf16x8*)(lds + PG8_SA(b, h) + aoff + m * 2048 + k * 1024); } while (0)
#define PG8_LDB(dst, b, h) do { _Pragma("unroll") for (int n = 0; n < 2; ++n) _Pragma("unroll") for (int k = 0; k < 2; ++k) dst[n][k] = *(const PG8_LAS bf16x8*)(lds + PG8_SB(b, h) + boff + n * 2048 + k * 1024); } while (0)
#define PG8_MMA(ai, bj, At, Bt) do { __builtin_amdgcn_s_setprio(1); _Pragma("unroll") for (int m = 0; m < 4; ++m) _Pragma("unroll") for (int n = 0; n < 2; ++n) _Pragma("unroll") for (int k = 0; k < 2; ++k) \
        acc[ai][bj][m][n] = __builtin_amdgcn_mfma_f32_16x16x32_bf16(Bt[n][k], At[m][k], acc[ai][bj][m][n], 0, 0, 0); __builtin_amdgcn_s_setprio(0); } while (0)
#define PG8_WAIT_V(n) asm volatile("s_waitcnt vmcnt(" #n ")" ::: "memory")
#define PG8_WAIT_L(n) asm volatile("s_waitcnt lgkmcnt(" #n ")" ::: "memory")
#define PG8_BAR __builtin_amdgcn_s_barrier()
#define PG8_SCHED __builtin_amdgcn_sched_barrier(0)
    Unit cur, nxt; int ui = 0;
    if (!S.next(0, cur)) return;
    f32x4 acc[2][2][4][2];
#pragma unroll
    for (int a = 0; a < 2; ++a)
#pragma unroll
        for (int b = 0; b < 2; ++b)
#pragma unroll
            for (int m = 0; m < 4; ++m)
#pragma unroll
                for (int n = 0; n < 2; ++n) acc[a][b][m][n] = (f32x4){0.f, 0.f, 0.f, 0.f};
    bf16x8 At[4][2], B0[2][2], B1[2][2];
    const char* cA = (const char*)g.A + (size_t)cur.pm * tstepA; const char* cB = (const char*)g.Bt + (size_t)cur.pn * tstep;
    S.a_ready(cur);
    if constexpr (SP2) {
        PG8_STAGE(PG8_SB(0, 0), cB, voffB); PG8_STAGE(PG8_SB(0, 1), cB + hstep, voffB); PG8_STAGE(PG8_SA(0, 0), cA, voffA); PG8_STAGE(PG8_SA(0, 1), cA + hstepA, voffA);
        if (wr == 1) PG8_BAR;
        PG8_WAIT_V(2); PG8_BAR;
        PG8_STAGE(PG8_SB(1, 0), cB + kstep, voffB); PG8_STAGE(PG8_SA(1, 0), cA + kstep, voffA); PG8_STAGE(PG8_SB(1, 1), cB + hstep + kstep, voffB);
        PG8_WAIT_V(6); PG8_BAR;
    } else {
        PG8_STAGE(PG8_SB(0, 0), cB, voffB); PG8_STAGE(PG8_SA(0, 0), cA, voffA); PG8_STAGE(PG8_SB(0, 1), cB + hstep, voffB); PG8_STAGE(PG8_SA(0, 1), cA + hstepA, voffA);
        if (wr == 1) PG8_BAR;
        PG8_WAIT_V(4); PG8_BAR;
        PG8_STAGE(PG8_SB(1, 0), cB + kstep, voffB); PG8_STAGE(PG8_SA(1, 0), cA + kstep, voffA); PG8_STAGE(PG8_SB(1, 1), cB + hstep + kstep, voffB);
        PG8_WAIT_V(6); PG8_BAR;
    }
    for (;;) {
        const bool has_next = S.next(ui + 1, nxt);
        const char* nA = has_next ? (const char*)g.A + (size_t)nxt.pm * tstepA : cA; const char* nB = has_next ? (const char*)g.Bt + (size_t)nxt.pn * tstep : cB;
        for (int t = 0; t < nt; t += 2) {
            const bool last = (t == nt - 2);
            const char* a1 = cA + (size_t)(t + 1) * kstep;
            const char* a2 = last ? nA : cA + (size_t)(t + 2) * kstep; const char* b2 = last ? nB : cB + (size_t)(t + 2) * kstep;
            const char* a3 = a2 + kstep; const char* b3 = b2 + kstep;
            if (last && has_next) S.a_ready(nxt);
            if constexpr (SP2) {
            PG8_LDB(B0, 0, 0); PG8_LDB(B1, 0, 1); PG8_SCHED; PG8_LDA(At, 0, 0); PG8_STAGE(PG8_SA(1, 1), a1 + hstepA, voffA);
            PG8_WAIT_V(8); PG8_WAIT_L(0); PG8_BAR; PG8_MMA(0, 0, At, B0); PG8_MMA(0, 1, At, B1); PG8_BAR; PG8_SCHED;
            PG8_LDA(At, 0, 1); PG8_STAGE(PG8_SB(0, 0), b2, voffB); PG8_STAGE(PG8_SB(0, 1), b2 + hstep, voffB); PG8_STAGE(PG8_SA(0, 0), a2, voffA);
            PG8_WAIT_V(8); PG8_WAIT_L(0); PG8_BAR; PG8_MMA(1, 0, At, B0); PG8_MMA(1, 1, At, B1); PG8_BAR; PG8_SCHED;
            PG8_LDB(B0, 1, 0); PG8_LDB(B1, 1, 1); PG8_SCHED; PG8_LDA(At, 1, 0); PG8_STAGE(PG8_SA(0, 1), a2 + hstepA, voffA);
            PG8_WAIT_V(8); PG8_WAIT_L(0); PG8_BAR; PG8_MMA(0, 0, At, B0); PG8_MMA(0, 1, At, B1); PG8_BAR; PG8_SCHED;
            PG8_LDA(At, 1, 1); PG8_STAGE(PG8_SB(1, 0), b3, voffB); PG8_STAGE(PG8_SB(1, 1), b3 + hstep, voffB); PG8_STAGE(PG8_SA(1, 0), a3, voffA);
            PG8_WAIT_V(8); PG8_WAIT_L(0); PG8_BAR; PG8_MMA(1, 0, At, B0); PG8_MMA(1, 1, At, B1); PG8_BAR; PG8_SCHED;
            } else {
            PG8_LDB(B0, 0, 0); PG8_SCHED; PG8_LDA(At, 0, 0); PG8_STAGE(PG8_SA(1, 1), a1 + hstepA, voffA);
            PG8_WAIT_L(8); PG8_BAR; PG8_WAIT_L(0); PG8_MMA(0, 0, At, B0); PG8_BAR; PG8_SCHED;
            PG8_LDB(B1, 0, 1); PG8_STAGE(PG8_SB(0, 0), b2, voffB);
            PG8_BAR; PG8_WAIT_L(0); PG8_MMA(0, 1, At, B1); PG8_BAR;
            PG8_LDA(At, 0, 1); PG8_STAGE(PG8_SA(0, 0), a2, voffA);
            PG8_BAR; PG8_WAIT_L(0); PG8_MMA(1, 0, At, B0); PG8_BAR; PG8_SCHED;
            PG8_STAGE(PG8_SB(0, 1), b2 + hstep, voffB);
            PG8_WAIT_V(6); PG8_BAR; PG8_MMA(1, 1, At, B1); PG8_BAR;
            PG8_LDB(B0, 1, 0); PG8_SCHED; PG8_LDA(At, 1, 0); PG8_STAGE(PG8_SA(0, 1), a2 + hstepA, voffA);
            PG8_WAIT_L(8); PG8_BAR; PG8_WAIT_L(0); PG8_MMA(0, 0, At, B0); PG8_BAR; PG8_SCHED;
            PG8_LDB(B1, 1, 1); PG8_STAGE(PG8_SB(1, 0), b3, voffB);
            PG8_BAR; PG8_WAIT_L(0); PG8_MMA(0, 1, At, B1); PG8_BAR;
            PG8_LDA(At, 1, 1); PG8_STAGE(PG8_SA(1, 0), a3, voffA);
            PG8_BAR; PG8_WAIT_L(0); PG8_MMA(1, 0, At, B0); PG8_BAR; PG8_SCHED;
            PG8_STAGE(PG8_SB(1, 1), b3 + hstep, voffB);
            PG8_WAIT_V(6); PG8_BAR; PG8_MMA(1, 1, At, B1); PG8_BAR;
            }
        }
        if constexpr (ALIGN_EPI) { if (wr == 0) PG8_BAR; }
        if constexpr (!Epi::AFTER_DRAIN) { E(acc, cur, wr, wc, fr, fq); S.done(cur); }
        if (!has_next) break;
#pragma unroll
        for (int a = 0; a < 2; ++a)
#pragma unroll
            for (int b = 0; b < 2; ++b)
#pragma unroll
                for (int m = 0; m < 4; ++m)
#pragma unroll
                    for (int n = 0; n < 2; ++n) acc[a][b][m][n] = (f32x4){0.f, 0.f, 0.f, 0.f};
        cur = nxt; cA = nA; cB = nB; ++ui;
        if constexpr (ALIGN_EPI) { if (wr == 1) PG8_BAR; }
    }
    PG8_WAIT_V(0);
    if constexpr (!ALIGN_EPI) { if (wr == 0) PG8_BAR; }
    PG8_BAR;
    if constexpr (Epi::AFTER_DRAIN) { E.fused(acc, cur, wr, wc, fr, fq, lds, wid, lane); S.done(cur); }
#undef PG8_SA
#undef PG8_SB
#undef PG8_STAGE
#undef PG8_LDA
#undef PG8_LDB
#undef PG8_MMA
#undef PG8_WAIT_V
#undef PG8_WAIT_L
#undef PG8_BAR
#undef PG8_SCHED
}
}

template <class E> struct PgEpi {
    static constexpr bool PERM = false, AFTER_DRAIN = false;
    E e;
    __device__ __forceinline__ void operator()(const f32x4 (&acc)[2][2][4][2], const pg8::Unit& u, int wr, int wc, int fr, int fq) const {
#pragma unroll
        for (int ai = 0; ai < 2; ++ai)
#pragma unroll
            for (int m = 0; m < 4; ++m) {
                const int row = u.pm * 256 + ai * 128 + wr * 64 + m * 16 + fr;
                const float rs = e.rowscale(row);
#pragma unroll
                for (int bj = 0; bj < 2; ++bj)
#pragma unroll
                    for (int n = 0; n < 2; ++n) e(row, u.pn * 256 + bj * 128 + wc * 32 + n * 16 + fq * 4, acc[ai][bj][m][n], rs);
            }
    }
};
template <class E>
__device__ __forceinline__ void run_gemm(const bf16_t* A, int lda, const bf16_t* Bt, int N, int K, const E& e, char* smem) {
    pg8::Gemm g{A, Bt, TOK, N, K, lda};
    pg8::StaticOrder S; S.init(TOK, N, (int)gridDim.x, (int)blockIdx.x);
    PgEpi<E> pe{e};
    pg8::gemm_phase<PgEpi<E>, pg8::StaticOrder, true, true>((LAS unsigned char*)smem, g, S, pe);
}

struct EpiSSD {
    bf16_t* Uz; bf16_t* Uxbc; float* DT; const float* dt_bias;
    __device__ __forceinline__ float rowscale(int) const { return 1.f; }
    __device__ __forceinline__ void operator()(int row, int col, f32x4 v, float) const {
        if (col < 2048) { f32x4 s; for (int i = 0; i < 4; ++i) s[i] = siluf(v[i]); *(u32x2*)(Uz + (size_t)row * 2048 + col) = pack4(s); }
        else if (col < 6144) { *(u32x2*)(Uxbc + (size_t)row * 4096 + (col - 2048)) = pack4(v); }
        else if (col < 6208) { const int c = col - 6144; f32x4 s; for (int i = 0; i < 4; ++i) s[i] = softplusf(v[i] + dt_bias[c + i]); *(f32x4*)(DT + (size_t)row * 64 + c) = s; }
    }
};
struct EpiMLP {
    bf16_t* U;
    __device__ __forceinline__ float rowscale(int) const { return 1.f; }
    __device__ __forceinline__ void operator()(int row, int col, f32x4 v, float) const {
        f32x4 s;
        if (col < 4096) { for (int i = 0; i < 4; ++i) s[i] = geluf(v[i]); } else { for (int i = 0; i < 4; ++i) s[i] = siluf(v[i]); }
        *(u32x2*)(U + (size_t)row * 6144 + col) = pack4(s);
    }
};
struct EpiS5 {
    bf16_t* Uu; bf16_t* Uz;
    __device__ __forceinline__ float rowscale(int) const { return 1.f; }
    __device__ __forceinline__ void operator()(int row, int col, f32x4 v, float) const {
        if (col < 2048) *(u32x2*)(Uu + (size_t)row * 2048 + col) = pack4(v);
        else { f32x4 s; for (int i = 0; i < 4; ++i) s[i] = siluf(v[i]); *(u32x2*)(Uz + (size_t)row * 2048 + (col - 2048)) = pack4(s); }
    }
};
struct EpiNAT {
    bf16_t* Q; bf16_t* Z; bf16_t* Kl; bf16_t* Vl; float* ck; float* cv;
    __device__ __forceinline__ float rowscale(int) const { return 1.f; }
    __device__ __forceinline__ void operator()(int row, int col, f32x4 v, float) const {
        if (col < 2048) { *(u32x2*)(Q + (size_t)row * 2048 + col) = pack4(v * 0.125f); }
        else if (col < 6144) {
            const bool isv = col >= 4096; const int c = col - (isv ? 4096 : 2048);
            if (row < TOKC) { const int b = row >> 8, s = row & 255, h = c >> 6, d = c & 63; float* dst = (isv ? cv : ck) + ((size_t)((b * 32 + h) * 256 + s)) * 64 + d; *(f32x4*)dst = v; }
            else { bf16_t* dst = (isv ? Vl : Kl) + (size_t)(row - TOKC) * 2048 + c; *(u32x2*)dst = pack4(v); }
        } else { f32x4 s; for (int i = 0; i < 4; ++i) s[i] = siluf(v[i]); *(u32x2*)(Z + (size_t)row * 2048 + (col - 6144)) = pack4(s); }
    }
};
struct EpiOut {
    const float* xp; const float* xs; float* X; const float* modl; const float* ssq; int first;
    __device__ __forceinline__ float rowscale(int row) const {
        if (!ssq) return 1.f;
        const f32x4* p = (const f32x4*)(ssq + (size_t)row * 32); float s = 0.f;
#pragma unroll
        for (int i = 0; i < 8; ++i) { f32x4 v = p[i]; s += (v[0] + v[1]) + (v[2] + v[3]); }
        return rsqrtf(s * (1.f / 2048.f) + EPSN);
    }
    __device__ __forceinline__ void operator()(int row, int col, f32x4 v, float rs) const {
        const f32x4 g = *(const f32x4*)(modl + cond_idx(row) * 3072 + 2048 + col);
        const float* xin = first ? (row < TOKC ? xp + (size_t)row * 1024 : xs + (size_t)(row - TOKC) * 1024) : X + (size_t)row * 1024;
        const f32x4 x = *(const f32x4*)(xin + col);
        *(f32x4*)(X + (size_t)row * 1024 + col) = x + g * (v * rs);
    }
};
struct EpiGLU {
    const bf16_t* Yb; bf16_t* Uz; const float* bglu;
    __device__ __forceinline__ float rowscale(int) const { return 1.f; }
    __device__ __forceinline__ void operator()(int row, int col, f32x4 v, float) const {
        const f32x4 y = unpack4(*(const u32x2*)(Yb + (size_t)row * 2048 + col));
        const f32x4 z = unpack4(*(const u32x2*)(Uz + (size_t)row * 2048 + col));
        const f32x4 b = *(const f32x4*)(bglu + col);
        f32x4 o; for (int i = 0; i < 4; ++i) o[i] = y[i] * sigmf(v[i] + b[i]) * z[i];
        *(u32x2*)(Uz + (size_t)row * 2048 + col) = pack4(o);
    }
};

__device__ __forceinline__ void prep_phase(const Params& p, char* smem) {
    int tid_ = threadIdx.x; asm volatile("" : "+v"(tid_));
    const int tid = tid_, lane = tid & 63, wid = tid >> 6;
    float* tile = (float*)smem;
    for (int T = blockIdx.x; T < p.total_tiles; T += gridDim.x) {
        int j = 0;
#pragma unroll
        for (int q = 1; q < 9; ++q) if (T >= p.jobs[q].tile0) j = q;
        const float* src = p.jobs[j].src; bf16_t* dst = p.jobs[j].dst; const int K = p.jobs[j].K, N = p.jobs[j].N;
        const int local = T - p.jobs[j].tile0, nkt = K >> 6, kt = local % nkt, nt = local / nkt, k0 = kt * 64, n0 = nt * 64;
        __syncthreads();
        if (n0 < N) {
#pragma unroll
            for (int q = tid; q < 1024; q += NT) { const int r = q >> 4, c4 = q & 15; const f32x4 v = *(const f32x4*)(src + (size_t)(k0 + r) * N + n0 + c4 * 4);
                tile[r * 65 + c4 * 4 + 0] = v[0]; tile[r * 65 + c4 * 4 + 1] = v[1]; tile[r * 65 + c4 * 4 + 2] = v[2]; tile[r * 65 + c4 * 4 + 3] = v[3]; }
        }
        __syncthreads();
        {
            const int nn = tid >> 3, kc = tid & 7; float f[8];
#pragma unroll
            for (int i = 0; i < 8; ++i) f[i] = (n0 < N) ? tile[(kc * 8 + i) * 65 + nn] : 0.f;
            *(u32x4*)(dst + (size_t)(n0 + nn) * K + k0 + kc * 8) = pack8(f);
        }
    }
    __syncthreads();
    float* sc = (float*)smem;
    float* part = (float*)smem + 3072;
    for (int q = tid; q < 3072; q += NT) { const int ci = q >> 10, k = q & 1023; const float cv = ci == 0 ? p.in[7][k] : p.in[6][(ci - 1) * 1024 + k]; sc[q] = siluf(cv); }
    __syncthreads();
    float* MOD = (float*)(p.ws + WS_MOD);
    for (int it = blockIdx.x; it < 192; it += gridDim.x) {
        const int layer = it / 48, cg0 = (it % 48) * 64, col = cg0 + lane;
        const float* w = p.in[9] + (size_t)layer * 1024 * 3072 + col;
        float a0 = 0.f, a1 = 0.f, a2 = 0.f;
        for (int k = wid * 128; k < wid * 128 + 128; ++k) { const float wv = w[(size_t)k * 3072]; a0 += sc[k] * wv; a1 += sc[1024 + k] * wv; a2 += sc[2048 + k] * wv; }
        part[(wid * 3 + 0) * 64 + lane] = a0; part[(wid * 3 + 1) * 64 + lane] = a1; part[(wid * 3 + 2) * 64 + lane] = a2;
        __syncthreads();
        if (tid < 192) { const int ci = tid >> 6, l = tid & 63; float s = p.in[10][layer * 3072 + cg0 + l];
#pragma unroll
            for (int w8 = 0; w8 < 8; ++w8) s += part[(w8 * 3 + ci) * 64 + l];
            MOD[(layer * 3 + ci) * 3072 + cg0 + l] = s; }
        __syncthreads();
    }
}

__device__ __forceinline__ void norm_phase(const Params& p, int layer) {
    const int lane = threadIdx.x & 63, gw = blockIdx.x * 8 + (threadIdx.x >> 6), nw = gridDim.x * 8;
    const float* g = p.in[8] + layer * 1024;
    const float* MOD = (const float*)(p.ws + WS_MOD) + layer * 3 * 3072;
    bf16_t* H = (bf16_t*)(p.ws + WS_H);
    for (int t = gw; t < TOK; t += nw) {
        const float* xr = layer == 0 ? (t < TOKC ? p.in[0] + (size_t)t * 1024 : p.in[1] + (size_t)(t - TOKC) * 1024) : p.out + (size_t)t * 1024;
        f32x4 v[4]; float ss = 0.f;
#pragma unroll
        for (int j = 0; j < 4; ++j) { v[j] = *(const f32x4*)(xr + j * 256 + lane * 4); ss += v[j][0] * v[j][0] + v[j][1] * v[j][1] + v[j][2] * v[j][2] + v[j][3] * v[j][3]; }
        ss = wave_sum(ss);
        const float rstd = rsqrtf(ss * (1.f / 1024.f) + EPSN);
        const float* md = MOD + cond_idx(t) * 3072;
#pragma unroll
        for (int j = 0; j < 4; ++j) {
            const int c = j * 256 + lane * 4;
            const f32x4 gg = *(const f32x4*)(g + c), sh = *(const f32x4*)(md + c), scl = *(const f32x4*)(md + 1024 + c);
            f32x4 h; for (int i = 0; i < 4; ++i) h[i] = v[j][i] * rstd * gg[i] * (1.f + scl[i]) + sh[i];
            *(u32x2*)(H + (size_t)t * 1024 + c) = pack4(h);
        }
    }
}
__device__ __forceinline__ void final_phase(const Params& p) {
    const int lane = threadIdx.x & 63, gw = blockIdx.x * 8 + (threadIdx.x >> 6), nw = gridDim.x * 8;
    const float* g = p.in[12];
    for (int t = gw; t < TOK; t += nw) {
        float* xr = p.out + (size_t)t * 1024;
        f32x4 v[4]; float ss = 0.f;
#pragma unroll
        for (int j = 0; j < 4; ++j) { v[j] = *(const f32x4*)(xr + j * 256 + lane * 4); ss += v[j][0] * v[j][0] + v[j][1] * v[j][1] + v[j][2] * v[j][2] + v[j][3] * v[j][3]; }
        ss = wave_sum(ss);
        const float rstd = rsqrtf(ss * (1.f / 1024.f) + EPSN);
#pragma unroll
        for (int j = 0; j < 4; ++j) { const int c = j * 256 + lane * 4; const f32x4 gg = *(const f32x4*)(g + c); *(f32x4*)(xr + c) = v[j] * rstd * gg; }
    }
}


__device__ __forceinline__ void ssd_conv_phase(const Params& p, const bf16_t* Uxbc, bf16_t* XBC) {
    int tid_ = threadIdx.x; asm volatile("" : "+v"(tid_));
    const int tid = tid_, lane = tid & 63, wid = tid >> 6;
    const float* DT = (const float*)(p.ws + WS_DT);
    float* ACUM = (float*)(p.ws + WS_ACUM);
    for (int ch = blockIdx.x * 8 + wid; ch < NCHUNK; ch += gridDim.x * 8) {
        const int t0 = ch * 128, d = lane >> 5;
        const float a = -__expf(p.in[17][lane]);
        float acc = 0.f;
        for (int i = 0; i < 128; ++i) { const int l = d ? 127 - i : i; acc += DT[(size_t)(t0 + l) * 64 + lane] * a; ACUM[(size_t)(t0 + l) * 64 + lane] = acc; }
    }
    const int chn = tid * 8;
    float w[5][8], bias[8];
#pragma unroll
    for (int j = 0; j < 5; ++j) { const f32x4 a = *(const f32x4*)(p.in[14] + j * 4096 + chn), b = *(const f32x4*)(p.in[14] + j * 4096 + chn + 4);
        w[j][0] = a[0]; w[j][1] = a[1]; w[j][2] = a[2]; w[j][3] = a[3]; w[j][4] = b[0]; w[j][5] = b[1]; w[j][6] = b[2]; w[j][7] = b[3]; }
    { const f32x4 a = *(const f32x4*)(p.in[15] + chn), b = *(const f32x4*)(p.in[15] + chn + 4);
      bias[0] = a[0]; bias[1] = a[1]; bias[2] = a[2]; bias[3] = a[3]; bias[4] = b[0]; bias[5] = b[1]; bias[6] = b[2]; bias[7] = b[3]; }
    const int rpb = (TOK + gridDim.x - 1) / gridDim.x;
    const int r0 = blockIdx.x * rpb, r1 = min(TOK, r0 + rpb);
    for (int t = r0; t < r1; ++t) {
        int s0, s1;
        if (t < TOKC) { s0 = t & ~255; s1 = s0 + 256; } else { s0 = TOKC + ((t - TOKC) & ~2047); s1 = s0 + 2048; }
        float acc[8];
#pragma unroll
        for (int i = 0; i < 8; ++i) acc[i] = bias[i];
#pragma unroll
        for (int j = 0; j < 5; ++j) {
            const int tt = t + j - 2;
            if (tt >= s0 && tt < s1) {
                float f[8]; unpack8(*(const u32x4*)(Uxbc + (size_t)tt * 4096 + chn), f);
#pragma unroll
                for (int i = 0; i < 8; ++i) acc[i] += w[j][i] * f[i];
            }
        }
#pragma unroll
        for (int i = 0; i < 8; ++i) acc[i] = siluf(acc[i]);
        *(u32x4*)(XBC + (size_t)t * 4096 + chn) = pack8(acc);
    }
}

__device__ __forceinline__ void ssd_state_phase(const Params& p, const bf16_t* XBC, bf16_t* SB, char* smem) {
    int tid_ = threadIdx.x; asm volatile("" : "+v"(tid_));
    const int tid = tid_, lane = tid & 63, wid = tid >> 6;
    const float* DT = (const float*)(p.ws + WS_DT);
    const float* ACUM = (const float*)(p.ws + WS_ACUM);
    bf16_t* Bt = (bf16_t*)smem;
    bf16_t* Xf = Bt + 128 * 136;
    bf16_t* Xb = Xf + 128 * 72;
    for (int item = blockIdx.x; item < NCHUNK * 8; item += gridDim.x) {
        const int ch = item >> 3, g = item & 7, t0 = ch * 128;
        __syncthreads();
#pragma unroll
        for (int j = 0; j < 4; ++j) { const int q = tid + NT * j, row = q >> 4, c = q & 15;
            *(u32x4*)(Bt + row * 136 + c * 8) = *(const u32x4*)(XBC + (size_t)(t0 + row) * 4096 + 2048 + g * 128 + c * 8); }
        for (int hh = 0; hh < 4; ++hh) {
            const int h = g * 4 + hh;
            __syncthreads();
            const float af_last = ACUM[(size_t)(t0 + 127) * 64 + h], sb_first = ACUM[(size_t)t0 * 64 + 32 + h];
#pragma unroll
            for (int j = 0; j < 2; ++j) { const int q = tid + NT * j, row = q >> 3, c = q & 7; const size_t tr = (size_t)(t0 + row);
                const float wf = __expf(af_last - ACUM[tr * 64 + h]) * DT[tr * 64 + h];
                const float wb = __expf(sb_first - ACUM[tr * 64 + 32 + h]) * DT[tr * 64 + 32 + h];
                float f[8], o[8]; unpack8(*(const u32x4*)(XBC + tr * 4096 + h * 64 + c * 8), f);
#pragma unroll
                for (int i = 0; i < 8; ++i) o[i] = f[i] * wf;
                *(u32x4*)(Xf + row * 72 + c * 8) = pack8(o);
#pragma unroll
                for (int i = 0; i < 8; ++i) o[i] = f[i] * wb;
                *(u32x4*)(Xb + row * 72 + c * 8) = pack8(o); }
            __syncthreads();
            const int dir = wid >> 2, nq = wid & 3;
            const bf16_t* Xd = dir ? Xb : Xf;
            f32x4 acc[4][2];
#pragma unroll
            for (int a = 0; a < 4; ++a) { acc[a][0] = (f32x4){0.f, 0.f, 0.f, 0.f}; acc[a][1] = (f32x4){0.f, 0.f, 0.f, 0.f}; }
#pragma unroll
            for (int ks = 0; ks < 4; ++ks) {
                bf16x8 xa[4], bb[2];
#pragma unroll
                for (int a = 0; a < 4; ++a) xa[a] = frag_tr(Xd, 72, ks * 32, a * 16, lane);
#pragma unroll
                for (int b = 0; b < 2; ++b) bb[b] = frag_tr(Bt, 136, ks * 32, nq * 32 + b * 16, lane);
#pragma unroll
                for (int a = 0; a < 4; ++a)
#pragma unroll
                    for (int b = 0; b < 2; ++b) acc[a][b] = mfma16(bb[b], xa[a], acc[a][b]);
            }
            bf16_t* dst = SB + ((size_t)((ch * 2 + dir) * 32 + h)) * 8192;
#pragma unroll
            for (int a = 0; a < 4; ++a)
#pragma unroll
                for (int b = 0; b < 2; ++b) { const int pp = a * 16 + (lane & 15), n = nq * 32 + b * 16 + (lane >> 4) * 4;
                    *(u32x2*)(dst + pp * 128 + n) = pack4(acc[a][b]); }
        }
    }
}

__device__ __forceinline__ void ssd_scan_phase(const Params& p, bf16_t* SB) {
    const int tid = threadIdx.x;
    const float* ACUM = (const float*)(p.ws + WS_ACUM);
    for (int item = blockIdx.x; item < 34 * 64; item += gridDim.x) {
        const int seq = item >> 6, d = (item >> 5) & 1, h = item & 31;
        const int nc = seq < 32 ? 2 : 16, ch0 = seq < 32 ? seq * 2 : 64 + (seq - 32) * 16;
#pragma unroll
        for (int j = 0; j < 2; ++j) {
            const int e = (tid + NT * j) * 8;
            float st[8];
            if (seq >= 32) { const float* h0 = p.in[2] + ((size_t)(((seq - 32) * 2 + d) * 32 + h)) * 8192 + e; const f32x4 a = *(const f32x4*)h0, b = *(const f32x4*)(h0 + 4);
                st[0] = a[0]; st[1] = a[1]; st[2] = a[2]; st[3] = a[3]; st[4] = b[0]; st[5] = b[1]; st[6] = b[2]; st[7] = b[3]; }
            else {
#pragma unroll
                for (int i = 0; i < 8; ++i) st[i] = 0.f; }
            for (int ci = 0; ci < nc; ++ci) {
                const int c = d ? nc - 1 - ci : ci, ch = ch0 + c, t0 = ch * 128;
                const float tot = d ? ACUM[(size_t)t0 * 64 + 32 + h] : ACUM[(size_t)(t0 + 127) * 64 + h];
                bf16_t* ptr = SB + ((size_t)((ch * 2 + d) * 32 + h)) * 8192 + e;
                float s[8]; unpack8(*(const u32x4*)ptr, s);
                *(u32x4*)ptr = pack8(st);
                const float dec = __expf(tot);
#pragma unroll
                for (int i = 0; i < 8; ++i) st[i] = dec * st[i] + s[i];
            }
            if (seq < 32) { float* o = p.out + OUT_SSD + ((size_t)((seq * 2 + d) * 32 + h)) * 8192 + e;
                *(f32x4*)o = (f32x4){st[0], st[1], st[2], st[3]}; *(f32x4*)(o + 4) = (f32x4){st[4], st[5], st[6], st[7]}; }
        }
    }
}

template <bool DRY>
__device__ __forceinline__ void ssd_out_phase(const Params& p, const bf16_t* XBC, const bf16_t* SB, bf16_t* Uz, char* smem) {
    int tid_ = threadIdx.x; asm volatile("" : "+v"(tid_));
    const int tid = tid_, lane = tid & 63, wid = tid >> 6;
    const float* DT = (const float*)(p.ws + WS_DT);
    const float* ACUM = (const float*)(p.ws + WS_ACUM);
    float* SSQ = (float*)(p.ws + WS_SSQ);
    bf16_t* Ct = (bf16_t*)smem;
    bf16_t* R1 = Ct + 128 * 136;
    bf16_t* Mt = R1 + 128 * 136;
    bf16_t* Xt = Mt + 128 * 136;
    float* vec = (float*)(Xt + 128 * 72);
    for (int item = blockIdx.x; item < NCHUNK * 8; item += gridDim.x) {
        const int ch = item >> 3, g = item & 7, t0 = ch * 128;
        __syncthreads();
#pragma unroll
        for (int j = 0; j < 4; ++j) { const int q = tid + NT * j, row = q >> 4, c = q & 15; const bf16_t* src = XBC + (size_t)(t0 + row) * 4096 + g * 128 + c * 8;
            *(u32x4*)(R1 + row * 136 + c * 8) = *(const u32x4*)(src + 2048);
            *(u32x4*)(Ct + row * 136 + c * 8) = *(const u32x4*)(src + 3072); }
#pragma unroll
        for (int j = 0; j < 4; ++j) { const int idx = tid + NT * j, kind = idx >> 9, hh = (idx >> 7) & 3, l = idx & 127; const int h = g * 4 + hh;
            const float* srcp = (kind < 2 ? ACUM : DT) + (size_t)(t0 + l) * 64 + (kind & 1) * 32 + h;
            vec[idx] = *srcp; }
        __syncthreads();
        f32x4 gacc[8];
#pragma unroll
        for (int st = 0; st < 8; ++st) gacc[st] = (f32x4){0.f, 0.f, 0.f, 0.f};
#pragma unroll
        for (int ks = 0; ks < 4; ++ks) {
            const bf16x8 cf = frag_rm(Ct, 136, 16 * wid, ks * 32, lane);
#pragma unroll
            for (int st = 0; st < 8; ++st) gacc[st] = mfma16(frag_rm(R1, 136, st * 16, ks * 32, lane), cf, gacc[st]);
        }
        const int l = 16 * wid + (lane & 15);
        for (int hh = 0; hh < 4; ++hh) {
            const int h = g * 4 + hh;
            const float* Af = vec + hh * 128; const float* Sb = vec + 512 + hh * 128; const float* dtf = vec + 1024 + hh * 128; const float* dtb = vec + 1536 + hh * 128;
            __syncthreads();
#pragma unroll
            for (int j = 0; j < 2; ++j) { const int q = tid + NT * j, row = q >> 3, c = q & 7;
                *(u32x4*)(Xt + row * 72 + c * 8) = *(const u32x4*)(XBC + (size_t)(t0 + row) * 4096 + h * 64 + c * 8); }
#pragma unroll
            for (int j = 0; j < 4; ++j) { const int q = tid + NT * j, dd = q >> 10, row = (q >> 4) & 63, c = q & 15;
                *(u32x4*)(R1 + (dd * 64 + row) * 136 + c * 8) = *(const u32x4*)(SB + ((size_t)((ch * 2 + dd) * 32 + h)) * 8192 + row * 128 + c * 8); }
            {
                const float afl = Af[l], sbl = Sb[l];
#pragma unroll
                for (int st = 0; st < 8; ++st) {
                    f32x4 m;
#pragma unroll
                    for (int r = 0; r < 4; ++r) { const int s = st * 16 + (lane >> 4) * 4 + r;
                        float wgt = 0.f;
                        if (s <= l) wgt += __expf(afl - Af[s]) * dtf[s];
                        if (s >= l) wgt += __expf(sbl - Sb[s]) * dtb[s];
                        m[r] = gacc[st][r] * wgt; }
                    *(u32x2*)(Mt + l * 136 + st * 16 + (lane >> 4) * 4) = pack4(m);
                }
            }
            __syncthreads();
            f32x4 ad[4], af[4], ab[4];
#pragma unroll
            for (int a = 0; a < 4; ++a) { ad[a] = (f32x4){0.f, 0.f, 0.f, 0.f}; af[a] = ad[a]; ab[a] = ad[a]; }
#pragma unroll
            for (int ks = 0; ks < 4; ++ks) {
                const bf16x8 mf = frag_rm(Mt, 136, 16 * wid, ks * 32, lane);
                const bf16x8 cf = frag_rm(Ct, 136, 16 * wid, ks * 32, lane);
#pragma unroll
                for (int a = 0; a < 4; ++a) {
                    ad[a] = mfma16(frag_tr(Xt, 72, ks * 32, a * 16, lane), mf, ad[a]);
                    af[a] = mfma16(frag_rm(R1, 136, a * 16, ks * 32, lane), cf, af[a]);
                    ab[a] = mfma16(frag_rm(R1 + 64 * 136, 136, a * 16, ks * 32, lane), cf, ab[a]);
                }
            }
            const float ef = __expf(Af[l]), eb = __expf(Sb[l]), Dh = p.in[18][h];
            const size_t t = (size_t)(t0 + l);
            float ssq = 0.f;
#pragma unroll
            for (int a = 0; a < 4; ++a) {
                const int pp = a * 16 + (lane >> 4) * 4, col = h * 64 + pp;
                const f32x4 x = unpack4(*(const u32x2*)(Xt + l * 72 + pp));
                const f32x4 sz = unpack4(*(const u32x2*)(Uz + t * 2048 + col));
                const f32x4 ng = *(const f32x4*)(p.in[19] + col);
                f32x4 y = (ad[a] + af[a] * ef + ab[a] * eb + x * Dh) * sz;
                ssq += y[0] * y[0] + y[1] * y[1] + y[2] * y[2] + y[3] * y[3];
                if (!DRY) *(u32x2*)(Uz + t * 2048 + col) = pack4(y * ng); else asm volatile("" :: "v"(y[0] * ng[0]), "v"(y[1]), "v"(y[2]), "v"(y[3]));
            }
            ssq += __shfl_xor(ssq, 16); ssq += __shfl_xor(ssq, 32);
            if (!DRY) { if (lane < 16) SSQ[t * 32 + h] = ssq; } else asm volatile("" :: "v"(ssq));
        }
    }
}


__device__ __forceinline__ void mlp_stats_phase(const Params& p, const bf16_t* U) {
    const int lane = threadIdx.x & 63, gw = blockIdx.x * 8 + (threadIdx.x >> 6), nw = gridDim.x * 8;
    float* STATS = (float*)(p.ws + WS_STATS);
    for (int t = gw; t < TOK; t += nw) {
        float f[32]; float s = 0.f;
#pragma unroll
        for (int j = 0; j < 4; ++j) { unpack8(*(const u32x4*)(U + (size_t)t * 6144 + 2048 + j * 512 + lane * 8), f + j * 8); }
#pragma unroll
        for (int i = 0; i < 32; ++i) s += f[i];
        s = wave_sum(s);
        const float mean = s * (1.f / 2048.f);
        float q = 0.f;
#pragma unroll
        for (int i = 0; i < 32; ++i) { const float d = f[i] - mean; q += d * d; }
        q = wave_sum(q);
        if (lane == 0) { STATS[(size_t)t * 2] = mean; STATS[(size_t)t * 2 + 1] = rsqrtf(q * (1.f / 2048.f) + EPSN); }
    }
}
template <bool DRY>
__device__ __forceinline__ void mlp_mix_phase(const Params& p, bf16_t* U, char* smem) {
    int tid_ = threadIdx.x; asm volatile("" : "+v"(tid_));
    const int tid = tid_, lane = tid & 63, wid = tid >> 6;
    const float* STATS = (const float*)(p.ws + WS_STATS);
    bf16_t* Wt = (bf16_t*)smem;
    bf16_t* Vt = Wt + 128 * 136;
    for (int item = blockIdx.x; item < NCHUNK * 16; item += gridDim.x) {
        const int ch = item >> 4, ct = item & 15, g = ct >> 1, c0 = ct * 128, t0 = ch * 128;
        __syncthreads();
#pragma unroll
        for (int jj = 0; jj < 8; ++jj) { const int q = tid + NT * jj, i = q >> 5, j4 = q & 31;
            const f32x4 w = *(const f32x4*)(p.in[23] + ((size_t)(g * 128 + i)) * 128 + j4 * 4);
            *(u32x2*)(Wt + i * 136 + j4 * 4) = pack4(w); }
#pragma unroll
        for (int jj = 0; jj < 4; ++jj) { const int q = tid + NT * jj, j = q >> 4, c = q & 15; const size_t t = (size_t)(t0 + j);
            const float mean = STATS[t * 2], rstd = STATS[t * 2 + 1];
            float f[8]; unpack8(*(const u32x4*)(U + t * 6144 + 2048 + c0 + c * 8), f);
            const f32x4 g0 = *(const f32x4*)(p.in[21] + c0 + c * 8), g1 = *(const f32x4*)(p.in[21] + c0 + c * 8 + 4);
            const f32x4 b0 = *(const f32x4*)(p.in[22] + c0 + c * 8), b1 = *(const f32x4*)(p.in[22] + c0 + c * 8 + 4);
#pragma unroll
            for (int i = 0; i < 4; ++i) { f[i] = (f[i] - mean) * rstd * g0[i] + b0[i]; f[4 + i] = (f[4 + i] - mean) * rstd * g1[i] + b1[i]; }
            *(u32x4*)(Vt + j * 136 + c * 8) = pack8(f); }
        __syncthreads();
        f32x4 acc[8];
#pragma unroll
        for (int a = 0; a < 8; ++a) acc[a] = (f32x4){0.f, 0.f, 0.f, 0.f};
#pragma unroll
        for (int ks = 0; ks < 4; ++ks) {
            const bf16x8 wf = frag_rm(Wt, 136, 16 * wid, ks * 32, lane);
#pragma unroll
            for (int a = 0; a < 8; ++a) acc[a] = mfma16(frag_tr(Vt, 136, ks * 32, a * 16, lane), wf, acc[a]);
        }
        const int i = 16 * wid + (lane & 15); const size_t t = (size_t)(t0 + i);
        const float bs = p.in[24][g * 128 + i];
#pragma unroll
        for (int a = 0; a < 8; ++a) {
            const int col = c0 + a * 16 + (lane >> 4) * 4;
            const f32x4 gu = unpack4(*(const u32x2*)(U + t * 6144 + col));
            const f32x4 sz = unpack4(*(const u32x2*)(U + t * 6144 + 4096 + col));
            { const f32x4 o = gu * (acc[a] + bs) * sz; if (!DRY) *(u32x2*)(U + t * 6144 + col) = pack4(o); else asm volatile("" :: "v"(o[0]), "v"(o[1]), "v"(o[2]), "v"(o[3])); }
        }
    }
}

__device__ __forceinline__ void s5_scan_phase(const Params& p, const bf16_t* Uu, bf16_t* Ydir, char* smem) {
    int tid_ = threadIdx.x; asm volatile("" : "+v"(tid_));
    const int tid = tid_, lane = tid & 63, wid = tid >> 6;
    float* drv = (float*)(smem + wid * 12800);
    bf16_t* Sbuf = (bf16_t*)(smem + wid * 12800 + 8448);
    const int nwaves = gridDim.x * 8;
    for (int wi = blockIdx.x * 8 + wid; wi < 2048; wi += nwaves) {
        const int combo = wi >> 3, slot = wi & 7, d = combo >> 7, g = combo & 127;
        const int dg = d * 128 + g;
        const float step = __expf(p.in[28][dg]);
        float ar, ai;
        {
            const float lr = p.in[26][dg * 64 + lane], li = p.in[27][dg * 64 + lane];
            const float mag = __expf(lr * step), ang = li * step;
            const float kk = rintf(ang * 0.15915494309189535f);
            float rr = fmaf(-kk, 6.2831854820251465f, ang); rr = fmaf(-kk, -1.7484555e-7f, rr);
            ar = mag * __cosf(rr); ai = mag * __sinf(rr);
        }
        bf16x8 bfr[8];
#pragma unroll
        for (int tq = 0; tq < 4; ++tq) {
            const int n = tq * 16 + (lane & 15);
            const float lr = p.in[26][dg * 64 + n], li = p.in[27][dg * 64 + n];
            const float mag = __expf(lr * step), ang = li * step;
            const float kk = rintf(ang * 0.15915494309189535f);
            float rr = fmaf(-kk, 6.2831854820251465f, ang); rr = fmaf(-kk, -1.7484555e-7f, rr);
            const float abr = mag * __cosf(rr), abi = mag * __sinf(rr);
            const float den = lr * lr + li * li, nr = abr - 1.f;
            const float cr = (nr * lr + abi * li) / den, ci = (abi * lr - nr * li) / den;
            float fr[8], fi[8];
            if ((lane >> 4) < 2) {
                const float* pr = p.in[29] + ((size_t)(dg * 64 + n)) * 16 + 8 * (lane >> 4);
                const float* pi = p.in[30] + ((size_t)(dg * 64 + n)) * 16 + 8 * (lane >> 4);
#pragma unroll
                for (int j = 0; j < 8; ++j) { const float br = pr[j], bi = pi[j]; fr[j] = cr * br - ci * bi; fi[j] = cr * bi + ci * br; }
            } else {
#pragma unroll
                for (int j = 0; j < 8; ++j) { fr[j] = 0.f; fi[j] = 0.f; }
            }
            bfr[tq] = as_frag(pack8(fr)); bfr[4 + tq] = as_frag(pack8(fi));
        }
        bf16x8 cfr[4];
#pragma unroll
        for (int ks = 0; ks < 4; ++ks) {
            const float* pc = (ks < 2 ? p.in[31] : p.in[32]) + ((size_t)(dg * 16 + (lane & 15))) * 64 + (ks & 1) * 32 + 8 * (lane >> 4);
            float f[8];
#pragma unroll
            for (int j = 0; j < 8; ++j) f[j] = ks < 2 ? pc[j] : -pc[j];
            cfr[ks] = as_frag(pack8(f));
        }
        const int nseq = slot < 2 ? 1 : (32 - (slot - 2) + 5) / 6;
        for (int si = 0; si < nseq; ++si) {
            const int seq = slot < 2 ? 32 + slot : (slot - 2) + 6 * si;
            const int L = seq < 32 ? 256 : 2048, tb = seq < 32 ? seq * 256 : TOKC + (seq - 32) * 2048, nchunks = L >> 4;
            float sr = 0.f, sim = 0.f;
            if (seq >= 32) { const float* h0 = p.in[3] + ((size_t)(((seq - 32) * 2 + d) * 2) * 128 + g) * 64 + lane; sr = h0[0]; sim = h0[128 * 64]; }
            u32x4 ucur = (u32x4){0u, 0u, 0u, 0u};
            { const int c = d ? nchunks - 1 : 0; if ((lane >> 4) < 2) ucur = *(const u32x4*)(Uu + (size_t)(tb + c * 16 + (lane & 15)) * 2048 + g * 16 + 8 * (lane >> 4)); }
            for (int ci = 0; ci < nchunks; ++ci) {
                const int c = d ? nchunks - 1 - ci : ci, tok0 = tb + c * 16;
                u32x4 unext = (u32x4){0u, 0u, 0u, 0u};
                if (ci + 1 < nchunks && (lane >> 4) < 2) { const int c2 = d ? c - 1 : c + 1; unext = *(const u32x4*)(Uu + (size_t)(tb + c2 * 16 + (lane & 15)) * 2048 + g * 16 + 8 * (lane >> 4)); }
                const bf16x8 uf = as_frag(ucur);
#pragma unroll
                for (int tl = 0; tl < 8; ++tl) {
                    const f32x4 dv = mfma16(bfr[tl], uf, (f32x4){0.f, 0.f, 0.f, 0.f});
                    *(f32x4*)(drv + (lane & 15) * 132 + tl * 16 + (lane >> 4) * 4) = dv;
                }
                WAVE_LDS_SYNC();
                float dre[16], dim[16];
#pragma unroll
                for (int i = 0; i < 16; ++i) { const int tt = d ? 15 - i : i; dre[i] = drv[tt * 132 + lane]; dim[i] = drv[tt * 132 + 64 + lane]; }
#pragma unroll
                for (int i = 0; i < 16; ++i) { const int tt = d ? 15 - i : i;
                    const float nr2 = ar * sr - ai * sim + dre[i], ni2 = ar * sim + ai * sr + dim[i];
                    sr = nr2; sim = ni2;
                    Sbuf[tt * 136 + lane] = (bf16_t)f2bf(sr); Sbuf[tt * 136 + 64 + lane] = (bf16_t)f2bf(sim); }
                WAVE_LDS_SYNC();
                f32x4 ya = (f32x4){0.f, 0.f, 0.f, 0.f};
#pragma unroll
                for (int ks = 0; ks < 4; ++ks) ya = mfma16(cfr[ks], frag_rm(Sbuf, 136, 0, ks * 32, lane), ya);
                *(u32x2*)(Ydir + ((size_t)d * TOK + tok0 + (lane & 15)) * 2048 + g * 16 + (lane >> 4) * 4) = pack4(ya);
                WAVE_LDS_SYNC();
                ucur = unext;
            }
            if (seq < 32) { float* o = p.out + OUT_S5 + ((size_t)((seq * 2 + d) * 2) * 128 + g) * 64 + lane; o[0] = sr; o[128 * 64] = sim; }
        }
    }
}
__device__ __forceinline__ void s5_post_phase(const Params& p, const bf16_t* Uu, bf16_t* Ydir) {
    const size_t nvec = (size_t)TOK * 2048 / 8;
    for (size_t v = (size_t)blockIdx.x * NT + threadIdx.x; v < nvec; v += (size_t)gridDim.x * NT) {
        const int col = (int)((v * 8) & 2047);
        float a[8], b[8], u[8];
        unpack8(*(const u32x4*)(Ydir + v * 8), a); unpack8(*(const u32x4*)(Ydir + (size_t)TOK * 2048 + v * 8), b); unpack8(*(const u32x4*)(Uu + v * 8), u);
        const f32x4 d0 = *(const f32x4*)(p.in[33] + col), d1 = *(const f32x4*)(p.in[33] + col + 4);
#pragma unroll
        for (int i = 0; i < 4; ++i) { a[i] = geluf(a[i] + b[i] + d0[i] * u[i]); a[4 + i] = geluf(a[4 + i] + b[4 + i] + d1[i] * u[4 + i]); }
        *(u32x4*)(Ydir + v * 8) = pack8(a);
    }
}

struct AttnState { float m, l; f32x4 o[4]; };
template <bool WIN, int KSTRIDE>
__device__ __forceinline__ void attend128(AttnState& st, const bf16x8 (&qf)[2], const bf16_t* Kt, const bf16_t* Vt, int krow0,
                                          bf16_t* Pbuf, int lane, const float* rpbh, int qc, int kcol0, int idxr0) {
    f32x4 s[8];
    {
        const int row = krow0 + (lane & 15), ksw = (row >> 1) & 7;
        const bf16_t* k0p = Kt + row * 64 + ((((lane >> 4)) ^ ksw) << 3);
        const bf16_t* k1p = Kt + row * 64 + (((4 + (lane >> 4)) ^ ksw) << 3);
#pragma unroll
        for (int kt = 0; kt < 8; ++kt) {
            const int ro = ((kt >> 1) * KSTRIDE + (kt & 1) * 16) * 64;
            s[kt] = mfma16(*(const bf16x8*)(k0p + ro), qf[0], (f32x4){0.f, 0.f, 0.f, 0.f});
            s[kt] = mfma16(*(const bf16x8*)(k1p + ro), qf[1], s[kt]);
        }
    }
    if (WIN) {
        const int cs = min(max(qc - 8, 0), 48);
#pragma unroll
        for (int kt = 0; kt < 8; ++kt) {
            const int ir = idxr0 + (kt >> 1);
#pragma unroll
            for (int r = 0; r < 4; ++r) { const int kc = kcol0 + (kt & 1) * 16 + (lane >> 4) * 4 + r;
                const bool ok = (kc >= cs) && (kc < cs + 16);
                const int ic = min(max(kc - qc + 15, 0), 30);
                s[kt][r] = ok ? s[kt][r] + rpbh[ir * 31 + ic] : -1e30f; }
        }
    }
    float mx = st.m;
#pragma unroll
    for (int kt = 0; kt < 8; ++kt) mx = fmaxf(mx, fmaxf(fmaxf(s[kt][0], s[kt][1]), fmaxf(s[kt][2], s[kt][3])));
    mx = fmaxf(mx, __shfl_xor(mx, 16)); mx = fmaxf(mx, __shfl_xor(mx, 32));
    const float alpha = __expf(st.m - mx);
    st.m = mx; st.l *= alpha;
#pragma unroll
    for (int a = 0; a < 4; ++a) st.o[a] = st.o[a] * alpha;
    const int vrow = krow0 + 8 * (lane >> 4) + ((lane >> 2) & 3);
    const int vs0 = (vrow >> 1) & 7, vs1 = ((vrow + 4) >> 1) & 7, c1 = (lane & 3) >> 1, cin = 4 * (lane & 1);
    const bf16_t* vb0 = Vt + vrow * 64 + cin;
    const bf16_t* vb1 = Vt + (vrow + 4) * 64 + cin;
    bf16_t* pw = Pbuf + (lane & 15) * 40 + (lane >> 4) * 4;
    const bf16_t* pr = Pbuf + (lane & 15) * 40 + 8 * (lane >> 4);
#pragma unroll
    for (int kk = 0; kk < 4; ++kk) {
        float ps = 0.f;
#pragma unroll
        for (int e = 0; e < 2; ++e) { f32x4 pv;
#pragma unroll
            for (int r = 0; r < 4; ++r) { pv[r] = __expf(s[2 * kk + e][r] - mx); ps += pv[r]; }
            *(u32x2*)(pw + e * 16) = pack4(pv); }
        st.l += ps;
        WAVE_LDS_SYNC();
        const bf16x8 pf = *(const bf16x8*)pr;
#pragma unroll
        for (int a = 0; a < 4; ++a) {
            const s16x4 lo = __builtin_amdgcn_ds_read_tr16_b64_v4i16((LAS s16x4*)(vb0 + kk * KSTRIDE * 64 + (((2 * a + c1) ^ vs0) << 3)));
            const s16x4 hi = __builtin_amdgcn_ds_read_tr16_b64_v4i16((LAS s16x4*)(vb1 + kk * KSTRIDE * 64 + (((2 * a + c1) ^ vs1) << 3)));
            bf16x8 vf; vf[0] = lo[0]; vf[1] = lo[1]; vf[2] = lo[2]; vf[3] = lo[3]; vf[4] = hi[0]; vf[5] = hi[1]; vf[6] = hi[2]; vf[7] = hi[3];
            st.o[a] = mfma16(vf, pf, st.o[a]);
        }
        WAVE_LDS_SYNC();
    }
}

template <bool DRY>
__device__ __forceinline__ void attn_phase(const Params& p, bf16_t* Q, const bf16_t* Z, const bf16_t* Kl, const bf16_t* Vl, char* smem) {
    int tid_ = threadIdx.x; asm volatile("" : "+v"(tid_));
    const int tid = tid_, lane = tid & 63, wid = tid >> 6;
    bf16_t* Kt = (bf16_t*)smem;
    bf16_t* Vt = Kt + 512 * 64;
    bf16_t* Pbuf = Vt + 512 * 64 + wid * 640;
    float* rpbs = (float*)(smem + 131072 + 10240);
    float* mrg = (float*)smem;
    const float* ck = p.out + OUT_CK; const float* cv = p.out + OUT_CV;
    for (int item = blockIdx.x; item < 4096; item += gridDim.x) {
        __syncthreads();
        if (item < 2048) {
            const int b = item >> 6, h = (item >> 1) & 31, qh = item & 1;
            const float* ksrc = ck + ((size_t)(b * 32 + h)) * 256 * 64; const float* vsrc = cv + ((size_t)(b * 32 + h)) * 256 * 64;
#pragma unroll
            for (int j = 0; j < 8; ++j) { const int q = tid + NT * j, key = q >> 4, c4 = q & 15;
                *(u32x2*)(Kt + sw64(key, c4 * 4)) = pack4(*(const f32x4*)(ksrc + key * 64 + c4 * 4));
                *(u32x2*)(Vt + sw64(key, c4 * 4)) = pack4(*(const f32x4*)(vsrc + key * 64 + c4 * 4)); }
            const size_t tq = (size_t)(b * 256 + qh * 128 + 16 * wid + (lane & 15));
            bf16x8 qf[2];
            qf[0] = *(const bf16x8*)(Q + tq * 2048 + h * 64 + 8 * (lane >> 4)); qf[1] = *(const bf16x8*)(Q + tq * 2048 + h * 64 + 32 + 8 * (lane >> 4));
            __syncthreads();
            AttnState st; st.m = -1e30f; st.l = 0.f;
#pragma unroll
            for (int a = 0; a < 4; ++a) st.o[a] = (f32x4){0.f, 0.f, 0.f, 0.f};
            attend128<false, 32>(st, qf, Kt, Vt, 0, Pbuf, lane, nullptr, 0, 0, 0);
            attend128<false, 32>(st, qf, Kt, Vt, 128, Pbuf, lane, nullptr, 0, 0, 0);
            float l = st.l; l += __shfl_xor(l, 16); l += __shfl_xor(l, 32);
            const float inv = 1.f / l;
#pragma unroll
            for (int a = 0; a < 4; ++a) { const int col = h * 64 + a * 16 + (lane >> 4) * 4;
                const f32x4 sz = unpack4(*(const u32x2*)(Z + tq * 2048 + col));
                { const f32x4 o = st.o[a] * inv * sz; if (!DRY) *(u32x2*)(Q + tq * 2048 + col) = pack4(o); else asm volatile("" :: "v"(o[0]), "v"(o[1]), "v"(o[2]), "v"(o[3])); } }
        } else {
            const int it = item - 2048, b = it >> 10, h = (it >> 5) & 31, r = it & 31, rs = min(max(r - 4, 0), 24);
            const bf16_t* ksrc = Kl + ((size_t)(b * 2048 + rs * 64)) * 2048 + h * 64; const bf16_t* vsrc = Vl + ((size_t)(b * 2048 + rs * 64)) * 2048 + h * 64;
#pragma unroll
            for (int j = 0; j < 8; ++j) { const int q = tid + NT * j, key = q >> 3, c = q & 7;
                *(u32x4*)(Kt + sw64(key, c * 8)) = *(const u32x4*)(ksrc + (size_t)key * 2048 + c * 8);
                *(u32x4*)(Vt + sw64(key, c * 8)) = *(const u32x4*)(vsrc + (size_t)key * 2048 + c * 8); }
            if (tid < 465) rpbs[tid] = p.in[37][h * 465 + tid];
            const int qt = wid & 3, hf = wid >> 2;
            const int qc = 16 * qt + (lane & 15);
            const size_t tq = (size_t)(TOKC + b * 2048 + r * 64 + qc);
            bf16x8 qf[2];
            qf[0] = *(const bf16x8*)(Q + tq * 2048 + h * 64 + 8 * (lane >> 4)); qf[1] = *(const bf16x8*)(Q + tq * 2048 + h * 64 + 32 + 8 * (lane >> 4));
            const int off = qt == 0 ? 0 : (qt == 1 ? 8 : (qt == 2 ? 24 : 32));
            __syncthreads();
            AttnState st; st.m = -1e30f; st.l = 0.f;
#pragma unroll
            for (int a = 0; a < 4; ++a) st.o[a] = (f32x4){0.f, 0.f, 0.f, 0.f};
            attend128<true, 64>(st, qf, Kt, Vt, hf * 256 + off, Pbuf, lane, rpbs, qc, off, rs + 4 * hf - r + 7);
            __syncthreads();
            const float* k2 = p.in[4] + ((size_t)(b * 32 + h)) * 256 * 64; const float* v2 = p.in[5] + ((size_t)(b * 32 + h)) * 256 * 64;
#pragma unroll
            for (int j = 0; j < 8; ++j) { const int q = tid + NT * j, key = q >> 4, c4 = q & 15;
                *(u32x2*)(Kt + sw64(key, c4 * 4)) = pack4(*(const f32x4*)(k2 + key * 64 + c4 * 4));
                *(u32x2*)(Vt + sw64(key, c4 * 4)) = pack4(*(const f32x4*)(v2 + key * 64 + c4 * 4)); }
            __syncthreads();
            attend128<false, 32>(st, qf, Kt, Vt, hf * 128, Pbuf, lane, nullptr, 0, 0, 0);
            float l = st.l; l += __shfl_xor(l, 16); l += __shfl_xor(l, 32);
            __syncthreads();
            if (hf == 1) { float* mp = mrg + qt * 18 * 64 + lane; mp[0] = st.m; mp[64] = l;
#pragma unroll
                for (int a = 0; a < 4; ++a)
#pragma unroll
                    for (int i = 0; i < 4; ++i) mp[(2 + a * 4 + i) * 64] = st.o[a][i]; }
            __syncthreads();
            if (hf == 0) { const float* mp = mrg + qt * 18 * 64 + lane; const float m2 = mp[0], l2 = mp[64];
                const float mm = fmaxf(st.m, m2), e1 = __expf(st.m - mm), e2 = __expf(m2 - mm);
                const float inv = 1.f / (l * e1 + l2 * e2);
#pragma unroll
                for (int a = 0; a < 4; ++a) { f32x4 o2;
#pragma unroll
                    for (int i = 0; i < 4; ++i) o2[i] = mp[(2 + a * 4 + i) * 64];
                    const int col = h * 64 + a * 16 + (lane >> 4) * 4;
                    const f32x4 sz = unpack4(*(const u32x2*)(Z + tq * 2048 + col));
                    { const f32x4 o = (st.o[a] * e1 + o2 * e2) * inv * sz; if (!DRY) *(u32x2*)(Q + tq * 2048 + col) = pack4(o); else asm volatile("" :: "v"(o[0]), "v"(o[1]), "v"(o[2]), "v"(o[3])); } }
            }
        }
    }
}


#define XB_TMO      128
#define XB_XCNT(j)  (256  + 64 * (j))
#define XB_XSUB(j)  (1280 + 64 * (j))
#define XB_XGEN(j)  (2304 + 64 * (j))
#define XB_TOP      3328
#define XB_TOPGEN   3392
#define XCD_BAR_WORDS 3456
#define XB_SPIN_CAP (1u << 22)
__device__ __forceinline__ unsigned xb_ld(unsigned* p)              { return __hip_atomic_load(p, __ATOMIC_RELAXED, __HIP_MEMORY_SCOPE_AGENT); }
__device__ __forceinline__ unsigned xb_add(unsigned* p, unsigned v) { return __hip_atomic_fetch_add(p, v, __ATOMIC_RELAXED, __HIP_MEMORY_SCOPE_AGENT); }
__device__ __forceinline__ unsigned xb_xcc_id() { return (unsigned)__builtin_amdgcn_s_getreg((3 << 11) | 20) & 0xFu; }
#define XB_SPIN(cond, bar) do { unsigned _sp = 0; while (cond) { __builtin_amdgcn_s_sleep(1); \
    if ((++_sp & 255u) == 0u) { if (xb_ld(&(bar)[XB_TMO])) break; if (_sp > XB_SPIN_CAP) { atomicAdd(&(bar)[XB_TMO], 1u); break; } } } } while (0)
struct XcdBarrier { unsigned* bar; unsigned x; volatile LAS unsigned* st; };
__device__ __forceinline__ XcdBarrier xcd_barrier_post(unsigned* bar, volatile LAS unsigned* st) {
    XcdBarrier b; b.bar = bar; b.x = xb_xcc_id(); b.st = st;
    if (threadIdx.x == 0) (void)xb_add(&bar[XB_XCNT(b.x)], 1u);
    return b;
}
__device__ __forceinline__ void xcd_barrier_complete(unsigned* bar, unsigned x, unsigned& nloc, unsigned& nx) {
    const unsigned G = gridDim.x * gridDim.y * gridDim.z;
    unsigned sum, cnt, mine, sp = 0u;
    for (;;) {
        sum = 0u; cnt = 0u; mine = 0u;
#pragma unroll
        for (unsigned j = 0; j < 16; ++j) { const unsigned c = xb_ld(&bar[XB_XCNT(j)]); sum += c; cnt += (c > 0u) ? 1u : 0u; mine = (j == x) ? c : mine; }
        if (sum == G) break;
        __builtin_amdgcn_s_sleep(1);
        if ((++sp & 255u) == 0u) { if (xb_ld(&bar[XB_TMO])) break; if (sp > XB_SPIN_CAP) { atomicAdd(&bar[XB_TMO], 1u); break; } }
    }
    nloc = mine > 0u ? mine : 1u; nx = cnt > 0u ? cnt : 1u;
}
__device__ __forceinline__ void xcd_barrier(const XcdBarrier& b) {
    asm volatile("s_waitcnt vmcnt(0)" ::: "memory");
    __syncthreads();
    if (threadIdx.x == 0) {
        unsigned* bar = b.bar;
        __builtin_amdgcn_s_waitcnt(0);
        unsigned nloc = b.st[0], nx = b.st[1];
        if (nloc == 0u) { xcd_barrier_complete(bar, b.x, nloc, nx); b.st[0] = nloc; b.st[1] = nx; }
        const unsigned old = xb_add(&bar[XB_XSUB(b.x)], 1u);
        const unsigned gen = old / nloc;
        if (old + 1u == (gen + 1u) * nloc) {
            __builtin_amdgcn_fence(__ATOMIC_RELEASE, "agent");
            asm volatile("s_waitcnt vmcnt(0)" ::: "memory");
            const unsigned og = xb_add(&bar[XB_TOP], 1u);
            const unsigned tg = og / nx;
            if (og + 1u == (tg + 1u) * nx) xb_add(&bar[XB_TOPGEN], 1u);
            else XB_SPIN(xb_ld(&bar[XB_TOPGEN]) == tg, bar);
            __builtin_amdgcn_fence(__ATOMIC_ACQUIRE, "agent");
            xb_add(&bar[XB_XGEN(b.x)], 1u);
            asm volatile("s_waitcnt vmcnt(0)" ::: "memory");
        } else {
            XB_SPIN(xb_ld(&bar[XB_XGEN(b.x)]) == gen, bar);
            __builtin_amdgcn_fence(__ATOMIC_ACQUIRE, "agent");
            asm volatile("s_waitcnt vmcnt(0)" ::: "memory");
        }
    }
    __syncthreads();
}

__global__ void __launch_bounds__(NT) fwd_megakernel(Params p) {
    extern __shared__ __attribute__((aligned(16))) char smem[];
    cg::grid_group grid = cg::this_grid();
    char* ws = p.ws;
    bf16_t* H = (bf16_t*)(ws + WS_H);
    float* MOD = (float*)(ws + WS_MOD);
    bf16_t* U = (bf16_t*)(ws + WS_U);
    bf16_t* SCR = (bf16_t*)(p.out + OUT_CK);
    const bf16_t* WtOut = (const bf16_t*)(ws + WS_WT_OUT);
    volatile LAS unsigned* xbst = (volatile LAS unsigned*)(smem + LDS_BYTES - 16);
    if (threadIdx.x == 0) { xbst[0] = 0u; xbst[1] = 0u; xbst[2] = 0u; xbst[3] = 0u; }
    __syncthreads();
    const XcdBarrier xbar = xcd_barrier_post((unsigned*)(ws + WS_BAR), xbst);
    if (p.pad == 0x5eed) grid.sync();
#define GSYNC() xcd_barrier(xbar)
    prep_phase(p, smem);
    GSYNC();
    if (PROBE & 2) { prep_phase(p, smem); GSYNC(); }
    norm_phase(p, 0);
    GSYNC();
    if (PROBE & 2) { norm_phase(p, 0); GSYNC(); }
    {
        bf16_t* Uz = U; bf16_t* Uxbc = U + (size_t)TOK * 2048; bf16_t* SB = Uxbc; bf16_t* XBC = SCR;
        { EpiSSD e{Uz, Uxbc, (float*)(ws + WS_DT), p.in[16]}; run_gemm(H, 1024, (const bf16_t*)(ws + WS_WT_SSD), 6400, 1024, e, smem);
          if (PROBE & 1) { GSYNC(); run_gemm(H, 1024, (const bf16_t*)(ws + WS_WT_SSD), 6400, 1024, e, smem); } }
        GSYNC();
        ssd_conv_phase(p, Uxbc, XBC);
        GSYNC();
        if (PROBE & 2) { ssd_conv_phase(p, Uxbc, XBC); GSYNC(); }
        ssd_state_phase(p, XBC, SB, smem);
        GSYNC();
        if (PROBE & 2) { ssd_state_phase(p, XBC, SB, smem); GSYNC(); }
        ssd_scan_phase(p, SB);
        GSYNC();
        if (PROBE & 8) { ssd_out_phase<true>(p, XBC, SB, Uz, smem); GSYNC(); }
        ssd_out_phase<false>(p, XBC, SB, Uz, smem);
        GSYNC();
        { EpiOut e{p.in[0], p.in[1], p.out, MOD + 0 * 3 * 3072, (const float*)(ws + WS_SSQ), 1}; run_gemm(Uz, 2048, WtOut, 1024, 2048, e, smem);
          if (PROBE & 1) { GSYNC(); run_gemm(Uz, 2048, WtOut, 1024, 2048, e, smem); } }
        GSYNC();
    }
    norm_phase(p, 1);
    GSYNC();
    if (PROBE & 2) { norm_phase(p, 1); GSYNC(); }
    {
        { EpiMLP e{U}; run_gemm(H, 1024, (const bf16_t*)(ws + WS_WT_MLP), 6144, 1024, e, smem);
          if (PROBE & 1) { GSYNC(); run_gemm(H, 1024, (const bf16_t*)(ws + WS_WT_MLP), 6144, 1024, e, smem); } }
        GSYNC();
        mlp_stats_phase(p, U);
        GSYNC();
        if (PROBE & 2) { mlp_stats_phase(p, U); GSYNC(); }
        if (PROBE & 16) { mlp_mix_phase<true>(p, U, smem); GSYNC(); }
        mlp_mix_phase<false>(p, U, smem);
        GSYNC();
        { EpiOut e{p.in[0], p.in[1], p.out, MOD + 1 * 3 * 3072, nullptr, 0}; run_gemm(U, 6144, WtOut + (size_t)1 * 1024 * 2048, 1024, 2048, e, smem); }
        GSYNC();
    }
    norm_phase(p, 2);
    GSYNC();
    if (PROBE & 2) { norm_phase(p, 2); GSYNC(); }
    {
        bf16_t* Uu = U; bf16_t* Uz = U + (size_t)TOK * 2048; bf16_t* Ydir = SCR;
        { EpiS5 e{Uu, Uz}; run_gemm(H, 1024, (const bf16_t*)(ws + WS_WT_S5), 4096, 1024, e, smem);
          if (PROBE & 1) { GSYNC(); run_gemm(H, 1024, (const bf16_t*)(ws + WS_WT_S5), 4096, 1024, e, smem); } }
        GSYNC();
        s5_scan_phase(p, Uu, Ydir, smem);
        GSYNC();
        if (PROBE & 4) { s5_scan_phase(p, Uu, Ydir, smem); GSYNC(); }
        s5_post_phase(p, Uu, Ydir);
        GSYNC();
        { EpiGLU e{Ydir, Uz, p.in[35]}; run_gemm(Ydir, 2048, (const bf16_t*)(ws + WS_WT_GLU), 2048, 2048, e, smem); }
        GSYNC();
        { EpiOut e{p.in[0], p.in[1], p.out, MOD + 2 * 3 * 3072, nullptr, 0}; run_gemm(Uz, 2048, WtOut + (size_t)2 * 1024 * 2048, 1024, 2048, e, smem); }
        GSYNC();
    }
    norm_phase(p, 3);
    GSYNC();
    if (PROBE & 2) { norm_phase(p, 3); GSYNC(); }
    {
        bf16_t* Q = U; bf16_t* Z = U + (size_t)TOK * 2048; bf16_t* Kl = U + (size_t)TOK * 4096; bf16_t* Vl = Kl + (size_t)4096 * 2048;
        { EpiNAT e{Q, Z, Kl, Vl, p.out + OUT_CK, p.out + OUT_CV}; run_gemm(H, 1024, (const bf16_t*)(ws + WS_WT_NAT), 8192, 1024, e, smem);
          if (PROBE & 1) { GSYNC(); run_gemm(H, 1024, (const bf16_t*)(ws + WS_WT_NAT), 8192, 1024, e, smem); } }
        GSYNC();
        if (PROBE & 32) { attn_phase<true>(p, Q, Z, Kl, Vl, smem); GSYNC(); }
        attn_phase<false>(p, Q, Z, Kl, Vl, smem);
        GSYNC();
        { EpiOut e{p.in[0], p.in[1], p.out, MOD + 3 * 3 * 3072, nullptr, 0}; run_gemm(Q, 2048, WtOut + (size_t)3 * 1024 * 2048, 1024, 2048, e, smem); }
        GSYNC();
    }
    final_phase(p);
}

extern "C" void kernel_launch(void* const* d_in, const int* in_sizes, int n_in, void* d_out, int out_size, void* d_ws, size_t ws_size,
                              hipStream_t stream) {
    static int grid_blocks = 0;
    if (grid_blocks == 0) {
        int dev = 0, cus = 0, per_cu = 0;
        hipGetDevice(&dev);
        hipDeviceGetAttribute(&cus, hipDeviceAttributeMultiprocessorCount, dev);
        if (hipFuncSetAttribute((const void*)fwd_megakernel, hipFuncAttributeMaxDynamicSharedMemorySize, LDS_BYTES) != hipSuccess) { fprintf(stderr, "hipFuncSetAttribute failed\n"); }
        if (hipOccupancyMaxActiveBlocksPerMultiprocessor(&per_cu, (const void*)fwd_megakernel, NT, LDS_BYTES) != hipSuccess || per_cu < 1) { fprintf(stderr, "occupancy query failed (%d)\n", per_cu); per_cu = 1; }
        (void)hipGetLastError();
        grid_blocks = cus;
        if (ws_size < WS_END) { fprintf(stderr, "workspace too small: %zu < %zu\n", ws_size, (size_t)WS_END); grid_blocks = -1; }
        if (n_in != 38) { fprintf(stderr, "expected 38 inputs, got %d\n", n_in); grid_blocks = -1; }
    }
    if (grid_blocks < 0) return;
    Params p;
    memset(&p, 0, sizeof(p));
    for (int i = 0; i < 38; ++i) p.in[i] = (const float*)d_in[i];
    p.out = (float*)d_out; p.ws = (char*)d_ws;
    char* ws = (char*)d_ws;
    int t0 = 0;
    auto job = [&](int i, const float* src, size_t off, int K, int N, int Npad) {
        p.jobs[i].src = src; p.jobs[i].dst = (bf16_t*)(ws + off); p.jobs[i].K = K; p.jobs[i].N = N; p.jobs[i].Npad = Npad; p.jobs[i].tile0 = t0; t0 += (K / 64) * (Npad / 64);
    };
    job(0, p.in[13], WS_WT_SSD, 1024, 6208, 6400);
    job(1, p.in[20], WS_WT_MLP, 1024, 6144, 6144);
    job(2, p.in[25], WS_WT_S5, 1024, 4096, 4096);
    job(3, p.in[36], WS_WT_NAT, 1024, 8192, 8192);
    job(4, p.in[34], WS_WT_GLU, 2048, 2048, 2048);
    for (int l = 0; l < 4; ++l) job(5 + l, p.in[11] + (size_t)l * 2048 * 1024, WS_WT_OUT + (size_t)l * 1024 * 2048 * 2, 2048, 1024, 1024);
    p.total_tiles = t0;
    if (hipMemsetAsync(ws + WS_BAR, 0, XCD_BAR_WORDS * 4, stream) != hipSuccess) { fprintf(stderr, "memset of barrier words failed\n"); return; }
    void* args[] = {&p};
    hipError_t e = hipLaunchCooperativeKernel((const void*)fwd_megakernel, dim3(grid_blocks), dim3(NT), args, LDS_BYTES, stream);
    if (e != hipSuccess) fprintf(stderr, "cooperative launch failed: %s (grid %d)\n", hipGetErrorString(e), grid_blocks);
}
```

```cpp
#include <hip/hip_runtime.h>
#include <hip/hip_cooperative_groups.h>
#include <cstdio>
#include <cstdint>
#include <cstring>
namespace cg = cooperative_groups;

typedef unsigned short bf16_t;
typedef short bf16x8 __attribute__((ext_vector_type(8)));
typedef short s16x4 __attribute__((ext_vector_type(4)));
typedef float f32x4 __attribute__((ext_vector_type(4)));
typedef float f32x2 __attribute__((ext_vector_type(2)));
typedef unsigned u32x4 __attribute__((ext_vector_type(4)));
typedef unsigned u32x2 __attribute__((ext_vector_type(2)));
#define LAS __attribute__((address_space(3)))
#define WAVE_LDS_SYNC() do { asm volatile("s_waitcnt lgkmcnt(0)" ::: "memory"); __builtin_amdgcn_wave_barrier(); } while (0)

#define PROBE 0
constexpr int NT = 512;
constexpr int DM = 1024, EE = 2048;
constexpr int TOK = 12288, TOKC = 8192;
constexpr int NCHUNK = 96;
constexpr float EPSN = 1e-6f;
constexpr int LDS_BYTES = 147456;

constexpr size_t WS_WT_SSD = 0;
constexpr size_t WS_WT_MLP = WS_WT_SSD + (size_t)6400 * 1024 * 2;
constexpr size_t WS_WT_S5  = WS_WT_MLP + (size_t)6144 * 1024 * 2;
constexpr size_t WS_WT_NAT = WS_WT_S5 + (size_t)4096 * 1024 * 2;
constexpr size_t WS_WT_GLU = WS_WT_NAT + (size_t)8192 * 1024 * 2;
constexpr size_t WS_WT_OUT = WS_WT_GLU + (size_t)2048 * 2048 * 2;
constexpr size_t WS_H      = WS_WT_OUT + (size_t)4 * 1024 * 2048 * 2;
constexpr size_t WS_MOD    = WS_H + (size_t)TOK * 1024 * 2;
constexpr size_t WS_DT     = WS_MOD + 147456;
constexpr size_t WS_ACUM   = WS_DT + (size_t)TOK * 64 * 4;
constexpr size_t WS_SSQ    = WS_ACUM + (size_t)TOK * 64 * 4;
constexpr size_t WS_STATS  = WS_SSQ + (size_t)TOK * 32 * 4;
constexpr size_t WS_BAR    = WS_STATS + (size_t)TOK * 8;
constexpr size_t WS_U      = WS_H + (size_t)TOK * 1024 * 2 + 8388608;
constexpr size_t WS_END    = WS_U + (size_t)TOK * 6144 * 2;
static_assert(WS_BAR + 16384 <= WS_U, "small region overflow");
static_assert(WS_END <= 268435456, "workspace over 256 MiB");

constexpr size_t OUT_SSD = (size_t)TOK * 1024;
constexpr size_t OUT_S5  = OUT_SSD + (size_t)32 * 2 * 32 * 64 * 128;
constexpr size_t OUT_CK  = OUT_S5 + (size_t)32 * 2 * 2 * 128 * 64;
constexpr size_t OUT_CV  = OUT_CK + (size_t)32 * 32 * 256 * 64;

struct TJob { const float* src; bf16_t* dst; int K, N, Npad, tile0; };
struct Params {
    const float* in[38];
    float* out;
    char* ws;
    TJob jobs[9];
    int total_tiles, pad;
};

__device__ __forceinline__ float bf2f(unsigned h) { return __uint_as_float(h << 16); }
__device__ __forceinline__ float bflo(unsigned u) { return __uint_as_float(u << 16); }
__device__ __forceinline__ float bfhi(unsigned u) { return __uint_as_float(u & 0xffff0000u); }
typedef __bf16 bf16v2_t __attribute__((ext_vector_type(2)));
__device__ __forceinline__ unsigned pack2(float a, float b) { f32x2 v; v[0] = a; v[1] = b; return __builtin_bit_cast(unsigned, __builtin_convertvector(v, bf16v2_t)); }
__device__ __forceinline__ unsigned f2bf(float f) { return pack2(f, 0.f) & 0xffffu; }
__device__ __forceinline__ u32x2 pack4(f32x4 v) { u32x2 r; r.x = pack2(v[0], v[1]); r.y = pack2(v[2], v[3]); return r; }
__device__ __forceinline__ f32x4 unpack4(u32x2 u) { f32x4 r; r[0] = bflo(u.x); r[1] = bfhi(u.x); r[2] = bflo(u.y); r[3] = bfhi(u.y); return r; }
__device__ __forceinline__ void unpack8(u32x4 u, float* f) {
    f[0] = bflo(u.x); f[1] = bfhi(u.x); f[2] = bflo(u.y); f[3] = bfhi(u.y); f[4] = bflo(u.z); f[5] = bfhi(u.z); f[6] = bflo(u.w); f[7] = bfhi(u.w);
}
__device__ __forceinline__ u32x4 pack8(const float* f) { u32x4 r; r.x = pack2(f[0], f[1]); r.y = pack2(f[2], f[3]); r.z = pack2(f[4], f[5]); r.w = pack2(f[6], f[7]); return r; }
__device__ __forceinline__ float fast_rcp(float x) { return __builtin_amdgcn_rcpf(x); }
__device__ __forceinline__ float siluf(float x) { return x * fast_rcp(1.f + __expf(-x)); }
__device__ __forceinline__ float sigmf(float x) { return fast_rcp(1.f + __expf(-x)); }
__device__ __forceinline__ float geluf(float x) {
    const float y2 = 1.5957691216057308f * (x + 0.044715f * x * x * x);
    return x * fast_rcp(1.f + __expf(-y2));
}
__device__ __forceinline__ float softplusf(float x) { return x > 20.f ? x : log1pf(__expf(x)); }
__device__ __forceinline__ float wave_sum(float v) {
#pragma unroll
    for (int o = 32; o > 0; o >>= 1) v += __shfl_xor(v, o);
    return v;
}
__device__ __forceinline__ int cond_idx(int t) { return t < TOKC ? 0 : 1 + ((t - TOKC) >> 11); }
__device__ __forceinline__ f32x4 mfma16(bf16x8 a, bf16x8 b, f32x4 c) { return __builtin_amdgcn_mfma_f32_16x16x32_bf16(a, b, c, 0, 0, 0); }
__device__ __forceinline__ bf16x8 as_frag(u32x4 u) { union { u32x4 a; bf16x8 b; } x; x.a = u; return x.b; }

__device__ __forceinline__ bf16x8 frag_rm(const bf16_t* tile, int stride, int row0, int k0, int lane) {
    return *(const bf16x8*)(tile + (row0 + (lane & 15)) * stride + k0 + 8 * (lane >> 4));
}
__device__ __forceinline__ bf16x8 frag_tr(const bf16_t* tile, int stride, int k0, int c0, int lane) {
    const bf16_t* p = tile + (k0 + 8 * (lane >> 4) + ((lane >> 2) & 3)) * stride + c0 + 4 * (lane & 3);
    s16x4 lo = __builtin_amdgcn_ds_read_tr16_b64_v4i16((LAS s16x4*)p);
    s16x4 hi = __builtin_amdgcn_ds_read_tr16_b64_v4i16((LAS s16x4*)(p + 4 * stride));
    bf16x8 r; r[0] = lo[0]; r[1] = lo[1]; r[2] = lo[2]; r[3] = lo[3]; r[4] = hi[0]; r[5] = hi[1]; r[6] = hi[2]; r[7] = hi[3];
    return r;
}
__device__ __forceinline__ int sw64(int row, int col) { return row * 64 + ((((col >> 3) ^ (row >> 1)) & 7) << 3) + (col & 7); }
__device__ __forceinline__ bf16x8 frag_rm_sw(const bf16_t* tile, int row0, int k0, int lane) {
    const int row = row0 + (lane & 15);
    return *(const bf16x8*)(tile + sw64(row, k0 + 8 * (lane >> 4)));
}
__device__ __forceinline__ bf16x8 frag_tr_sw(const bf16_t* tile, int k0, int c0, int lane) {
    const int row = k0 + 8 * (lane >> 4) + ((lane >> 2) & 3), col = c0 + 4 * (lane & 3);
    s16x4 lo = __builtin_amdgcn_ds_read_tr16_b64_v4i16((LAS s16x4*)(tile + sw64(row, col)));
    s16x4 hi = __builtin_amdgcn_ds_read_tr16_b64_v4i16((LAS s16x4*)(tile + sw64(row + 4, col)));
    bf16x8 r; r[0] = lo[0]; r[1] = lo[1]; r[2] = lo[2]; r[3] = lo[3]; r[4] = hi[0]; r[5] = hi[1]; r[6] = hi[2]; r[7] = hi[3];
    return r;
}


namespace pg8 {
#define PG8_LAS __attribute__((address_space(3)))
constexpr int BM = 256, BK = 64, HALF = 128, HTB = HALF * BK * 2  , STAGE_BYTES = 8 * HTB, NXCD = 8, WGM = 8;

__host__ __device__ __forceinline__ int lds_byte(int r, int c) { const int st = (r >> 4) * 2 + (c >> 5), rr = r & 15, cc = c & 31, ob = rr * 64 + cc * 2; return st * 1024 + (ob ^ (((ob >> 9) & 1) << 5)); }
__host__ __device__ __forceinline__ void stage_rc(int b, int& R, int& C) { const int st = b / 1024, sb = b % 1024, swz = sb ^ (((sb >> 9) & 1) << 5); R = (st >> 1) * 16 + swz / 64; C = (st & 1) * 32 + (swz % 64) / 2; }
__host__ __device__ __forceinline__ int perm32(int rho) { const int n = rho >> 4, i = rho & 15; return 8 * (i >> 2) + 4 * n + (i & 3); }
struct Unit { int pm, pn; };
struct Gemm { const bf16_t* A; const bf16_t* Bt; int M, N, K, lda; };
struct StaticOrder {
    int nM, nN, nwg, G, c;
    __host__ __device__ void init(int M, int N, int G_, int c_) { nM = M / BM; nN = N / BM; nwg = nM * nN; G = G_; c = c_; }
    __host__ __device__ bool next(int i, Unit& u) const {
        const long L = (long)i * G + c; if (L >= nwg) return false;
        int wgid = (int)L; { const int q = nwg / NXCD, r = nwg % NXCD, xcd = wgid % NXCD, off = wgid / NXCD; wgid = (xcd < r ? xcd * (q + 1) : r * (q + 1) + (xcd - r) * q) + off; }
        const int nig = WGM * nN, gid = wgid / nig, fm = gid * WGM, gsz = (nM - fm) < WGM ? (nM - fm) : WGM;
        u.pm = fm + ((wgid % nig) % gsz); u.pn = (wgid % nig) / gsz; return true;
    }
    __device__ __forceinline__ void a_ready(const Unit&) const {}
    __device__ __forceinline__ void done(const Unit&) const {}
};
template <class Epi, class Sched, bool ALIGN_EPI = false, bool SP2 = false>
__device__ __forceinline__ void gemm_phase(PG8_LAS unsigned char* lds, const Gemm g, const Sched& S, const Epi& E) {
    int tid_ = threadIdx.x; asm volatile("" : "+v"(tid_));
    const int tid = tid_, wid = __builtin_amdgcn_readfirstlane(tid >> 6), lane = tid & 63, wr = wid >> 2, wc = wid & 3, fr = lane & 15, fq = lane >> 4;
    const int K = g.K, nt = K / BK;
    unsigned voffA[2], voffB[2];
#pragma unroll
    for (int i = 0; i < 2; ++i) { int R, C; stage_rc(tid * 16 + i * 8192, R, C); const int Rb = Epi::PERM ? ((R & ~31) + perm32(R & 31)) : R;
        voffA[i] = (unsigned)(R * g.lda + C) * 2u; voffB[i] = (unsigned)(Rb * K + C) * 2u; }
    const size_t kstep = (size_t)(BK * 2);
    const size_t hstep = (size_t)HALF * K * 2;
    const size_t tstep = 2 * hstep;
    const size_t hstepA = (size_t)HALF * g.lda * 2, tstepA = 2 * hstepA;
    const unsigned ldsw = (unsigned)wid * 1024u;
    const int aoff = lds_byte(wr * 64 + fr, fq * 8), boff = lds_byte(wc * 32 + fr, fq * 8);
#define PG8_SA(b, h) (((b) * 2 + (h)) * HTB)
#define PG8_SB(b, h) ((4 + (b) * 2 + (h)) * HTB)
#define PG8_STAGE(bufoff, gbase, voff) do { _Pragma("unroll") for (int _i = 0; _i < 2; ++_i) \
        __builtin_amdgcn_global_load_lds((const unsigned*)((const char*)(gbase) + (voff)[_i]), (PG8_LAS unsigned*)(lds + (bufoff) + ldsw + _i * 8192), 16, 0, 0); } while (0)
#define PG8_LDA(dst, b, h) do { _Pragma("unroll") for (int m = 0; m < 4; ++m) _Pragma("unroll") for (int k = 0; k < 2; ++k) dst[m][k] = *(const PG8_LAS bf16x8*)(lds + PG8_SA(b, h) + aoff + m * 2048 + k * 1024); } while (0)
#define PG8_LDB(dst, b, h) do { _Pragma("unroll") for (int n = 0; n < 2; ++n) _Pragma("unroll") for (int k = 0; k < 2; ++k) dst[n][k] = *(const PG8_LAS bf16x8*)(lds + PG8_SB(b, h) + boff + n * 2048 + k * 1024); } while (0)
#define PG8_MMA(ai, bj, At, Bt) do { __builtin_amdgcn_s_setprio(1); _Pragma("unroll") for (int m = 0; m < 4; ++m) _Pragma("unroll") for (int n = 0; n < 2; ++n) _Pragma("unroll") for (int k = 0; k < 2; ++k) \
        acc[ai][bj][m][n] = __builtin_amdgcn_mfma_f32_16x16x32_bf16(Bt[n][k], At[m][k], acc[ai][bj][m][n], 0, 0, 0); __builtin_amdgcn_s_setprio(0); } while (0)
#define PG8_WAIT_V(n) asm volatile("s_waitcnt vmcnt(" #n ")" ::: "memory")
#define PG8_WAIT_L(n) asm volatile("s_waitcnt lgkmcnt(" #n ")" ::: "memory")
#define PG8_BAR __builtin_amdgcn_s_barrier()
#define PG8_SCHED __builtin_amdgcn_sched_barrier(0)
    Unit cur, nxt; int ui = 0;
    if (!S.next(0, cur)) return;
    f32x4 acc[2][2][4][2];
#pragma unroll
    for (int a = 0; a < 2; ++a)
#pragma unroll
        for (int b = 0; b < 2; ++b)
#pragma unroll
            for (int m = 0; m < 4; ++m)
#pragma unroll
                for (int n = 0; n < 2; ++n) acc[a][b][m][n] = (f32x4){0.f, 0.f, 0.f, 0.f};
    bf16x8 At[4][2], B0[2][2], B1[2][2];
    const char* cA = (const char*)g.A + (size_t)cur.pm * tstepA; const char* cB = (const char*)g.Bt + (size_t)cur.pn * tstep;
    S.a_ready(cur);
    if constexpr (SP2) {
        PG8_STAGE(PG8_SB(0, 0), cB, voffB); PG8_STAGE(PG8_SB(0, 1), cB + hstep, voffB); PG8_STAGE(PG8_SA(0, 0), cA, voffA); PG8_STAGE(PG8_SA(0, 1), cA + hstepA, voffA);
        if (wr == 1) PG8_BAR;
        PG8_WAIT_V(2); PG8_BAR;
        PG8_STAGE(PG8_SB(1, 0), cB + kstep, voffB); PG8_STAGE(PG8_SA(1, 0), cA + kstep, voffA); PG8_STAGE(PG8_SB(1, 1), cB + hstep + kstep, voffB);
        PG8_WAIT_V(6); PG8_BAR;
    } else {
        PG8_STAGE(PG8_SB(0, 0), cB, voffB); PG8_STAGE(PG8_SA(0, 0), cA, voffA); PG8_STAGE(PG8_SB(0, 1), cB + hstep, voffB); PG8_STAGE(PG8_SA(0, 1), cA + hstepA, voffA);
        if (wr == 1) PG8_BAR;
        PG8_WAIT_V(4); PG8_BAR;
        PG8_STAGE(PG8_SB(1, 0), cB + kstep, voffB); PG8_STAGE(PG8_SA(1, 0), cA + kstep, voffA); PG8_STAGE(PG8_SB(1, 1), cB + hstep + kstep, voffB);
        PG8_WAIT_V(6); PG8_BAR;
    }
    for (;;) {
        const bool has_next = S.next(ui + 1, nxt);
        const char* nA = has_next ? (const char*)g.A + (size_t)nxt.pm * tstepA : cA; const char* nB = has_next ? (const char*)g.Bt + (size_t)nxt.pn * tstep : cB;
        for (int t = 0; t < nt; t += 2) {
            const bool last = (t == nt - 2);
            const char* a1 = cA + (size_t)(t + 1) * kstep;
            const char* a2 = last ? nA : cA + (size_t)(t + 2) * kstep; const char* b2 = last ? nB : cB + (size_t)(t + 2) * kstep;
            const char* a3 = a2 + kstep; const char* b3 = b2 + kstep;
            if (last && has_next) S.a_ready(nxt);
            if constexpr (SP2) {
            PG8_LDB(B0, 0, 0); PG8_LDB(B1, 0, 1); PG8_SCHED; PG8_LDA(At, 0, 0); PG8_STAGE(PG8_SA(1, 1), a1 + hstepA, voffA);
            PG8_WAIT_V(8); PG8_WAIT_L(0); PG8_BAR; PG8_MMA(0, 0, At, B0); PG8_MMA(0, 1, At, B1); PG8_BAR; PG8_SCHED;
            PG8_LDA(At, 0, 1); PG8_STAGE(PG8_SB(0, 0), b2, voffB); PG8_STAGE(PG8_SB(0, 1), b2 + hstep, voffB); PG8_STAGE(PG8_SA(0, 0), a2, voffA);
            PG8_WAIT_V(8); PG8_WAIT_L(0); PG8_BAR; PG8_MMA(1, 0, At, B0); PG8_MMA(1, 1, At, B1); PG8_BAR; PG8_SCHED;
            PG8_LDB(B0, 1, 0); PG8_LDB(B1, 1, 1); PG8_SCHED; PG8_LDA(At, 1, 0); PG8_STAGE(PG8_SA(0, 1), a2 + hstepA, voffA);
            PG8_WAIT_V(8); PG8_WAIT_L(0); PG8_BAR; PG8_MMA(0, 0, At, B0); PG8_MMA(0, 1, At, B1); PG8_BAR; PG8_SCHED;
            PG8_LDA(At, 1, 1); PG8_STAGE(PG8_SB(1, 0), b3, voffB); PG8_STAGE(PG8_SB(1, 1), b3 + hstep, voffB); PG8_STAGE(PG8_SA(1, 0), a3, voffA);
            PG8_WAIT_V(8); PG8_WAIT_L(0); PG8_BAR; PG8_MMA(1, 0, At, B0); PG8_MMA(1, 1, At, B1); PG8_BAR; PG8_SCHED;
            } else {
            PG8_LDB(B0, 0, 0); PG8_SCHED; PG8_LDA(At, 0, 0); PG8_STAGE(PG8_SA(1, 1), a1 + hstepA, voffA);
            PG8_WAIT_L(8); PG8_BAR; PG8_WAIT_L(0); PG8_MMA(0, 0, At, B0); PG8_BAR; PG8_SCHED;
            PG8_LDB(B1, 0, 1); PG8_STAGE(PG8_SB(0, 0), b2, voffB);
            PG8_BAR; PG8_WAIT_L(0); PG8_MMA(0, 1, At, B1); PG8_BAR;
            PG8_LDA(At, 0, 1); PG8_STAGE(PG8_SA(0, 0), a2, voffA);
            PG8_BAR; PG8_WAIT_L(0); PG8_MMA(1, 0, At, B0); PG8_BAR; PG8_SCHED;
            PG8_STAGE(PG8_SB(0, 1), b2 + hstep, voffB);
            PG8_WAIT_V(6); PG8_BAR; PG8_MMA(1, 1, At, B1); PG8_BAR;
            PG8_LDB(B0, 1, 0); PG8_SCHED; PG8_LDA(At, 1, 0); PG8_STAGE(PG8_SA(0, 1), a2 + hstepA, voffA);
            PG8_WAIT_L(8); PG8_BAR; PG8_WAIT_L(0); PG8_MMA(0, 0, At, B0); PG8_BAR; PG8_SCHED;
            PG8_LDB(B1, 1, 1); PG8_STAGE(PG8_SB(1, 0), b3, voffB);
            PG8_BAR; PG8_WAIT_L(0); PG8_MMA(0, 1, At, B1); PG8_BAR;
            PG8_LDA(At, 1, 1); PG8_STAGE(PG8_SA(1, 0), a3, voffA);
            PG8_BAR; PG8_WAIT_L(0); PG8_MMA(1, 0, At, B0); PG8_BAR; PG8_SCHED;
            PG8_STAGE(PG8_SB(1, 1), b3 + hstep, voffB);
            PG8_WAIT_V(6); PG8_BAR; PG8_MMA(1, 1, At, B1); PG8_BAR;
            }
        }
        if constexpr (ALIGN_EPI) { if (wr == 0) PG8_BAR; }
        if constexpr (!Epi::AFTER_DRAIN) { E(acc, cur, wr, wc, fr, fq); S.done(cur); }
        if (!has_next) break;
#pragma unroll
        for (int a = 0; a < 2; ++a)
#pragma unroll
            for (int b = 0; b < 2; ++b)
#pragma unroll
                for (int m = 0; m < 4; ++m)
#pragma unroll
                    for (int n = 0; n < 2; ++n) acc[a][b][m][n] = (f32x4){0.f, 0.f, 0.f, 0.f};
        cur = nxt; cA = nA; cB = nB; ++ui;
        if constexpr (ALIGN_EPI) { if (wr == 1) PG8_BAR; }
    }
    PG8_WAIT_V(0);
    if constexpr (!ALIGN_EPI) { if (wr == 0) PG8_BAR; }
    PG8_BAR;
    if constexpr (Epi::AFTER_DRAIN) { E.fused(acc, cur, wr, wc, fr, fq, lds, wid, lane); S.done(cur); }
#undef PG8_SA
#undef PG8_SB
#undef PG8_STAGE
#undef PG8_LDA
#undef PG8_LDB
#undef PG8_MMA
#undef PG8_WAIT_V
#undef PG8_WAIT_L
#undef PG8_BAR
#undef PG8_SCHED
}
}

template <class E> struct PgEpi {
    static constexpr bool PERM = true, AFTER_DRAIN = false;
    E e;
    __device__ __forceinline__ void operator()(const f32x4 (&acc)[2][2][4][2], const pg8::Unit& u, int wr, int wc, int fr, int fq) const {
#pragma unroll
        for (int ai = 0; ai < 2; ++ai)
#pragma unroll
            for (int m = 0; m < 4; ++m) {
                const int row = u.pm * 256 + ai * 128 + wr * 64 + m * 16 + fr;
                const float rs = e.rowscale(row);
#pragma unroll
                for (int bj = 0; bj < 2; ++bj) e(row, u.pn * 256 + bj * 128 + wc * 32 + fq * 8, acc[ai][bj][m][0], acc[ai][bj][m][1], rs);
            }
    }
};
struct XcdOrder {
    int nM, nN, G8, c, tmx, perX;
    __device__ void init(int M, int N, int G_, int c_) { nM = M / 256; nN = N / 256; G8 = G_ >> 3; c = c_; tmx = nM >> 3; perX = tmx * nN; }
    __device__ bool next(int i, pg8::Unit& u) const {
        const int j = i * G8 + (c >> 3); if (j >= perX) return false;
        const int pn = j / tmx; u.pn = pn; u.pm = (c & 7) * tmx + (j - pn * tmx); return true;
    }
    __device__ __forceinline__ void a_ready(const pg8::Unit&) const {}
    __device__ __forceinline__ void done(const pg8::Unit&) const {}
};
#define GEMM_ORDER 0
template <class E>
__device__ __forceinline__ void run_gemm(const bf16_t* A, int lda, const bf16_t* Bt, int N, int K, const E& e, char* smem) {
    pg8::Gemm g{A, Bt, TOK, N, K, lda};
    PgEpi<E> pe{e};
#if GEMM_ORDER
    XcdOrder S; S.init(TOK, N, (int)gridDim.x, (int)blockIdx.x);
    pg8::gemm_phase<PgEpi<E>, XcdOrder, true, true>((LAS unsigned char*)smem, g, S, pe);
#else
    pg8::StaticOrder S; S.init(TOK, N, (int)gridDim.x, (int)blockIdx.x);
    pg8::gemm_phase<PgEpi<E>, pg8::StaticOrder, true, true>((LAS unsigned char*)smem, g, S, pe);
#endif
}

__device__ __forceinline__ u32x4 pack44(f32x4 a, f32x4 b) { u32x4 r; r.x = pack2(a[0], a[1]); r.y = pack2(a[2], a[3]); r.z = pack2(b[0], b[1]); r.w = pack2(b[2], b[3]); return r; }
__device__ __forceinline__ void unpack44(u32x4 u, f32x4& a, f32x4& b) { a[0] = bflo(u.x); a[1] = bfhi(u.x); a[2] = bflo(u.y); a[3] = bfhi(u.y); b[0] = bflo(u.z); b[1] = bfhi(u.z); b[2] = bflo(u.w); b[3] = bfhi(u.w); }
__device__ __forceinline__ f32x4 silu4(f32x4 v) { f32x4 s; s[0] = siluf(v[0]); s[1] = siluf(v[1]); s[2] = siluf(v[2]); s[3] = siluf(v[3]); return s; }
__device__ __forceinline__ f32x4 gelu4(f32x4 v) { f32x4 s; s[0] = geluf(v[0]); s[1] = geluf(v[1]); s[2] = geluf(v[2]); s[3] = geluf(v[3]); return s; }
struct EpiSSD {
    bf16_t* Uz; bf16_t* Uxbc; float* DT; const float* dt_bias;
    __device__ __forceinline__ float rowscale(int) const { return 1.f; }
    __device__ __forceinline__ void operator()(int row, int col, f32x4 v0, f32x4 v1, float) const {
        if (col < 2048) { *(u32x4*)(Uz + (size_t)row * 2048 + col) = pack44(silu4(v0), silu4(v1)); }
        else if (col < 6144) { *(u32x4*)(Uxbc + (size_t)row * 4096 + (col - 2048)) = pack44(v0, v1); }
        else if (col < 6208) { const int c = col - 6144; const f32x4 b0 = *(const f32x4*)(dt_bias + c), b1 = *(const f32x4*)(dt_bias + c + 4);
            *(f32x4*)(DT + (size_t)row * 64 + c) = v0 + b0; *(f32x4*)(DT + (size_t)row * 64 + c + 4) = v1 + b1; }
    }
};
struct EpiMLP {
    bf16_t* U;
    __device__ __forceinline__ float rowscale(int) const { return 1.f; }
    __device__ __forceinline__ void operator()(int row, int col, f32x4 v0, f32x4 v1, float) const {
        u32x4 o;
        if (col < 4096) o = pack44(gelu4(v0), gelu4(v1)); else o = pack44(silu4(v0), silu4(v1));
        *(u32x4*)(U + (size_t)row * 6144 + col) = o;
    }
};
struct EpiS5 {
    bf16_t* Uu; bf16_t* Uz;
    __device__ __forceinline__ float rowscale(int) const { return 1.f; }
    __device__ __forceinline__ void operator()(int row, int col, f32x4 v0, f32x4 v1, float) const {
        if (col < 2048) *(u32x4*)(Uu + (size_t)row * 2048 + col) = pack44(v0, v1);
        else *(u32x4*)(Uz + (size_t)row * 2048 + (col - 2048)) = pack44(silu4(v0), silu4(v1));
    }
};
struct EpiNAT {
    bf16_t* Q; bf16_t* Z; bf16_t* Kl; bf16_t* Vl; float* ck; float* cv;
    __device__ __forceinline__ float rowscale(int) const { return 1.f; }
    __device__ __forceinline__ void operator()(int row, int col, f32x4 v0, f32x4 v1, float) const {
        if (col < 2048) { *(u32x4*)(Q + (size_t)row * 2048 + col) = pack44(v0 * 0.125f, v1 * 0.125f); }
        else if (col < 6144) {
            const bool isv = col >= 4096; const int c = col - (isv ? 4096 : 2048);
            if (row < TOKC) { const int b = row >> 8, s = row & 255, h = c >> 6, d = c & 63; float* dst = (isv ? cv : ck) + ((size_t)((b * 32 + h) * 256 + s)) * 64 + d; *(f32x4*)dst = v0; *(f32x4*)(dst + 4) = v1; }
            else { bf16_t* dst = (isv ? Vl : Kl) + (size_t)(row - TOKC) * 2048 + c; *(u32x4*)dst = pack44(v0, v1); }
        } else { *(u32x4*)(Z + (size_t)row * 2048 + (col - 6144)) = pack44(silu4(v0), silu4(v1)); }
    }
};
struct EpiOut {
    const float* xp; const float* xs; float* X; const float* modl; const float* ssq; int first;
    __device__ __forceinline__ float rowscale(int row) const {
        if (!ssq) return 1.f;
        const f32x4* p = (const f32x4*)(ssq + (size_t)row * 32); float s = 0.f;
#pragma unroll
        for (int i = 0; i < 8; ++i) { f32x4 v = p[i]; s += (v[0] + v[1]) + (v[2] + v[3]); }
        return rsqrtf(s * (1.f / 2048.f) + EPSN);
    }
    __device__ __forceinline__ void operator()(int row, int col, f32x4 v0, f32x4 v1, float rs) const {
        const float* gp = modl + cond_idx(row) * 3072 + 2048 + col;
        const f32x4 g0 = *(const f32x4*)gp, g1 = *(const f32x4*)(gp + 4);
        const float* xin = (first ? (row < TOKC ? xp + (size_t)row * 1024 : xs + (size_t)(row - TOKC) * 1024) : X + (size_t)row * 1024) + col;
        const f32x4 x0 = *(const f32x4*)xin, x1 = *(const f32x4*)(xin + 4);
        float* o = X + (size_t)row * 1024 + col;
        *(f32x4*)o = x0 + g0 * (v0 * rs); *(f32x4*)(o + 4) = x1 + g1 * (v1 * rs);
    }
};
struct EpiGLU {
    const bf16_t* Yb; bf16_t* Uz; const float* bglu;
    __device__ __forceinline__ float rowscale(int) const { return 1.f; }
    __device__ __forceinline__ void operator()(int row, int col, f32x4 v0, f32x4 v1, float) const {
        f32x4 y0, y1, z0, z1; unpack44(*(const u32x4*)(Yb + (size_t)row * 2048 + col), y0, y1); unpack44(*(const u32x4*)(Uz + (size_t)row * 2048 + col), z0, z1);
        const f32x4 b0 = *(const f32x4*)(bglu + col), b1 = *(const f32x4*)(bglu + col + 4);
        f32x4 o0, o1;
#pragma unroll
        for (int i = 0; i < 4; ++i) { o0[i] = y0[i] * sigmf(v0[i] + b0[i]) * z0[i]; o1[i] = y1[i] * sigmf(v1[i] + b1[i]) * z1[i]; }
        *(u32x4*)(Uz + (size_t)row * 2048 + col) = pack44(o0, o1);
    }
};

__device__ __forceinline__ void prep_phase(const Params& p, char* smem) {
    int tid_ = threadIdx.x; asm volatile("" : "+v"(tid_));
    const int tid = tid_, lane = tid & 63, wid = tid >> 6;
    float* tile = (float*)smem;
    for (int T4 = blockIdx.x; T4 < (p.total_tiles >> 2); T4 += gridDim.x) {
        const int T = T4 * 4;
        int j = 0;
#pragma unroll
        for (int q = 1; q < 9; ++q) if (T >= p.jobs[q].tile0) j = q;
        const float* src = p.jobs[j].src; bf16_t* dst = p.jobs[j].dst; const int K = p.jobs[j].K, N = p.jobs[j].N;
        const int local = T - p.jobs[j].tile0, nkt = K >> 6, kt = local % nkt, nt = local / nkt, k0 = kt * 64, n0 = nt * 64;
        __syncthreads();
        if (n0 < N) {
            f32x4 v[8];
#pragma unroll
            for (int q = 0; q < 8; ++q) { const int idx = tid + NT * q, r = idx >> 4, c4 = idx & 15; v[q] = *(const f32x4*)(src + (size_t)(k0 + r) * N + n0 + c4 * 4); }
#pragma unroll
            for (int q = 0; q < 8; ++q) { const int idx = tid + NT * q, r = idx >> 4, c4 = idx & 15; float* tp = tile + (r >> 6) * 4160 + (r & 63) * 65 + c4 * 4;
                tp[0] = v[q][0]; tp[1] = v[q][1]; tp[2] = v[q][2]; tp[3] = v[q][3]; }
        }
        __syncthreads();
        {
            const int nn = tid >> 3, kc = tid & 7;
#pragma unroll
            for (int s = 0; s < 4; ++s) { float f[8];
#pragma unroll
                for (int i = 0; i < 8; ++i) f[i] = (n0 < N) ? tile[s * 4160 + (kc * 8 + i) * 65 + nn] : 0.f;
                *(u32x4*)(dst + (size_t)(n0 + nn) * K + k0 + s * 64 + kc * 8) = pack8(f); }
        }
    }
    __syncthreads();
    float* sc = (float*)smem;
    float* part = (float*)smem + 3072;
    for (int q = tid; q < 3072; q += NT) { const int ci = q >> 10, k = q & 1023; const float cv = ci == 0 ? p.in[7][k] : p.in[6][(ci - 1) * 1024 + k]; sc[q] = siluf(cv); }
    __syncthreads();
    float* MOD = (float*)(p.ws + WS_MOD);
    for (int it = blockIdx.x; it < 192; it += gridDim.x) {
        const int layer = it / 48, cg0 = (it % 48) * 64, col = cg0 + lane;
        const float* w = p.in[9] + (size_t)layer * 1024 * 3072 + col;
        float a0 = 0.f, a1 = 0.f, a2 = 0.f;
        for (int k = wid * 128; k < wid * 128 + 128; k += 16) { float wv[16];
#pragma unroll
            for (int u = 0; u < 16; ++u) wv[u] = w[(size_t)(k + u) * 3072];
#pragma unroll
            for (int u = 0; u < 16; ++u) { a0 += sc[k + u] * wv[u]; a1 += sc[1024 + k + u] * wv[u]; a2 += sc[2048 + k + u] * wv[u]; } }
        part[(wid * 3 + 0) * 64 + lane] = a0; part[(wid * 3 + 1) * 64 + lane] = a1; part[(wid * 3 + 2) * 64 + lane] = a2;
        __syncthreads();
        if (tid < 192) { const int ci = tid >> 6, l = tid & 63; float s = p.in[10][layer * 3072 + cg0 + l];
#pragma unroll
            for (int w8 = 0; w8 < 8; ++w8) s += part[(w8 * 3 + ci) * 64 + l];
            MOD[(layer * 3 + ci) * 3072 + cg0 + l] = s; }
        __syncthreads();
    }
}

__device__ __forceinline__ void norm_phase(const Params& p, int layer) {
    const int lane = threadIdx.x & 63, gw = blockIdx.x * 8 + (threadIdx.x >> 6), nw = gridDim.x * 8;
    const float* g = p.in[8] + layer * 1024;
    const float* MOD = (const float*)(p.ws + WS_MOD) + layer * 3 * 3072;
    bf16_t* H = (bf16_t*)(p.ws + WS_H);
    for (int tb = gw; tb < TOK; tb += 3 * nw) {
        f32x4 v[3][4]; float ss[3];
#pragma unroll
        for (int r = 0; r < 3; ++r) { const int t = tb + r * nw; ss[r] = 0.f;
            if (t < TOK) { const float* xr = layer == 0 ? (t < TOKC ? p.in[0] + (size_t)t * 1024 : p.in[1] + (size_t)(t - TOKC) * 1024) : p.out + (size_t)t * 1024;
#pragma unroll
                for (int j = 0; j < 4; ++j) v[r][j] = *(const f32x4*)(xr + j * 256 + lane * 4); } }
#pragma unroll
        for (int r = 0; r < 3; ++r) { const int t = tb + r * nw;
            if (t < TOK) {
#pragma unroll
                for (int j = 0; j < 4; ++j) ss[r] += v[r][j][0] * v[r][j][0] + v[r][j][1] * v[r][j][1] + v[r][j][2] * v[r][j][2] + v[r][j][3] * v[r][j][3];
                ss[r] = wave_sum(ss[r]);
                const float rstd = rsqrtf(ss[r] * (1.f / 1024.f) + EPSN);
                const float* md = MOD + cond_idx(t) * 3072;
#pragma unroll
                for (int j = 0; j < 4; ++j) {
                    const int c = j * 256 + lane * 4;
                    const f32x4 gg = *(const f32x4*)(g + c), sh = *(const f32x4*)(md + c), scl = *(const f32x4*)(md + 1024 + c);
                    f32x4 h; for (int i = 0; i < 4; ++i) h[i] = v[r][j][i] * rstd * gg[i] * (1.f + scl[i]) + sh[i];
                    *(u32x2*)(H + (size_t)t * 1024 + c) = pack4(h);
                }
            } }
    }
}
__device__ __forceinline__ void final_phase(const Params& p) {
    const int lane = threadIdx.x & 63, gw = blockIdx.x * 8 + (threadIdx.x >> 6), nw = gridDim.x * 8;
    const float* g = p.in[12];
    for (int tb = gw; tb < TOK; tb += 3 * nw) {
        f32x4 v[3][4];
#pragma unroll
        for (int r = 0; r < 3; ++r) { const int t = tb + r * nw;
            if (t < TOK) { const float* xr = p.out + (size_t)t * 1024;
#pragma unroll
                for (int j = 0; j < 4; ++j) v[r][j] = *(const f32x4*)(xr + j * 256 + lane * 4); } }
#pragma unroll
        for (int r = 0; r < 3; ++r) { const int t = tb + r * nw;
            if (t < TOK) { float ss = 0.f; float* xr = p.out + (size_t)t * 1024;
#pragma unroll
                for (int j = 0; j < 4; ++j) ss += v[r][j][0] * v[r][j][0] + v[r][j][1] * v[r][j][1] + v[r][j][2] * v[r][j][2] + v[r][j][3] * v[r][j][3];
                ss = wave_sum(ss);
                const float rstd = rsqrtf(ss * (1.f / 1024.f) + EPSN);
#pragma unroll
                for (int j = 0; j < 4; ++j) { const int c = j * 256 + lane * 4; const f32x4 gg = *(const f32x4*)(g + c); *(f32x4*)(xr + c) = v[r][j] * rstd * gg; } } }
    }
}

__device__ __forceinline__ void ssd_conv_phase(const Params& p, const bf16_t* Uxbc, bf16_t* XBC) {
    int tid_ = threadIdx.x; asm volatile("" : "+v"(tid_));
    const int tid = tid_, lane = tid & 63, wid = tid >> 6;
    float* DT = (float*)(p.ws + WS_DT);
    float* ACUM = (float*)(p.ws + WS_ACUM);
    for (int ch = blockIdx.x * 8 + wid; ch < NCHUNK; ch += gridDim.x * 8) {
        const int t0 = ch * 128, d = lane >> 5;
        const float a = -__expf(p.in[17][lane]);
        float acc = 0.f;
        for (int i = 0; i < 128; ++i) { const int l = d ? 127 - i : i; const float dtv = softplusf(DT[(size_t)(t0 + l) * 64 + lane]); DT[(size_t)(t0 + l) * 64 + lane] = dtv; acc += dtv * a; ACUM[(size_t)(t0 + l) * 64 + lane] = acc; }
    }
    const int chn = tid * 8;
    float w[5][8], bias[8];
#pragma unroll
    for (int j = 0; j < 5; ++j) { const f32x4 a = *(const f32x4*)(p.in[14] + j * 4096 + chn), b = *(const f32x4*)(p.in[14] + j * 4096 + chn + 4);
        w[j][0] = a[0]; w[j][1] = a[1]; w[j][2] = a[2]; w[j][3] = a[3]; w[j][4] = b[0]; w[j][5] = b[1]; w[j][6] = b[2]; w[j][7] = b[3]; }
    { const f32x4 a = *(const f32x4*)(p.in[15] + chn), b = *(const f32x4*)(p.in[15] + chn + 4);
      bias[0] = a[0]; bias[1] = a[1]; bias[2] = a[2]; bias[3] = a[3]; bias[4] = b[0]; bias[5] = b[1]; bias[6] = b[2]; bias[7] = b[3]; }
    for (int grp = blockIdx.x; grp < TOK / 8; grp += gridDim.x) {
        const int t0 = grp * 8;
        int s0, s1;
        if (t0 < TOKC) { s0 = t0 & ~255; s1 = s0 + 256; } else { s0 = TOKC + ((t0 - TOKC) & ~2047); s1 = s0 + 2048; }
        u32x4 rowv[12];
#pragma unroll
        for (int i = 0; i < 12; ++i) { const int tt = t0 - 2 + i; rowv[i] = (u32x4){0u, 0u, 0u, 0u};
            if (tt >= s0 && tt < s1) rowv[i] = *(const u32x4*)(Uxbc + (size_t)tt * 4096 + chn); }
#pragma unroll
        for (int o = 0; o < 8; ++o) {
            float acc[8];
#pragma unroll
            for (int i = 0; i < 8; ++i) acc[i] = bias[i];
#pragma unroll
            for (int j = 0; j < 5; ++j) { float f[8]; unpack8(rowv[o + j], f);
#pragma unroll
                for (int i = 0; i < 8; ++i) acc[i] += w[j][i] * f[i]; }
#pragma unroll
            for (int i = 0; i < 8; ++i) acc[i] = siluf(acc[i]);
            *(u32x4*)(XBC + (size_t)(t0 + o) * 4096 + chn) = pack8(acc);
        }
    }
}

__device__ __forceinline__ void ssd_state_phase(const Params& p, const bf16_t* XBC, bf16_t* SB, char* smem) {
    int tid_ = threadIdx.x; asm volatile("" : "+v"(tid_));
    const int tid = tid_, lane = tid & 63, wid = tid >> 6;
    const float* DT = (const float*)(p.ws + WS_DT);
    const float* ACUM = (const float*)(p.ws + WS_ACUM);
    bf16_t* Bt = (bf16_t*)smem;
    bf16_t* Xf = Bt + 128 * 136;
    bf16_t* Xb = Xf + 128 * 72;
    for (int item = blockIdx.x; item < NCHUNK * 8; item += gridDim.x) {
        const int ch = item >> 3, g = item & 7, t0 = ch * 128;
        __syncthreads();
#pragma unroll
        for (int j = 0; j < 4; ++j) { const int q = tid + NT * j, row = q >> 4, c = q & 15;
            *(u32x4*)(Bt + row * 136 + c * 8) = *(const u32x4*)(XBC + (size_t)(t0 + row) * 4096 + 2048 + g * 128 + c * 8); }
        for (int hh = 0; hh < 4; ++hh) {
            const int h = g * 4 + hh;
            __syncthreads();
            const float af_last = ACUM[(size_t)(t0 + 127) * 64 + h], sb_first = ACUM[(size_t)t0 * 64 + 32 + h];
#pragma unroll
            for (int j = 0; j < 2; ++j) { const int q = tid + NT * j, row = q >> 3, c = q & 7; const size_t tr = (size_t)(t0 + row);
                const float wf = __expf(af_last - ACUM[tr * 64 + h]) * DT[tr * 64 + h];
                const float wb = __expf(sb_first - ACUM[tr * 64 + 32 + h]) * DT[tr * 64 + 32 + h];
                float f[8], o[8]; unpack8(*(const u32x4*)(XBC + tr * 4096 + h * 64 + c * 8), f);
#pragma unroll
                for (int i = 0; i < 8; ++i) o[i] = f[i] * wf;
                *(u32x4*)(Xf + row * 72 + c * 8) = pack8(o);
#pragma unroll
                for (int i = 0; i < 8; ++i) o[i] = f[i] * wb;
                *(u32x4*)(Xb + row * 72 + c * 8) = pack8(o); }
            __syncthreads();
            const int dir = wid >> 2, nq = wid & 3;
            const bf16_t* Xd = dir ? Xb : Xf;
            f32x4 acc[4][2];
#pragma unroll
            for (int a = 0; a < 4; ++a) { acc[a][0] = (f32x4){0.f, 0.f, 0.f, 0.f}; acc[a][1] = (f32x4){0.f, 0.f, 0.f, 0.f}; }
#pragma unroll
            for (int ks = 0; ks < 4; ++ks) {
                bf16x8 xa[4], bb[2];
#pragma unroll
                for (int a = 0; a < 4; ++a) xa[a] = frag_tr(Xd, 72, ks * 32, a * 16, lane);
#pragma unroll
                for (int b = 0; b < 2; ++b) bb[b] = frag_tr(Bt, 136, ks * 32, nq * 32 + b * 16, lane);
#pragma unroll
                for (int a = 0; a < 4; ++a)
#pragma unroll
                    for (int b = 0; b < 2; ++b) acc[a][b] = mfma16(bb[b], xa[a], acc[a][b]);
            }
            bf16_t* dst = SB + ((size_t)((ch * 2 + dir) * 32 + h)) * 8192;
#pragma unroll
            for (int a = 0; a < 4; ++a)
#pragma unroll
                for (int b = 0; b < 2; ++b) { const int pp = a * 16 + (lane & 15), n = nq * 32 + b * 16 + (lane >> 4) * 4;
                    *(u32x2*)(dst + pp * 128 + n) = pack4(acc[a][b]); }
        }
    }
}

__device__ __forceinline__ void ssd_scan_phase(const Params& p, bf16_t* SB) {
    const int tid = threadIdx.x;
    const float* ACUM = (const float*)(p.ws + WS_ACUM);
    for (int item = blockIdx.x; item < 34 * 64; item += gridDim.x) {
        const int seq = item >> 6, d = (item >> 5) & 1, h = item & 31;
        const int nc = seq < 32 ? 2 : 16, ch0 = seq < 32 ? seq * 2 : 64 + (seq - 32) * 16;
#pragma unroll
        for (int j = 0; j < 2; ++j) {
            const int e = (tid + NT * j) * 8;
            float st[8];
            if (seq >= 32) { const float* h0 = p.in[2] + ((size_t)(((seq - 32) * 2 + d) * 32 + h)) * 8192 + e; const f32x4 a = *(const f32x4*)h0, b = *(const f32x4*)(h0 + 4);
                st[0] = a[0]; st[1] = a[1]; st[2] = a[2]; st[3] = a[3]; st[4] = b[0]; st[5] = b[1]; st[6] = b[2]; st[7] = b[3]; }
            else {
#pragma unroll
                for (int i = 0; i < 8; ++i) st[i] = 0.f; }
            for (int ci = 0; ci < nc; ++ci) {
                const int c = d ? nc - 1 - ci : ci, ch = ch0 + c, t0 = ch * 128;
                const float tot = d ? ACUM[(size_t)t0 * 64 + 32 + h] : ACUM[(size_t)(t0 + 127) * 64 + h];
                bf16_t* ptr = SB + ((size_t)((ch * 2 + d) * 32 + h)) * 8192 + e;
                float s[8]; unpack8(*(const u32x4*)ptr, s);
                *(u32x4*)ptr = pack8(st);
                const float dec = __expf(tot);
#pragma unroll
                for (int i = 0; i < 8; ++i) st[i] = dec * st[i] + s[i];
            }
            if (seq < 32) { float* o = p.out + OUT_SSD + ((size_t)((seq * 2 + d) * 32 + h)) * 8192 + e;
                *(f32x4*)o = (f32x4){st[0], st[1], st[2], st[3]}; *(f32x4*)(o + 4) = (f32x4){st[4], st[5], st[6], st[7]}; }
        }
    }
}

template <bool DRY>
__device__ __forceinline__ void ssd_out_phase(const Params& p, const bf16_t* XBC, const bf16_t* SB, bf16_t* Uz, char* smem) {
    int tid_ = threadIdx.x; asm volatile("" : "+v"(tid_));
    const int tid = tid_, lane = tid & 63, wid = tid >> 6;
    const float* DT = (const float*)(p.ws + WS_DT);
    const float* ACUM = (const float*)(p.ws + WS_ACUM);
    float* SSQ = (float*)(p.ws + WS_SSQ);
    bf16_t* Ct = (bf16_t*)smem;
    bf16_t* R1 = Ct + 128 * 136;
    bf16_t* Mt = R1 + 128 * 136;
    bf16_t* Xt = Mt + 128 * 136;
    float* vec = (float*)(Xt + 128 * 72);
    for (int item = blockIdx.x; item < NCHUNK * 8; item += gridDim.x) {
        const int ch = item >> 3, g = item & 7, t0 = ch * 128;
        __syncthreads();
#pragma unroll
        for (int j = 0; j < 4; ++j) { const int q = tid + NT * j, row = q >> 4, c = q & 15; const bf16_t* src = XBC + (size_t)(t0 + row) * 4096 + g * 128 + c * 8;
            *(u32x4*)(R1 + row * 136 + c * 8) = *(const u32x4*)(src + 2048);
            *(u32x4*)(Ct + row * 136 + c * 8) = *(const u32x4*)(src + 3072); }
#pragma unroll
        for (int j = 0; j < 4; ++j) { const int idx = tid + NT * j, kind = idx >> 9, hh = (idx >> 7) & 3, l = idx & 127; const int h = g * 4 + hh;
            const float* srcp = (kind < 2 ? ACUM : DT) + (size_t)(t0 + l) * 64 + (kind & 1) * 32 + h;
            vec[idx] = *srcp; }
        __syncthreads();
        f32x4 gacc[8];
#pragma unroll
        for (int st = 0; st < 8; ++st) gacc[st] = (f32x4){0.f, 0.f, 0.f, 0.f};
#pragma unroll
        for (int ks = 0; ks < 4; ++ks) {
            const bf16x8 cf = frag_rm(Ct, 136, 16 * wid, ks * 32, lane);
#pragma unroll
            for (int st = 0; st < 8; ++st) gacc[st] = mfma16(frag_rm(R1, 136, st * 16, ks * 32, lane), cf, gacc[st]);
        }
        const int l = 16 * wid + (lane & 15);
        for (int hh = 0; hh < 4; ++hh) {
            const int h = g * 4 + hh;
            const float* Af = vec + hh * 128; const float* Sb = vec + 512 + hh * 128; const float* dtf = vec + 1024 + hh * 128; const float* dtb = vec + 1536 + hh * 128;
            __syncthreads();
#pragma unroll
            for (int j = 0; j < 2; ++j) { const int q = tid + NT * j, row = q >> 3, c = q & 7;
                *(u32x4*)(Xt + row * 72 + c * 8) = *(const u32x4*)(XBC + (size_t)(t0 + row) * 4096 + h * 64 + c * 8); }
#pragma unroll
            for (int j = 0; j < 4; ++j) { const int q = tid + NT * j, dd = q >> 10, row = (q >> 4) & 63, c = q & 15;
                *(u32x4*)(R1 + (dd * 64 + row) * 136 + c * 8) = *(const u32x4*)(SB + ((size_t)((ch * 2 + dd) * 32 + h)) * 8192 + row * 128 + c * 8); }
            {
                const float afl = Af[l], sbl = Sb[l];
#pragma unroll
                for (int st = 0; st < 8; ++st) {
                    f32x4 m;
#pragma unroll
                    for (int r = 0; r < 4; ++r) { const int s = st * 16 + (lane >> 4) * 4 + r;
                        float wgt = 0.f;
                        if (s <= l) wgt += __expf(afl - Af[s]) * dtf[s];
                        if (s >= l) wgt += __expf(sbl - Sb[s]) * dtb[s];
                        m[r] = gacc[st][r] * wgt; }
                    *(u32x2*)(Mt + l * 136 + st * 16 + (lane >> 4) * 4) = pack4(m);
                }
            }
            __syncthreads();
            f32x4 ad[4], af[4], ab[4];
#pragma unroll
            for (int a = 0; a < 4; ++a) { ad[a] = (f32x4){0.f, 0.f, 0.f, 0.f}; af[a] = ad[a]; ab[a] = ad[a]; }
#pragma unroll
            for (int ks = 0; ks < 4; ++ks) {
                const bf16x8 mf = frag_rm(Mt, 136, 16 * wid, ks * 32, lane);
                const bf16x8 cf = frag_rm(Ct, 136, 16 * wid, ks * 32, lane);
#pragma unroll
                for (int a = 0; a < 4; ++a) {
                    ad[a] = mfma16(frag_tr(Xt, 72, ks * 32, a * 16, lane), mf, ad[a]);
                    af[a] = mfma16(frag_rm(R1, 136, a * 16, ks * 32, lane), cf, af[a]);
                    ab[a] = mfma16(frag_rm(R1 + 64 * 136, 136, a * 16, ks * 32, lane), cf, ab[a]);
                }
            }
            const float ef = __expf(Af[l]), eb = __expf(Sb[l]), Dh = p.in[18][h];
            const size_t t = (size_t)(t0 + l);
            float ssq = 0.f;
#pragma unroll
            for (int a = 0; a < 4; ++a) {
                const int pp = a * 16 + (lane >> 4) * 4, col = h * 64 + pp;
                const f32x4 x = unpack4(*(const u32x2*)(Xt + l * 72 + pp));
                const f32x4 sz = unpack4(*(const u32x2*)(Uz + t * 2048 + col));
                const f32x4 ng = *(const f32x4*)(p.in[19] + col);
                f32x4 y = (ad[a] + af[a] * ef + ab[a] * eb + x * Dh) * sz;
                ssq += y[0] * y[0] + y[1] * y[1] + y[2] * y[2] + y[3] * y[3];
                if (!DRY) *(u32x2*)(Uz + t * 2048 + col) = pack4(y * ng); else asm volatile("" :: "v"(y[0] * ng[0]), "v"(y[1]), "v"(y[2]), "v"(y[3]));
            }
            ssq += __shfl_xor(ssq, 16); ssq += __shfl_xor(ssq, 32);
            if (!DRY) { if (lane < 16) SSQ[t * 32 + h] = ssq; } else asm volatile("" :: "v"(ssq));
        }
    }
}


__device__ __forceinline__ void mlp_stats_phase(const Params& p, const bf16_t* U) {
    const int lane = threadIdx.x & 63, gw = blockIdx.x * 8 + (threadIdx.x >> 6), nw = gridDim.x * 8;
    float* STATS = (float*)(p.ws + WS_STATS);
    for (int t = gw; t < TOK; t += nw) {
        float f[32]; float s = 0.f;
#pragma unroll
        for (int j = 0; j < 4; ++j) { unpack8(*(const u32x4*)(U + (size_t)t * 6144 + 2048 + j * 512 + lane * 8), f + j * 8); }
#pragma unroll
        for (int i = 0; i < 32; ++i) s += f[i];
        s = wave_sum(s);
        const float mean = s * (1.f / 2048.f);
        float q = 0.f;
#pragma unroll
        for (int i = 0; i < 32; ++i) { const float d = f[i] - mean; q += d * d; }
        q = wave_sum(q);
        if (lane == 0) { STATS[(size_t)t * 2] = mean; STATS[(size_t)t * 2 + 1] = rsqrtf(q * (1.f / 2048.f) + EPSN); }
    }
}
template <bool DRY>
__device__ __forceinline__ void mlp_mix_phase(const Params& p, bf16_t* U, char* smem) {
    int tid_ = threadIdx.x; asm volatile("" : "+v"(tid_));
    const int tid = tid_, lane = tid & 63, wid = tid >> 6;
    const float* STATS = (const float*)(p.ws + WS_STATS);
    bf16_t* Wt = (bf16_t*)smem;
    bf16_t* Vt = Wt + 128 * 136;
    for (int item = blockIdx.x; item < NCHUNK * 16; item += gridDim.x) {
        const int ch = item >> 4, ct = item & 15, g = ct >> 1, c0 = ct * 128, t0 = ch * 128;
        __syncthreads();
#pragma unroll
        for (int jj = 0; jj < 8; ++jj) { const int q = tid + NT * jj, i = q >> 5, j4 = q & 31;
            const f32x4 w = *(const f32x4*)(p.in[23] + ((size_t)(g * 128 + i)) * 128 + j4 * 4);
            *(u32x2*)(Wt + i * 136 + j4 * 4) = pack4(w); }
#pragma unroll
        for (int jj = 0; jj < 4; ++jj) { const int q = tid + NT * jj, j = q >> 4, c = q & 15; const size_t t = (size_t)(t0 + j);
            const float mean = STATS[t * 2], rstd = STATS[t * 2 + 1];
            float f[8]; unpack8(*(const u32x4*)(U + t * 6144 + 2048 + c0 + c * 8), f);
            const f32x4 g0 = *(const f32x4*)(p.in[21] + c0 + c * 8), g1 = *(const f32x4*)(p.in[21] + c0 + c * 8 + 4);
            const f32x4 b0 = *(const f32x4*)(p.in[22] + c0 + c * 8), b1 = *(const f32x4*)(p.in[22] + c0 + c * 8 + 4);
#pragma unroll
            for (int i = 0; i < 4; ++i) { f[i] = (f[i] - mean) * rstd * g0[i] + b0[i]; f[4 + i] = (f[4 + i] - mean) * rstd * g1[i] + b1[i]; }
            *(u32x4*)(Vt + j * 136 + c * 8) = pack8(f); }
        __syncthreads();
        f32x4 acc[8];
#pragma unroll
        for (int a = 0; a < 8; ++a) acc[a] = (f32x4){0.f, 0.f, 0.f, 0.f};
#pragma unroll
        for (int ks = 0; ks < 4; ++ks) {
            const bf16x8 wf = frag_rm(Wt, 136, 16 * wid, ks * 32, lane);
#pragma unroll
            for (int a = 0; a < 8; ++a) acc[a] = mfma16(frag_tr(Vt, 136, ks * 32, a * 16, lane), wf, acc[a]);
        }
        const int i = 16 * wid + (lane & 15); const size_t t = (size_t)(t0 + i);
        const float bs = p.in[24][g * 128 + i];
#pragma unroll
        for (int a = 0; a < 8; ++a) {
            const int col = c0 + a * 16 + (lane >> 4) * 4;
            const f32x4 gu = unpack4(*(const u32x2*)(U + t * 6144 + col));
            const f32x4 sz = unpack4(*(const u32x2*)(U + t * 6144 + 4096 + col));
            { const f32x4 o = gu * (acc[a] + bs) * sz; if (!DRY) *(u32x2*)(U + t * 6144 + col) = pack4(o); else asm volatile("" :: "v"(o[0]), "v"(o[1]), "v"(o[2]), "v"(o[3])); }
        }
    }
}

__device__ __forceinline__ void s5_scan_phase(const Params& p, const bf16_t* Uu, bf16_t* Ydir, char* smem) {
    int tid_ = threadIdx.x; asm volatile("" : "+v"(tid_));
    const int tid = tid_, lane = tid & 63, wid = tid >> 6;
    bf16_t* Ktab = (bf16_t*)smem;
    bf16_t* Qtab = (bf16_t*)(smem + 4608);
    bf16_t* Ptab = (bf16_t*)(smem + 37376);
    char* wbase = smem + 72192;
    float* qbuf = (float*)(wbase + wid * 8448);
    bf16_t* Sbuf = (bf16_t*)(wbase + wid * 8448);
    f32x2* t_pow = (f32x2*)wbase;
    f32x2* t_coef = t_pow + 9 * 64;
    f32x2* t_bb = t_coef + 64;
    f32x2* t_c = t_bb + 1024;
    for (int combo = blockIdx.x; combo < 256; combo += gridDim.x) {
        const int cx = combo & 7, cy = combo >> 3, d = cy >> 4, g = cx * 16 + (cy & 15), dg = d * 128 + g;
        __syncthreads();
        if (tid < 64) {
            const float step = __expf(p.in[28][dg]);
            const float lr = p.in[26][dg * 64 + tid], li = p.in[27][dg * 64 + tid];
            const float mag = __expf(lr * step), ang = li * step;
            const float kk = rintf(ang * 0.15915494309189535f);
            float rr = fmaf(-kk, 6.2831854820251465f, ang); rr = fmaf(-kk, -1.7484555e-7f, rr);
            const float ar = mag * __cosf(rr), ai = mag * __sinf(rr);
            const float den = lr * lr + li * li, nr = ar - 1.f;
            t_coef[tid] = (f32x2){(nr * lr + ai * li) / den, (ai * lr - nr * li) / den};
            float pr = 1.f, pi = 0.f;
#pragma unroll
            for (int t = 0; t < 9; ++t) { t_pow[t * 64 + tid] = (f32x2){pr, pi}; const float a = pr * ar - pi * ai, b = pr * ai + pi * ar; pr = a; pi = b; }
        }
#pragma unroll
        for (int i = 0; i < 2; ++i) { const int q = tid + NT * i, j = q >> 6, n = q & 63; const size_t o = ((size_t)(dg * 16 + j)) * 64 + n; t_c[q] = (f32x2){p.in[31][o], p.in[32][o]}; }
        __syncthreads();
#pragma unroll
        for (int i = 0; i < 2; ++i) { const int q = tid + NT * i, n = q >> 4; const size_t o = ((size_t)(dg * 64 + n)) * 16 + (q & 15);
            const float br = p.in[29][o], bi = p.in[30][o]; const f32x2 cf = t_coef[n]; t_bb[q] = (f32x2){cf[0] * br - cf[1] * bi, cf[0] * bi + cf[1] * br}; }
        __syncthreads();
#pragma unroll 4
        for (int i = 0; i < 16; ++i) { const int q = tid + NT * i, t = q >> 10, n = (q >> 4) & 63, ch = q & 15;
            const f32x2 pw = t_pow[(7 - t) * 64 + n], bb = t_bb[n * 16 + ch];
            Qtab[(t * 128 + 2 * n) * 16 + ch] = (bf16_t)f2bf(pw[0] * bb[0] - pw[1] * bb[1]);
            Qtab[(t * 128 + 2 * n + 1) * 16 + ch] = (bf16_t)f2bf(pw[0] * bb[1] + pw[1] * bb[0]); }
#pragma unroll 4
        for (int i = 0; i < 16; ++i) { const int q = tid + NT * i, t = q >> 10, j = (q >> 6) & 15, n = q & 63;
            const f32x2 c = t_c[j * 64 + n], pw = t_pow[(t + 1) * 64 + n];
            *(unsigned*)(Ptab + (t * 16 + j) * 136 + 2 * n) = pack2(c[0] * pw[0] - c[1] * pw[1], -(c[0] * pw[1] + c[1] * pw[0])); }
        {
            const int tau = tid >> 6, j = (tid >> 2) & 15, c4 = tid & 3;
            f32x4 a = (f32x4){0.f, 0.f, 0.f, 0.f};
            for (int n = 0; n < 64; ++n) { const f32x2 c = t_c[j * 64 + n], pw = t_pow[tau * 64 + n];
                const float cpr = c[0] * pw[0] - c[1] * pw[1], cpi = c[0] * pw[1] + c[1] * pw[0];
#pragma unroll
                for (int e2 = 0; e2 < 4; ++e2) { const f32x2 bb = t_bb[n * 16 + 4 * c4 + e2]; a[e2] += cpr * bb[0] - cpi * bb[1]; } }
            *(u32x2*)(Ktab + (tau * 16 + j) * 16 + 4 * c4) = pack4(a);
            if (tid < 64) *(u32x2*)(Ktab + 8 * 256 + tid * 4) = (u32x2){0u, 0u};
        }
        const f32x2 a8 = t_pow[8 * 64 + lane];
        __syncthreads();
        const int slot = wid;
        const int ntl = slot < 2 ? 16 : 2 * ((32 - (slot - 2) + 5) / 6);
        const int cl = lane & 15, ch0 = 8 * ((lane >> 4) & 1), th = lane >> 5;
        const bf16_t* qf0 = Qtab + ((th * 128 + cl) * 16 + ch0);
        const bf16_t* pf0 = Ptab + cl * 136 + 8 * (lane >> 4);
        u32x4 ucur[4], unext[4];
        {
            const int seq = slot < 2 ? 32 + slot : (slot - 2);
            const int L = seq < 32 ? 256 : 2048, tb = seq < 32 ? seq * 256 : TOKC + (seq - 32) * 2048;
#pragma unroll
            for (int ks = 0; ks < 4; ++ks) { const int m = cl * 8 + 2 * ks + th, tok = d ? tb + L - 1 - m : tb + m; ucur[ks] = *(const u32x4*)(Uu + (size_t)tok * 2048 + g * 16 + ch0); }
        }
        float sr = 0.f, sim = 0.f;
        for (int k = 0; k < ntl; ++k) {
            const int si = slot < 2 ? 0 : (k >> 1), ti = slot < 2 ? k : (k & 1);
            const int seq = slot < 2 ? 32 + slot : (slot - 2) + 6 * si;
            const int L = seq < 32 ? 256 : 2048, tb = seq < 32 ? seq * 256 : TOKC + (seq - 32) * 2048, ntiles = L >> 7;
            if (ti == 0) {
                sr = 0.f; sim = 0.f;
                if (seq >= 32) { const float* h0 = p.in[3] + ((size_t)(((seq - 32) * 2 + d) * 2) * 128 + g) * 64 + lane; sr = h0[0]; sim = h0[128 * 64]; }
            }
            if (k + 1 < ntl) {
                const int k2 = k + 1, si2 = slot < 2 ? 0 : (k2 >> 1), ti2 = slot < 2 ? k2 : (k2 & 1);
                const int seq2 = slot < 2 ? 32 + slot : (slot - 2) + 6 * si2;
                const int L2 = seq2 < 32 ? 256 : 2048, tb2 = seq2 < 32 ? seq2 * 256 : TOKC + (seq2 - 32) * 2048;
#pragma unroll
                for (int ks = 0; ks < 4; ++ks) { const int m = ti2 * 128 + cl * 8 + 2 * ks + th, tok = d ? tb2 + L2 - 1 - m : tb2 + m; unext[ks] = *(const u32x4*)(Uu + (size_t)tok * 2048 + g * 16 + ch0); }
            }
            bf16x8 uf[4];
#pragma unroll
            for (int ks = 0; ks < 4; ++ks) uf[ks] = as_frag(ucur[ks]);
#pragma unroll
            for (int nt = 0; nt < 8; ++nt) {
                f32x4 acc = (f32x4){0.f, 0.f, 0.f, 0.f};
#pragma unroll
                for (int ks = 0; ks < 4; ++ks) acc = mfma16(*(const bf16x8*)(qf0 + (2 * ks * 128 + nt * 16) * 16), uf[ks], acc);
                *(f32x4*)(qbuf + cl * 132 + nt * 16 + (lane >> 4) * 4) = acc;
            }
            WAVE_LDS_SYNC();
            f32x2 dq[16];
#pragma unroll
            for (int c = 0; c < 16; ++c) dq[c] = *(const f32x2*)(qbuf + c * 132 + 2 * lane);
            unsigned sw[16];
#pragma unroll
            for (int c = 0; c < 16; ++c) { sw[c] = pack2(sr, sim);
                const float nr2 = a8[0] * sr - a8[1] * sim + dq[c][0], ni2 = a8[0] * sim + a8[1] * sr + dq[c][1]; sr = nr2; sim = ni2; }
            WAVE_LDS_SYNC();
#pragma unroll
            for (int c = 0; c < 16; ++c) *(unsigned*)(Sbuf + c * 136 + 2 * lane) = sw[c];
            WAVE_LDS_SYNC();
            bf16x8 sf[4];
#pragma unroll
            for (int ks = 0; ks < 4; ++ks) sf[ks] = frag_rm(Sbuf, 136, 0, ks * 32, lane);
#pragma unroll
            for (int tp = 0; tp < 8; ++tp) {
                f32x4 acc = (f32x4){0.f, 0.f, 0.f, 0.f};
#pragma unroll
                for (int ks = 0; ks < 4; ++ks) {
                    if (2 * ks <= tp) { const int tau = tp - 2 * ks - th, taui = tau < 0 ? 8 : tau;
                        acc = mfma16(*(const bf16x8*)(Ktab + (taui * 16 + cl) * 16 + ch0), uf[ks], acc); }
                    acc = mfma16(*(const bf16x8*)(pf0 + tp * 16 * 136 + ks * 32), sf[ks], acc);
                }
                const int m = ti * 128 + cl * 8 + tp, tok = d ? tb + L - 1 - m : tb + m;
                *(u32x2*)(Ydir + ((size_t)d * TOK + tok) * 2048 + g * 16 + (lane >> 4) * 4) = pack4(acc);
            }
            WAVE_LDS_SYNC();
            if (ti + 1 == ntiles && seq < 32) { float* o = p.out + OUT_S5 + ((size_t)((seq * 2 + d) * 2) * 128 + g) * 64 + lane; o[0] = sr; o[128 * 64] = sim; }
#pragma unroll
            for (int ks = 0; ks < 4; ++ks) ucur[ks] = unext[ks];
        }
    }
}
__device__ __forceinline__ void s5_post_phase(const Params& p, const bf16_t* Uu, bf16_t* Ydir) {
    const size_t nvec = (size_t)TOK * 2048 / 8;
    for (size_t v = (size_t)blockIdx.x * NT + threadIdx.x; v < nvec; v += (size_t)gridDim.x * NT) {
        const int col = (int)((v * 8) & 2047);
        float a[8], b[8], u[8];
        unpack8(*(const u32x4*)(Ydir + v * 8), a); unpack8(*(const u32x4*)(Ydir + (size_t)TOK * 2048 + v * 8), b); unpack8(*(const u32x4*)(Uu + v * 8), u);
        const f32x4 d0 = *(const f32x4*)(p.in[33] + col), d1 = *(const f32x4*)(p.in[33] + col + 4);
#pragma unroll
        for (int i = 0; i < 4; ++i) { a[i] = geluf(a[i] + b[i] + d0[i] * u[i]); a[4 + i] = geluf(a[4 + i] + b[4 + i] + d1[i] * u[4 + i]); }
        *(u32x4*)(Ydir + v * 8) = pack8(a);
    }
}

struct AttnState { float m, l; f32x4 o[4]; };
template <bool WIN, int KSTRIDE>
__device__ __forceinline__ void attend128(AttnState& st, const bf16x8 (&qf)[2], const bf16_t* Kt, const bf16_t* Vt, int krow0,
                                          bf16_t* Pbuf, int lane, const float* rpbh, int qc, int kcol0, int idxr0) {
    f32x4 s[8];
    {
        const int row = krow0 + (lane & 15), ksw = (row >> 1) & 7;
        const bf16_t* k0p = Kt + row * 64 + ((((lane >> 4)) ^ ksw) << 3);
        const bf16_t* k1p = Kt + row * 64 + (((4 + (lane >> 4)) ^ ksw) << 3);
#pragma unroll
        for (int kt = 0; kt < 8; ++kt) {
            const int ro = ((kt >> 1) * KSTRIDE + (kt & 1) * 16) * 64;
            s[kt] = mfma16(*(const bf16x8*)(k0p + ro), qf[0], (f32x4){0.f, 0.f, 0.f, 0.f});
            s[kt] = mfma16(*(const bf16x8*)(k1p + ro), qf[1], s[kt]);
        }
    }
    if (WIN) {
        const int cs = min(max(qc - 8, 0), 48);
#pragma unroll
        for (int kt = 0; kt < 8; ++kt) {
            const int ir = idxr0 + (kt >> 1);
#pragma unroll
            for (int r = 0; r < 4; ++r) { const int kc = kcol0 + (kt & 1) * 16 + (lane >> 4) * 4 + r;
                const bool ok = (kc >= cs) && (kc < cs + 16);
                const int ic = min(max(kc - qc + 15, 0), 30);
                s[kt][r] = ok ? s[kt][r] + rpbh[ir * 31 + ic] : -1e30f; }
        }
    }
    float mx = st.m;
#pragma unroll
    for (int kt = 0; kt < 8; ++kt) mx = fmaxf(mx, fmaxf(fmaxf(s[kt][0], s[kt][1]), fmaxf(s[kt][2], s[kt][3])));
    mx = fmaxf(mx, __shfl_xor(mx, 16)); mx = fmaxf(mx, __shfl_xor(mx, 32));
    const float alpha = __expf(st.m - mx);
    st.m = mx; st.l *= alpha;
#pragma unroll
    for (int a = 0; a < 4; ++a) st.o[a] = st.o[a] * alpha;
    const int vrow = krow0 + 8 * (lane >> 4) + ((lane >> 2) & 3);
    const int vs0 = (vrow >> 1) & 7, vs1 = ((vrow + 4) >> 1) & 7, c1 = (lane & 3) >> 1, cin = 4 * (lane & 1);
    const bf16_t* vb0 = Vt + vrow * 64 + cin;
    const bf16_t* vb1 = Vt + (vrow + 4) * 64 + cin;
    bf16_t* pw = Pbuf + (lane & 15) * 40 + (lane >> 4) * 4;
    const bf16_t* pr = Pbuf + (lane & 15) * 40 + 8 * (lane >> 4);
#pragma unroll
    for (int kk = 0; kk < 4; ++kk) {
        float ps = 0.f;
#pragma unroll
        for (int e = 0; e < 2; ++e) { f32x4 pv;
#pragma unroll
            for (int r = 0; r < 4; ++r) { pv[r] = __expf(s[2 * kk + e][r] - mx); ps += pv[r]; }
            *(u32x2*)(pw + e * 16) = pack4(pv); }
        st.l += ps;
        WAVE_LDS_SYNC();
        const bf16x8 pf = *(const bf16x8*)pr;
#pragma unroll
        for (int a = 0; a < 4; ++a) {
            const s16x4 lo = __builtin_amdgcn_ds_read_tr16_b64_v4i16((LAS s16x4*)(vb0 + kk * KSTRIDE * 64 + (((2 * a + c1) ^ vs0) << 3)));
            const s16x4 hi = __builtin_amdgcn_ds_read_tr16_b64_v4i16((LAS s16x4*)(vb1 + kk * KSTRIDE * 64 + (((2 * a + c1) ^ vs1) << 3)));
            bf16x8 vf; vf[0] = lo[0]; vf[1] = lo[1]; vf[2] = lo[2]; vf[3] = lo[3]; vf[4] = hi[0]; vf[5] = hi[1]; vf[6] = hi[2]; vf[7] = hi[3];
            st.o[a] = mfma16(vf, pf, st.o[a]);
        }
        WAVE_LDS_SYNC();
    }
}

template <bool DRY>
__device__ __forceinline__ void attn_phase(const Params& p, bf16_t* Q, const bf16_t* Z, const bf16_t* Kl, const bf16_t* Vl, char* smem) {
    int tid_ = threadIdx.x; asm volatile("" : "+v"(tid_));
    const int tid = tid_, lane = tid & 63, wid = tid >> 6;
    bf16_t* Kt = (bf16_t*)smem;
    bf16_t* Vt = Kt + 512 * 64;
    bf16_t* Pbuf = Vt + 512 * 64 + wid * 640;
    float* rpbs = (float*)(smem + 131072 + 10240);
    float* mrg = (float*)smem;
    const float* ck = p.out + OUT_CK; const float* cv = p.out + OUT_CV;
    for (int item = blockIdx.x; item < 4096; item += gridDim.x) {
        __syncthreads();
        if (item < 2048) {
            const int b = item >> 6, h = (item >> 1) & 31, qh = item & 1;
            const float* ksrc = ck + ((size_t)(b * 32 + h)) * 256 * 64; const float* vsrc = cv + ((size_t)(b * 32 + h)) * 256 * 64;
#pragma unroll
            for (int j = 0; j < 8; ++j) { const int q = tid + NT * j, key = q >> 4, c4 = q & 15;
                *(u32x2*)(Kt + sw64(key, c4 * 4)) = pack4(*(const f32x4*)(ksrc + key * 64 + c4 * 4));
                *(u32x2*)(Vt + sw64(key, c4 * 4)) = pack4(*(const f32x4*)(vsrc + key * 64 + c4 * 4)); }
            const size_t tq = (size_t)(b * 256 + qh * 128 + 16 * wid + (lane & 15));
            bf16x8 qf[2];
            qf[0] = *(const bf16x8*)(Q + tq * 2048 + h * 64 + 8 * (lane >> 4)); qf[1] = *(const bf16x8*)(Q + tq * 2048 + h * 64 + 32 + 8 * (lane >> 4));
            __syncthreads();
            AttnState st; st.m = -1e30f; st.l = 0.f;
#pragma unroll
            for (int a = 0; a < 4; ++a) st.o[a] = (f32x4){0.f, 0.f, 0.f, 0.f};
            attend128<false, 32>(st, qf, Kt, Vt, 0, Pbuf, lane, nullptr, 0, 0, 0);
            attend128<false, 32>(st, qf, Kt, Vt, 128, Pbuf, lane, nullptr, 0, 0, 0);
            float l = st.l; l += __shfl_xor(l, 16); l += __shfl_xor(l, 32);
            const float inv = 1.f / l;
#pragma unroll
            for (int a = 0; a < 4; ++a) { const int col = h * 64 + a * 16 + (lane >> 4) * 4;
                const f32x4 sz = unpack4(*(const u32x2*)(Z + tq * 2048 + col));
                { const f32x4 o = st.o[a] * inv * sz; if (!DRY) *(u32x2*)(Q + tq * 2048 + col) = pack4(o); else asm volatile("" :: "v"(o[0]), "v"(o[1]), "v"(o[2]), "v"(o[3])); } }
        } else {
            const int it = item - 2048, b = it >> 10, h = (it >> 5) & 31, r = it & 31, rs = min(max(r - 4, 0), 24);
            const bf16_t* ksrc = Kl + ((size_t)(b * 2048 + rs * 64)) * 2048 + h * 64; const bf16_t* vsrc = Vl + ((size_t)(b * 2048 + rs * 64)) * 2048 + h * 64;
#pragma unroll
            for (int j = 0; j < 8; ++j) { const int q = tid + NT * j, key = q >> 3, c = q & 7;
                *(u32x4*)(Kt + sw64(key, c * 8)) = *(const u32x4*)(ksrc + (size_t)key * 2048 + c * 8);
                *(u32x4*)(Vt + sw64(key, c * 8)) = *(const u32x4*)(vsrc + (size_t)key * 2048 + c * 8); }
            if (tid < 465) rpbs[tid] = p.in[37][h * 465 + tid];
            const int qt = wid & 3, hf = wid >> 2;
            const int qc = 16 * qt + (lane & 15);
            const size_t tq = (size_t)(TOKC + b * 2048 + r * 64 + qc);
            bf16x8 qf[2];
            qf[0] = *(const bf16x8*)(Q + tq * 2048 + h * 64 + 8 * (lane >> 4)); qf[1] = *(const bf16x8*)(Q + tq * 2048 + h * 64 + 32 + 8 * (lane >> 4));
            const int off = qt == 0 ? 0 : (qt == 1 ? 8 : (qt == 2 ? 24 : 32));
            __syncthreads();
            AttnState st; st.m = -1e30f; st.l = 0.f;
#pragma unroll
            for (int a = 0; a < 4; ++a) st.o[a] = (f32x4){0.f, 0.f, 0.f, 0.f};
            attend128<true, 64>(st, qf, Kt, Vt, hf * 256 + off, Pbuf, lane, rpbs, qc, off, rs + 4 * hf - r + 7);
            __syncthreads();
            const float* k2 = p.in[4] + ((size_t)(b * 32 + h)) * 256 * 64; const float* v2 = p.in[5] + ((size_t)(b * 32 + h)) * 256 * 64;
#pragma unroll
            for (int j = 0; j < 8; ++j) { const int q = tid + NT * j, key = q >> 4, c4 = q & 15;
                *(u32x2*)(Kt + sw64(key, c4 * 4)) = pack4(*(const f32x4*)(k2 + key * 64 + c4 * 4));
                *(u32x2*)(Vt + sw64(key, c4 * 4)) = pack4(*(const f32x4*)(v2 + key * 64 + c4 * 4)); }
            __syncthreads();
            attend128<false, 32>(st, qf, Kt, Vt, hf * 128, Pbuf, lane, nullptr, 0, 0, 0);
            float l = st.l; l += __shfl_xor(l, 16); l += __shfl_xor(l, 32);
            __syncthreads();
            if (hf == 1) { float* mp = mrg + qt * 18 * 64 + lane; mp[0] = st.m; mp[64] = l;
#pragma unroll
                for (int a = 0; a < 4; ++a)
#pragma unroll
                    for (int i = 0; i < 4; ++i) mp[(2 + a * 4 + i) * 64] = st.o[a][i]; }
            __syncthreads();
            if (hf == 0) { const float* mp = mrg + qt * 18 * 64 + lane; const float m2 = mp[0], l2 = mp[64];
                const float mm = fmaxf(st.m, m2), e1 = __expf(st.m - mm), e2 = __expf(m2 - mm);
                const float inv = 1.f / (l * e1 + l2 * e2);
#pragma unroll
                for (int a = 0; a < 4; ++a) { f32x4 o2;
#pragma unroll
                    for (int i = 0; i < 4; ++i) o2[i] = mp[(2 + a * 4 + i) * 64];
                    const int col = h * 64 + a * 16 + (lane >> 4) * 4;
                    const f32x4 sz = unpack4(*(const u32x2*)(Z + tq * 2048 + col));
                    { const f32x4 o = (st.o[a] * e1 + o2 * e2) * inv * sz; if (!DRY) *(u32x2*)(Q + tq * 2048 + col) = pack4(o); else asm volatile("" :: "v"(o[0]), "v"(o[1]), "v"(o[2]), "v"(o[3])); } }
            }
        }
    }
}


#define XB_TMO      128
#define XB_XCNT(j)  (256  + 64 * (j))
#define XB_XSUB(j)  (1280 + 64 * (j))
#define XB_XGEN(j)  (2304 + 64 * (j))
#define XB_TOP      3328
#define XB_TOPGEN   3392
#define XCD_BAR_WORDS 3456
#define XB_SPIN_CAP (1u << 22)
__device__ __forceinline__ unsigned xb_ld(unsigned* p)              { return __hip_atomic_load(p, __ATOMIC_RELAXED, __HIP_MEMORY_SCOPE_AGENT); }
__device__ __forceinline__ unsigned xb_add(unsigned* p, unsigned v) { return __hip_atomic_fetch_add(p, v, __ATOMIC_RELAXED, __HIP_MEMORY_SCOPE_AGENT); }
__device__ __forceinline__ unsigned xb_xcc_id() { return (unsigned)__builtin_amdgcn_s_getreg((3 << 11) | 20) & 0xFu; }
#define XB_SPIN(cond, bar) do { unsigned _sp = 0; while (cond) { __builtin_amdgcn_s_sleep(1); \
    if ((++_sp & 255u) == 0u) { if (xb_ld(&(bar)[XB_TMO])) break; if (_sp > XB_SPIN_CAP) { atomicAdd(&(bar)[XB_TMO], 1u); break; } } } } while (0)
struct XcdBarrier { unsigned* bar; unsigned x; volatile LAS unsigned* st; };
__device__ __forceinline__ XcdBarrier xcd_barrier_post(unsigned* bar, volatile LAS unsigned* st) {
    XcdBarrier b; b.bar = bar; b.x = xb_xcc_id(); b.st = st;
    if (threadIdx.x == 0) (void)xb_add(&bar[XB_XCNT(b.x)], 1u);
    return b;
}
__device__ __forceinline__ void xcd_barrier_complete(unsigned* bar, unsigned x, unsigned& nloc, unsigned& nx) {
    const unsigned G = gridDim.x * gridDim.y * gridDim.z;
    unsigned sum, cnt, mine, sp = 0u;
    for (;;) {
        sum = 0u; cnt = 0u; mine = 0u;
#pragma unroll
        for (unsigned j = 0; j < 16; ++j) { const unsigned c = xb_ld(&bar[XB_XCNT(j)]); sum += c; cnt += (c > 0u) ? 1u : 0u; mine = (j == x) ? c : mine; }
        if (sum == G) break;
        __builtin_amdgcn_s_sleep(1);
        if ((++sp & 255u) == 0u) { if (xb_ld(&bar[XB_TMO])) break; if (sp > XB_SPIN_CAP) { atomicAdd(&bar[XB_TMO], 1u); break; } }
    }
    nloc = mine > 0u ? mine : 1u; nx = cnt > 0u ? cnt : 1u;
}
__device__ __forceinline__ void xcd_barrier(const XcdBarrier& b) {
    asm volatile("s_waitcnt vmcnt(0)" ::: "memory");
    __syncthreads();
    if (threadIdx.x == 0) {
        unsigned* bar = b.bar;
        __builtin_amdgcn_s_waitcnt(0);
        unsigned nloc = b.st[0], nx = b.st[1];
        if (nloc == 0u) { xcd_barrier_complete(bar, b.x, nloc, nx); b.st[0] = nloc; b.st[1] = nx; }
        const unsigned old = xb_add(&bar[XB_XSUB(b.x)], 1u);
        const unsigned gen = old / nloc;
        if (old + 1u == (gen + 1u) * nloc) {
            __builtin_amdgcn_fence(__ATOMIC_RELEASE, "agent");
            asm volatile("s_waitcnt vmcnt(0)" ::: "memory");
            const unsigned og = xb_add(&bar[XB_TOP], 1u);
            const unsigned tg = og / nx;
            if (og + 1u == (tg + 1u) * nx) xb_add(&bar[XB_TOPGEN], 1u);
            else XB_SPIN(xb_ld(&bar[XB_TOPGEN]) == tg, bar);
            __builtin_amdgcn_fence(__ATOMIC_ACQUIRE, "agent");
            xb_add(&bar[XB_XGEN(b.x)], 1u);
            asm volatile("s_waitcnt vmcnt(0)" ::: "memory");
        } else {
            XB_SPIN(xb_ld(&bar[XB_XGEN(b.x)]) == gen, bar);
            __builtin_amdgcn_fence(__ATOMIC_ACQUIRE, "agent");
            asm volatile("s_waitcnt vmcnt(0)" ::: "memory");
        }
    }
    __syncthreads();
}

__global__ void __launch_bounds__(NT) fwd_megakernel(Params p) {
    extern __shared__ __attribute__((aligned(16))) char smem[];
    cg::grid_group grid = cg::this_grid();
    char* ws = p.ws;
    bf16_t* H = (bf16_t*)(ws + WS_H);
    float* MOD = (float*)(ws + WS_MOD);
    bf16_t* U = (bf16_t*)(ws + WS_U);
    bf16_t* SCR = (bf16_t*)(p.out + OUT_CK);
    const bf16_t* WtOut = (const bf16_t*)(ws + WS_WT_OUT);
    volatile LAS unsigned* xbst = (volatile LAS unsigned*)(smem + LDS_BYTES - 16);
    if (threadIdx.x == 0) { xbst[0] = 0u; xbst[1] = 0u; xbst[2] = 0u; xbst[3] = 0u; }
    __syncthreads();
    const XcdBarrier xbar = xcd_barrier_post((unsigned*)(ws + WS_BAR), xbst);
    if (p.pad == 0x5eed) grid.sync();
#define GSYNC() xcd_barrier(xbar)
    prep_phase(p, smem);
    GSYNC();
    if (PROBE & 2) { prep_phase(p, smem); GSYNC(); }
    norm_phase(p, 0);
    GSYNC();
    if (PROBE & 2) { norm_phase(p, 0); GSYNC(); }
    {
        bf16_t* Uz = U; bf16_t* Uxbc = U + (size_t)TOK * 2048; bf16_t* SB = Uxbc; bf16_t* XBC = SCR;
        { EpiSSD e{Uz, Uxbc, (float*)(ws + WS_DT), p.in[16]}; run_gemm(H, 1024, (const bf16_t*)(ws + WS_WT_SSD), 6400, 1024, e, smem);
          if (PROBE & 1) { GSYNC(); run_gemm(H, 1024, (const bf16_t*)(ws + WS_WT_SSD), 6400, 1024, e, smem); } }
        GSYNC();
        ssd_conv_phase(p, Uxbc, XBC);
        GSYNC();
        if (PROBE & 2) { ssd_conv_phase(p, Uxbc, XBC); GSYNC(); }
        ssd_state_phase(p, XBC, SB, smem);
        GSYNC();
        if (PROBE & 2) { ssd_state_phase(p, XBC, SB, smem); GSYNC(); }
        ssd_scan_phase(p, SB);
        GSYNC();
        if (PROBE & 8) { ssd_out_phase<true>(p, XBC, SB, Uz, smem); GSYNC(); }
        ssd_out_phase<false>(p, XBC, SB, Uz, smem);
        GSYNC();
        { EpiOut e{p.in[0], p.in[1], p.out, MOD + 0 * 3 * 3072, (const float*)(ws + WS_SSQ), 1}; run_gemm(Uz, 2048, WtOut, 1024, 2048, e, smem);
          if (PROBE & 1) { GSYNC(); run_gemm(Uz, 2048, WtOut, 1024, 2048, e, smem); } }
        GSYNC();
    }
    norm_phase(p, 1);
    GSYNC();
    if (PROBE & 2) { norm_phase(p, 1); GSYNC(); }
    {
        { EpiMLP e{U}; run_gemm(H, 1024, (const bf16_t*)(ws + WS_WT_MLP), 6144, 1024, e, smem);
          if (PROBE & 1) { GSYNC(); run_gemm(H, 1024, (const bf16_t*)(ws + WS_WT_MLP), 6144, 1024, e, smem); } }
        GSYNC();
        mlp_stats_phase(p, U);
        GSYNC();
        if (PROBE & 2) { mlp_stats_phase(p, U); GSYNC(); }
        if (PROBE & 16) { mlp_mix_phase<true>(p, U, smem); GSYNC(); }
        mlp_mix_phase<false>(p, U, smem);
        GSYNC();
        { EpiOut e{p.in[0], p.in[1], p.out, MOD + 1 * 3 * 3072, nullptr, 0}; run_gemm(U, 6144, WtOut + (size_t)1 * 1024 * 2048, 1024, 2048, e, smem); }
        GSYNC();
    }
    norm_phase(p, 2);
    GSYNC();
    if (PROBE & 2) { norm_phase(p, 2); GSYNC(); }
    {
        bf16_t* Uu = U; bf16_t* Uz = U + (size_t)TOK * 2048; bf16_t* Ydir = SCR;
        { EpiS5 e{Uu, Uz}; run_gemm(H, 1024, (const bf16_t*)(ws + WS_WT_S5), 4096, 1024, e, smem);
          if (PROBE & 1) { GSYNC(); run_gemm(H, 1024, (const bf16_t*)(ws + WS_WT_S5), 4096, 1024, e, smem); } }
        GSYNC();
        s5_scan_phase(p, Uu, Ydir, smem);
        GSYNC();
        if (PROBE & 4) { s5_scan_phase(p, Uu, Ydir, smem); GSYNC(); }
        s5_post_phase(p, Uu, Ydir);
        GSYNC();
        { EpiGLU e{Ydir, Uz, p.in[35]}; run_gemm(Ydir, 2048, (const bf16_t*)(ws + WS_WT_GLU), 2048, 2048, e, smem); }
        GSYNC();
        { EpiOut e{p.in[0], p.in[1], p.out, MOD + 2 * 3 * 3072, nullptr, 0}; run_gemm(Uz, 2048, WtOut + (size_t)2 * 1024 * 2048, 1024, 2048, e, smem); }
        GSYNC();
    }
    norm_phase(p, 3);
    GSYNC();
    if (PROBE & 2) { norm_phase(p, 3); GSYNC(); }
    {
        bf16_t* Q = U; bf16_t* Z = U + (size_t)TOK * 2048; bf16_t* Kl = U + (size_t)TOK * 4096; bf16_t* Vl = Kl + (size_t)4096 * 2048;
        { EpiNAT e{Q, Z, Kl, Vl, p.out + OUT_CK, p.out + OUT_CV}; run_gemm(H, 1024, (const bf16_t*)(ws + WS_WT_NAT), 8192, 1024, e, smem);
          if (PROBE & 1) { GSYNC(); run_gemm(H, 1024, (const bf16_t*)(ws + WS_WT_NAT), 8192, 1024, e, smem); } }
        GSYNC();
        if (PROBE & 32) { attn_phase<true>(p, Q, Z, Kl, Vl, smem); GSYNC(); }
        attn_phase<false>(p, Q, Z, Kl, Vl, smem);
        GSYNC();
        { EpiOut e{p.in[0], p.in[1], p.out, MOD + 3 * 3 * 3072, nullptr, 0}; run_gemm(Q, 2048, WtOut + (size_t)3 * 1024 * 2048, 1024, 2048, e, smem); }
        GSYNC();
    }
    final_phase(p);
}

extern "C" void kernel_launch(void* const* d_in, const int* in_sizes, int n_in, void* d_out, int out_size, void* d_ws, size_t ws_size,
                              hipStream_t stream) {
    static int grid_blocks = 0;
    if (grid_blocks == 0) {
        int dev = 0, cus = 0, per_cu = 0;
        hipGetDevice(&dev);
        hipDeviceGetAttribute(&cus, hipDeviceAttributeMultiprocessorCount, dev);
        if (hipFuncSetAttribute((const void*)fwd_megakernel, hipFuncAttributeMaxDynamicSharedMemorySize, LDS_BYTES) != hipSuccess) { fprintf(stderr, "hipFuncSetAttribute failed\n"); }
        if (hipOccupancyMaxActiveBlocksPerMultiprocessor(&per_cu, (const void*)fwd_megakernel, NT, LDS_BYTES) != hipSuccess || per_cu < 1) { fprintf(stderr, "occupancy query failed (%d)\n", per_cu); per_cu = 1; }
        (void)hipGetLastError();
        grid_blocks = cus;
        if (ws_size < WS_END) { fprintf(stderr, "workspace too small: %zu < %zu\n", ws_size, (size_t)WS_END); grid_blocks = -1; }
        if (n_in != 38) { fprintf(stderr, "expected 38 inputs, got %d\n", n_in); grid_blocks = -1; }
    }
    if (grid_blocks < 0) return;
    Params p;
    memset(&p, 0, sizeof(p));
    for (int i = 0; i < 38; ++i) p.in[i] = (const float*)d_in[i];
    p.out = (float*)d_out; p.ws = (char*)d_ws;
    char* ws = (char*)d_ws;
    int t0 = 0;
    auto job = [&](int i, const float* src, size_t off, int K, int N, int Npad) {
        p.jobs[i].src = src; p.jobs[i].dst = (bf16_t*)(ws + off); p.jobs[i].K = K; p.jobs[i].N = N; p.jobs[i].Npad = Npad; p.jobs[i].tile0 = t0; t0 += (K / 64) * (Npad / 64);
    };
    job(0, p.in[13], WS_WT_SSD, 1024, 6208, 6400);
    job(1, p.in[20], WS_WT_MLP, 1024, 6144, 6144);
    job(2, p.in[25], WS_WT_S5, 1024, 4096, 4096);
    job(3, p.in[36], WS_WT_NAT, 1024, 8192, 8192);
    job(4, p.in[34], WS_WT_GLU, 2048, 2048, 2048);
    for (int l = 0; l < 4; ++l) job(5 + l, p.in[11] + (size_t)l * 2048 * 1024, WS_WT_OUT + (size_t)l * 1024 * 2048 * 2, 2048, 1024, 1024);
    p.total_tiles = t0;
    if (hipMemsetAsync(ws + WS_BAR, 0, XCD_BAR_WORDS * 4, stream) != hipSuccess) { fprintf(stderr, "memset of barrier words failed\n"); return; }
    void* args[] = {&p};
    hipError_t e = hipLaunchCooperativeKernel((const void*)fwd_megakernel, dim3(grid_blocks), dim3(NT), args, LDS_BYTES, stream);
    if (e != hipSuccess) fprintf(stderr, "cooperative launch failed: %s (grid %d)\n", hipGetErrorString(e), grid_blocks);
}
```

```cpp
#include <hip/hip_runtime.h>
#include <hip/hip_cooperative_groups.h>
#include <cstdio>
#include <cstdint>
#include <cstring>
namespace cg = cooperative_groups;

typedef unsigned short bf16_t;
typedef short bf16x8 __attribute__((ext_vector_type(8)));
typedef short s16x4 __attribute__((ext_vector_type(4)));
typedef float f32x4 __attribute__((ext_vector_type(4)));
typedef float f32x2 __attribute__((ext_vector_type(2)));
typedef unsigned u32x4 __attribute__((ext_vector_type(4)));
typedef unsigned u32x2 __attribute__((ext_vector_type(2)));
#define LAS __attribute__((address_space(3)))
#define WAVE_LDS_SYNC() do { asm volatile("s_waitcnt lgkmcnt(0)" ::: "memory"); __builtin_amdgcn_wave_barrier(); } while (0)

#define PROBE 0
constexpr int NT = 512;
constexpr int DM = 1024, EE = 2048;
constexpr int TOK = 12288, TOKC = 8192;
constexpr int NCHUNK = 96;
constexpr float EPSN = 1e-6f;
constexpr int LDS_BYTES = 147456;

constexpr size_t WS_WT_SSD = 0;
constexpr size_t WS_WT_MLP = WS_WT_SSD + (size_t)6400 * 1024 * 2;
constexpr size_t WS_WT_S5  = WS_WT_MLP + (size_t)6144 * 1024 * 2;
constexpr size_t WS_WT_NAT = WS_WT_S5 + (size_t)4096 * 1024 * 2;
constexpr size_t WS_WT_GLU = WS_WT_NAT + (size_t)8192 * 1024 * 2;
constexpr size_t WS_WT_OUT = WS_WT_GLU + (size_t)2048 * 2048 * 2;
constexpr size_t WS_H      = WS_WT_OUT + (size_t)4 * 1024 * 2048 * 2;
constexpr size_t WS_MOD    = WS_H + (size_t)TOK * 1024 * 2;
constexpr size_t WS_DT     = WS_MOD + 147456;
constexpr size_t WS_ACUM   = WS_DT + (size_t)TOK * 64 * 4;
constexpr size_t WS_SSQ    = WS_ACUM + (size_t)TOK * 64 * 4;
constexpr size_t WS_STATS  = WS_SSQ + (size_t)TOK * 32 * 4;
constexpr size_t WS_BAR    = WS_STATS + (size_t)TOK * 8;
constexpr size_t WS_U      = WS_H + (size_t)TOK * 1024 * 2 + 8388608;
constexpr size_t WS_END    = WS_U + (size_t)TOK * 6144 * 2;
static_assert(WS_BAR + 16384 <= WS_U, "small region overflow");
static_assert(WS_END <= 268435456, "workspace over 256 MiB");

constexpr size_t OUT_SSD = (size_t)TOK * 1024;
constexpr size_t OUT_S5  = OUT_SSD + (size_t)32 * 2 * 32 * 64 * 128;
constexpr size_t OUT_CK  = OUT_S5 + (size_t)32 * 2 * 2 * 128 * 64;
constexpr size_t OUT_CV  = OUT_CK + (size_t)32 * 32 * 256 * 64;

struct TJob { const float* src; bf16_t* dst; int K, N, Npad, tile0; };
struct Params {
    const float* in[38];
    float* out;
    char* ws;
    TJob jobs[9];
    int total_tiles, pad;
};

__device__ __forceinline__ float bf2f(unsigned h) { return __uint_as_float(h << 16); }
__device__ __forceinline__ float bflo(unsigned u) { return __uint_as_float(u << 16); }
__device__ __forceinline__ float bfhi(unsigned u) { return __uint_as_float(u & 0xffff0000u); }
typedef __bf16 bf16v2_t __attribute__((ext_vector_type(2)));
__device__ __forceinline__ unsigned pack2(float a, float b) { f32x2 v; v[0] = a; v[1] = b; return __builtin_bit_cast(unsigned, __builtin_convertvector(v, bf16v2_t)); }
__device__ __forceinline__ unsigned f2bf(float f) { return pack2(f, 0.f) & 0xffffu; }
__device__ __forceinline__ u32x2 pack4(f32x4 v) { u32x2 r; r.x = pack2(v[0], v[1]); r.y = pack2(v[2], v[3]); return r; }
__device__ __forceinline__ f32x4 unpack4(u32x2 u) { f32x4 r; r[0] = bflo(u.x); r[1] = bfhi(u.x); r[2] = bflo(u.y); r[3] = bfhi(u.y); return r; }
__device__ __forceinline__ void unpack8(u32x4 u, float* f) {
    f[0] = bflo(u.x); f[1] = bfhi(u.x); f[2] = bflo(u.y); f[3] = bfhi(u.y); f[4] = bflo(u.z); f[5] = bfhi(u.z); f[6] = bflo(u.w); f[7] = bfhi(u.w);
}
__device__ __forceinline__ u32x4 pack8(const float* f) { u32x4 r; r.x = pack2(f[0], f[1]); r.y = pack2(f[2], f[3]); r.z = pack2(f[4], f[5]); r.w = pack2(f[6], f[7]); return r; }
__device__ __forceinline__ float fast_rcp(float x) { return __builtin_amdgcn_rcpf(x); }
__device__ __forceinline__ float siluf(float x) { return x * fast_rcp(1.f + __expf(-x)); }
__device__ __forceinline__ float sigmf(float x) { return fast_rcp(1.f + __expf(-x)); }
__device__ __forceinline__ float geluf(float x) {
    const float y2 = 1.5957691216057308f * (x + 0.044715f * x * x * x);
    return x * fast_rcp(1.f + __expf(-y2));
}
__device__ __forceinline__ float softplusf(float x) { return x > 20.f ? x : log1pf(__expf(x)); }
__device__ __forceinline__ float wave_sum(float v) {
#pragma unroll
    for (int o = 32; o > 0; o >>= 1) v += __shfl_xor(v, o);
    return v;
}
__device__ __forceinline__ int otid() { int t = threadIdx.x; asm volatile("" : "+v"(t)); return t; }
__device__ __forceinline__ int cond_idx(int t) { return t < TOKC ? 0 : 1 + ((t - TOKC) >> 11); }
__device__ __forceinline__ f32x4 mfma16(bf16x8 a, bf16x8 b, f32x4 c) { return __builtin_amdgcn_mfma_f32_16x16x32_bf16(a, b, c, 0, 0, 0); }
__device__ __forceinline__ bf16x8 as_frag(u32x4 u) { union { u32x4 a; bf16x8 b; } x; x.a = u; return x.b; }

__device__ __forceinline__ bf16x8 frag_rm(const bf16_t* tile, int stride, int row0, int k0, int lane) {
    return *(const bf16x8*)(tile + (row0 + (lane & 15)) * stride + k0 + 8 * (lane >> 4));
}
__device__ __forceinline__ bf16x8 frag_tr(const bf16_t* tile, int stride, int k0, int c0, int lane) {
    const bf16_t* p = tile + (k0 + 8 * (lane >> 4) + ((lane >> 2) & 3)) * stride + c0 + 4 * (lane & 3);
    s16x4 lo = __builtin_amdgcn_ds_read_tr16_b64_v4i16((LAS s16x4*)p);
    s16x4 hi = __builtin_amdgcn_ds_read_tr16_b64_v4i16((LAS s16x4*)(p + 4 * stride));
    bf16x8 r; r[0] = lo[0]; r[1] = lo[1]; r[2] = lo[2]; r[3] = lo[3]; r[4] = hi[0]; r[5] = hi[1]; r[6] = hi[2]; r[7] = hi[3];
    return r;
}
__device__ __forceinline__ int sw64(int row, int col) { return row * 64 + ((((col >> 3) ^ (row >> 1)) & 7) << 3) + (col & 7); }
__device__ __forceinline__ bf16x8 frag_rm_sw(const bf16_t* tile, int row0, int k0, int lane) {
    const int row = row0 + (lane & 15);
    return *(const bf16x8*)(tile + sw64(row, k0 + 8 * (lane >> 4)));
}
__device__ __forceinline__ bf16x8 frag_tr_sw(const bf16_t* tile, int k0, int c0, int lane) {
    const int row = k0 + 8 * (lane >> 4) + ((lane >> 2) & 3), col = c0 + 4 * (lane & 3);
    s16x4 lo = __builtin_amdgcn_ds_read_tr16_b64_v4i16((LAS s16x4*)(tile + sw64(row, col)));
    s16x4 hi = __builtin_amdgcn_ds_read_tr16_b64_v4i16((LAS s16x4*)(tile + sw64(row + 4, col)));
    bf16x8 r; r[0] = lo[0]; r[1] = lo[1]; r[2] = lo[2]; r[3] = lo[3]; r[4] = hi[0]; r[5] = hi[1]; r[6] = hi[2]; r[7] = hi[3];
    return r;
}


namespace pg8 {
#define PG8_LAS __attribute__((address_space(3)))
constexpr int BM = 256, BK = 64, HALF = 128, HTB = HALF * BK * 2  , STAGE_BYTES = 8 * HTB, NXCD = 8, WGM = 8;

__host__ __device__ __forceinline__ int lds_byte(int r, int c) { const int st = (r >> 4) * 2 + (c >> 5), rr = r & 15, cc = c & 31, ob = rr * 64 + cc * 2; return st * 1024 + (ob ^ (((ob >> 9) & 1) << 5)); }
__host__ __device__ __forceinline__ void stage_rc(int b, int& R, int& C) { const int st = b / 1024, sb = b % 1024, swz = sb ^ (((sb >> 9) & 1) << 5); R = (st >> 1) * 16 + swz / 64; C = (st & 1) * 32 + (swz % 64) / 2; }
__host__ __device__ __forceinline__ int perm32(int rho) { const int n = rho >> 4, i = rho & 15; return 8 * (i >> 2) + 4 * n + (i & 3); }
struct Unit { int pm, pn; };
struct Gemm { const bf16_t* A; const bf16_t* Bt; int M, N, K, lda; };
struct StaticOrder {
    int nM, nN, nwg, G, c;
    __host__ __device__ void init(int M, int N, int G_, int c_) { nM = M / BM; nN = N / BM; nwg = nM * nN; G = G_; c = c_; }
    __host__ __device__ bool next(int i, Unit& u) const {
        const long L = (long)i * G + c; if (L >= nwg) return false;
        int wgid = (int)L; { const int q = nwg / NXCD, r = nwg % NXCD, xcd = wgid % NXCD, off = wgid / NXCD; wgid = (xcd < r ? xcd * (q + 1) : r * (q + 1) + (xcd - r) * q) + off; }
        const int nig = WGM * nN, gid = wgid / nig, fm = gid * WGM, gsz = (nM - fm) < WGM ? (nM - fm) : WGM;
        u.pm = fm + ((wgid % nig) % gsz); u.pn = (wgid % nig) / gsz; return true;
    }
    __device__ __forceinline__ void a_ready(const Unit&) const {}
    __device__ __forceinline__ void done(const Unit&) const {}
};
template <class Epi, class Sched, bool ALIGN_EPI = false, bool SP2 = false>
__device__ __forceinline__ void gemm_phase(PG8_LAS unsigned char* lds, const Gemm g, const Sched& S, const Epi& E) {
    int tid_ = threadIdx.x; asm volatile("" : "+v"(tid_));
    const int tid = tid_, wid = __builtin_amdgcn_readfirstlane(tid >> 6), lane = tid & 63, wr = wid >> 2, wc = wid & 3, fr = lane & 15, fq = lane >> 4;
    const int K = g.K, nt = K / BK;
    unsigned voffA[2], voffB[2];
#pragma unroll
    for (int i = 0; i < 2; ++i) { int R, C; stage_rc(tid * 16 + i * 8192, R, C); const int Rb = Epi::PERM ? ((R & ~31) + perm32(R & 31)) : R;
        voffA[i] = (unsigned)(R * g.lda + C) * 2u; voffB[i] = (unsigned)(Rb * K + C) * 2u; }
    const size_t kstep = (size_t)(BK * 2);
    const size_t hstep = (size_t)HALF * K * 2;
    const size_t tstep = 2 * hstep;
    const size_t hstepA = (size_t)HALF * g.lda * 2, tstepA = 2 * hstepA;
    const unsigned ldsw = (unsigned)wid * 1024u;
    const int aoff = lds_byte(wr * 64 + fr, fq * 8), boff = lds_byte(wc * 32 + fr, fq * 8);
#define PG8_SA(b, h) (((b) * 2 + (h)) * HTB)
#define PG8_SB(b, h) ((4 + (b) * 2 + (h)) * HTB)
#define PG8_STAGE(bufoff, gbase, voff) do { _Pragma("unroll") for (int _i = 0; _i < 2; ++_i) \
        __builtin_amdgcn_global_load_lds((const unsigned*)((const char*)(gbase) + (voff)[_i]), (PG8_LAS unsigned*)(lds + (bufoff) + ldsw + _i * 8192), 16, 0, 0); } while (0)
#define PG8_LDA(dst, b, h) do { _Pragma("unroll") for (int m = 0; m < 4; ++m) _Pragma("unroll") for (int k = 0; k < 2; ++k) dst[m][k] = *(const PG8_LAS bf16x8*)(lds + PG8_SA(b, h) + aoff + m * 2048 + k * 1024); } while (0)
#define PG8_LDB(dst, b, h) do { _Pragma("unroll") for (int n = 0; n < 2; ++n) _Pragma("unroll") for (int k = 0; k < 2; ++k) dst[n][k] = *(const PG8_LAS bf16x8*)(lds + PG8_SB(b, h) + boff + n * 2048 + k * 1024); } while (0)
#define PG8_MMA(ai, bj, At, Bt) do { __builtin_amdgcn_s_setprio(1); _Pragma("unroll") for (int m = 0; m < 4; ++m) _Pragma("unroll") for (int n = 0; n < 2; ++n) _Pragma("unroll") for (int k = 0; k < 2; ++k) \
        acc[ai][bj][m][n] = __builtin_amdgcn_mfma_f32_16x16x32_bf16(Bt[n][k], At[m][k], acc[ai][bj][m][n], 0, 0, 0); __builtin_amdgcn_s_setprio(0); } while (0)
#define PG8_WAIT_V(n) asm volatile("s_waitcnt vmcnt(" #n ")" ::: "memory")
#define PG8_WAIT_L(n) asm volatile("s_waitcnt lgkmcnt(" #n ")" ::: "memory")
#define PG8_BAR __builtin_amdgcn_s_barrier()
#define PG8_SCHED __builtin_amdgcn_sched_barrier(0)
    Unit cur, nxt; int ui = 0;
    if (!S.next(0, cur)) return;
    f32x4 acc[2][2][4][2];
#pragma unroll
    for (int a = 0; a < 2; ++a)
#pragma unroll
        for (int b = 0; b < 2; ++b)
#pragma unroll
            for (int m = 0; m < 4; ++m)
#pragma unroll
                for (int n = 0; n < 2; ++n) acc[a][b][m][n] = (f32x4){0.f, 0.f, 0.f, 0.f};
    bf16x8 At[4][2], B0[2][2], B1[2][2];
    const char* cA = (const char*)g.A + (size_t)cur.pm * tstepA; const char* cB = (const char*)g.Bt + (size_t)cur.pn * tstep;
    S.a_ready(cur);
    if constexpr (SP2) {
        PG8_STAGE(PG8_SB(0, 0), cB, voffB); PG8_STAGE(PG8_SB(0, 1), cB + hstep, voffB); PG8_STAGE(PG8_SA(0, 0), cA, voffA); PG8_STAGE(PG8_SA(0, 1), cA + hstepA, voffA);
        if (wr == 1) PG8_BAR;
        PG8_WAIT_V(2); PG8_BAR;
        PG8_STAGE(PG8_SB(1, 0), cB + kstep, voffB); PG8_STAGE(PG8_SA(1, 0), cA + kstep, voffA); PG8_STAGE(PG8_SB(1, 1), cB + hstep + kstep, voffB);
        PG8_WAIT_V(6); PG8_BAR;
    } else {
        PG8_STAGE(PG8_SB(0, 0), cB, voffB); PG8_STAGE(PG8_SA(0, 0), cA, voffA); PG8_STAGE(PG8_SB(0, 1), cB + hstep, voffB); PG8_STAGE(PG8_SA(0, 1), cA + hstepA, voffA);
        if (wr == 1) PG8_BAR;
        PG8_WAIT_V(4); PG8_BAR;
        PG8_STAGE(PG8_SB(1, 0), cB + kstep, voffB); PG8_STAGE(PG8_SA(1, 0), cA + kstep, voffA); PG8_STAGE(PG8_SB(1, 1), cB + hstep + kstep, voffB);
        PG8_WAIT_V(6); PG8_BAR;
    }
    for (;;) {
        const bool has_next = S.next(ui + 1, nxt);
        const char* nA = has_next ? (const char*)g.A + (size_t)nxt.pm * tstepA : cA; const char* nB = has_next ? (const char*)g.Bt + (size_t)nxt.pn * tstep : cB;
        for (int t = 0; t < nt; t += 2) {
            const bool last = (t == nt - 2);
            const char* a1 = cA + (size_t)(t + 1) * kstep;
            const char* a2 = last ? nA : cA + (size_t)(t + 2) * kstep; const char* b2 = last ? nB : cB + (size_t)(t + 2) * kstep;
            const char* a3 = a2 + kstep; const char* b3 = b2 + kstep;
            if (last && has_next) S.a_ready(nxt);
            if constexpr (SP2) {
            PG8_LDB(B0, 0, 0); PG8_LDB(B1, 0, 1); PG8_SCHED; PG8_LDA(At, 0, 0); PG8_STAGE(PG8_SA(1, 1), a1 + hstepA, voffA);
            PG8_WAIT_V(8); PG8_WAIT_L(0); PG8_BAR; PG8_MMA(0, 0, At, B0); PG8_MMA(0, 1, At, B1); PG8_BAR; PG8_SCHED;
            PG8_LDA(At, 0, 1); PG8_STAGE(PG8_SB(0, 0), b2, voffB); PG8_STAGE(PG8_SB(0, 1), b2 + hstep, voffB); PG8_STAGE(PG8_SA(0, 0), a2, voffA);
            PG8_WAIT_V(8); PG8_WAIT_L(0); PG8_BAR; PG8_MMA(1, 0, At, B0); PG8_MMA(1, 1, At, B1); PG8_BAR; PG8_SCHED;
            PG8_LDB(B0, 1, 0); PG8_LDB(B1, 1, 1); PG8_SCHED; PG8_LDA(At, 1, 0); PG8_STAGE(PG8_SA(0, 1), a2 + hstepA, voffA);
            PG8_WAIT_V(8); PG8_WAIT_L(0); PG8_BAR; PG8_MMA(0, 0, At, B0); PG8_MMA(0, 1, At, B1); PG8_BAR; PG8_SCHED;
            PG8_LDA(At, 1, 1); PG8_STAGE(PG8_SB(1, 0), b3, voffB); PG8_STAGE(PG8_SB(1, 1), b3 + hstep, voffB); PG8_STAGE(PG8_SA(1, 0), a3, voffA);
            PG8_WAIT_V(8); PG8_WAIT_L(0); PG8_BAR; PG8_MMA(1, 0, At, B0); PG8_MMA(1, 1, At, B1); PG8_BAR; PG8_SCHED;
            } else {
            PG8_LDB(B0, 0, 0); PG8_SCHED; PG8_LDA(At, 0, 0); PG8_STAGE(PG8_SA(1, 1), a1 + hstepA, voffA);
            PG8_WAIT_L(8); PG8_BAR; PG8_WAIT_L(0); PG8_MMA(0, 0, At, B0); PG8_BAR; PG8_SCHED;
            PG8_LDB(B1, 0, 1); PG8_STAGE(PG8_SB(0, 0), b2, voffB);
            PG8_BAR; PG8_WAIT_L(0); PG8_MMA(0, 1, At, B1); PG8_BAR;
            PG8_LDA(At, 0, 1); PG8_STAGE(PG8_SA(0, 0), a2, voffA);
            PG8_BAR; PG8_WAIT_L(0); PG8_MMA(1, 0, At, B0); PG8_BAR; PG8_SCHED;
            PG8_STAGE(PG8_SB(0, 1), b2 + hstep, voffB);
            PG8_WAIT_V(6); PG8_BAR; PG8_MMA(1, 1, At, B1); PG8_BAR;
            PG8_LDB(B0, 1, 0); PG8_SCHED; PG8_LDA(At, 1, 0); PG8_STAGE(PG8_SA(0, 1), a2 + hstepA, voffA);
            PG8_WAIT_L(8); PG8_BAR; PG8_WAIT_L(0); PG8_MMA(0, 0, At, B0); PG8_BAR; PG8_SCHED;
            PG8_LDB(B1, 1, 1); PG8_STAGE(PG8_SB(1, 0), b3, voffB);
            PG8_BAR; PG8_WAIT_L(0); PG8_MMA(0, 1, At, B1); PG8_BAR;
            PG8_LDA(At, 1, 1); PG8_STAGE(PG8_SA(1, 0), a3, voffA);
            PG8_BAR; PG8_WAIT_L(0); PG8_MMA(1, 0, At, B0); PG8_BAR; PG8_SCHED;
            PG8_STAGE(PG8_SB(1, 1), b3 + hstep, voffB);
            PG8_WAIT_V(6); PG8_BAR; PG8_MMA(1, 1, At, B1); PG8_BAR;
            }
        }
        if constexpr (ALIGN_EPI) { if (wr == 0) PG8_BAR; }
        if constexpr (!Epi::AFTER_DRAIN) { E(acc, cur, wr, wc, fr, fq); S.done(cur); }
        if (!has_next) break;
#pragma unroll
        for (int a = 0; a < 2; ++a)
#pragma unroll
            for (int b = 0; b < 2; ++b)
#pragma unroll
                for (int m = 0; m < 4; ++m)
#pragma unroll
                    for (int n = 0; n < 2; ++n) acc[a][b][m][n] = (f32x4){0.f, 0.f, 0.f, 0.f};
        cur = nxt; cA = nA; cB = nB; ++ui;
        if constexpr (ALIGN_EPI) { if (wr == 1) PG8_BAR; }
    }
    PG8_WAIT_V(0);
    if constexpr (!ALIGN_EPI) { if (wr == 0) PG8_BAR; }
    PG8_BAR;
    if constexpr (Epi::AFTER_DRAIN) { E.fused(acc, cur, wr, wc, fr, fq, lds, wid, lane); S.done(cur); }
#undef PG8_SA
#undef PG8_SB
#undef PG8_STAGE
#undef PG8_LDA
#undef PG8_LDB
#undef PG8_MMA
#undef PG8_WAIT_V
#undef PG8_WAIT_L
#undef PG8_BAR
#undef PG8_SCHED
}
}

template <class E> struct PgEpi {
    static constexpr bool PERM = true, AFTER_DRAIN = false;
    E e;
    __device__ __forceinline__ void operator()(const f32x4 (&acc)[2][2][4][2], const pg8::Unit& u, int wr, int wc, int fr, int fq) const {
#pragma unroll
        for (int ai = 0; ai < 2; ++ai)
#pragma unroll
            for (int m = 0; m < 4; ++m) {
                const int row = u.pm * 256 + ai * 128 + wr * 64 + m * 16 + fr;
                const float rs = e.rowscale(row);
#pragma unroll
                for (int bj = 0; bj < 2; ++bj) e(row, u.pn * 256 + bj * 128 + wc * 32 + fq * 8, acc[ai][bj][m][0], acc[ai][bj][m][1], rs);
            }
    }
};
struct XcdOrder {
    int nM, nN, G8, c, tmx, perX;
    __device__ void init(int M, int N, int G_, int c_) { nM = M / 256; nN = N / 256; G8 = G_ >> 3; c = c_; tmx = nM >> 3; perX = tmx * nN; }
    __device__ bool next(int i, pg8::Unit& u) const {
        const int j = i * G8 + (c >> 3); if (j >= perX) return false;
        const int pn = j / tmx; u.pn = pn; u.pm = (c & 7) * tmx + (j - pn * tmx); return true;
    }
    __device__ __forceinline__ void a_ready(const pg8::Unit&) const {}
    __device__ __forceinline__ void done(const pg8::Unit&) const {}
};
#define GEMM_ORDER 0
template <class E>
__device__ __forceinline__ void run_gemm(const bf16_t* A, int lda, const bf16_t* Bt, int N, int K, const E& e, char* smem) {
    pg8::Gemm g{A, Bt, TOK, N, K, lda};
    PgEpi<E> pe{e};
#if GEMM_ORDER
    XcdOrder S; S.init(TOK, N, (int)gridDim.x, (int)blockIdx.x);
    pg8::gemm_phase<PgEpi<E>, XcdOrder, true, true>((LAS unsigned char*)smem, g, S, pe);
#else
    pg8::StaticOrder S; S.init(TOK, N, (int)gridDim.x, (int)blockIdx.x);
    pg8::gemm_phase<PgEpi<E>, pg8::StaticOrder, true, true>((LAS unsigned char*)smem, g, S, pe);
#endif
}

__device__ __forceinline__ u32x4 pack44(f32x4 a, f32x4 b) { u32x4 r; r.x = pack2(a[0], a[1]); r.y = pack2(a[2], a[3]); r.z = pack2(b[0], b[1]); r.w = pack2(b[2], b[3]); return r; }
__device__ __forceinline__ void unpack44(u32x4 u, f32x4& a, f32x4& b) { a[0] = bflo(u.x); a[1] = bfhi(u.x); a[2] = bflo(u.y); a[3] = bfhi(u.y); b[0] = bflo(u.z); b[1] = bfhi(u.z); b[2] = bflo(u.w); b[3] = bfhi(u.w); }
__device__ __forceinline__ f32x4 silu4(f32x4 v) { f32x4 s; s[0] = siluf(v[0]); s[1] = siluf(v[1]); s[2] = siluf(v[2]); s[3] = siluf(v[3]); return s; }
__device__ __forceinline__ f32x4 gelu4(f32x4 v) { f32x4 s; s[0] = geluf(v[0]); s[1] = geluf(v[1]); s[2] = geluf(v[2]); s[3] = geluf(v[3]); return s; }
struct EpiSSD {
    bf16_t* Uz; bf16_t* Uxbc; float* DT; const float* dt_bias;
    __device__ __forceinline__ float rowscale(int) const { return 1.f; }
    __device__ __forceinline__ void operator()(int row, int col, f32x4 v0, f32x4 v1, float) const {
        if (col < 2048) { *(u32x4*)(Uz + (size_t)row * 2048 + col) = pack44(silu4(v0), silu4(v1)); }
        else if (col < 6144) { *(u32x4*)(Uxbc + (size_t)row * 4096 + (col - 2048)) = pack44(v0, v1); }
        else if (col < 6208) { const int c = col - 6144; const f32x4 b0 = *(const f32x4*)(dt_bias + c), b1 = *(const f32x4*)(dt_bias + c + 4);
            *(f32x4*)(DT + (size_t)row * 64 + c) = v0 + b0; *(f32x4*)(DT + (size_t)row * 64 + c + 4) = v1 + b1; }
    }
};
struct EpiMLP {
    bf16_t* U;
    __device__ __forceinline__ float rowscale(int) const { return 1.f; }
    __device__ __forceinline__ void operator()(int row, int col, f32x4 v0, f32x4 v1, float) const {
        u32x4 o;
        if (col < 4096) o = pack44(gelu4(v0), gelu4(v1)); else o = pack44(silu4(v0), silu4(v1));
        *(u32x4*)(U + (size_t)row * 6144 + col) = o;
    }
};
struct EpiS5 {
    bf16_t* Uu; bf16_t* Uz;
    __device__ __forceinline__ float rowscale(int) const { return 1.f; }
    __device__ __forceinline__ void operator()(int row, int col, f32x4 v0, f32x4 v1, float) const {
        if (col < 2048) *(u32x4*)(Uu + (size_t)row * 2048 + col) = pack44(v0, v1);
        else *(u32x4*)(Uz + (size_t)row * 2048 + (col - 2048)) = pack44(silu4(v0), silu4(v1));
    }
};
struct EpiNAT {
    bf16_t* Q; bf16_t* Z; bf16_t* Kl; bf16_t* Vl; float* ck; float* cv;
    __device__ __forceinline__ float rowscale(int) const { return 1.f; }
    __device__ __forceinline__ void operator()(int row, int col, f32x4 v0, f32x4 v1, float) const {
        if (col < 2048) { *(u32x4*)(Q + (size_t)row * 2048 + col) = pack44(v0 * 0.125f, v1 * 0.125f); }
        else if (col < 6144) {
            const bool isv = col >= 4096; const int c = col - (isv ? 4096 : 2048);
            if (row < TOKC) { const int b = row >> 8, s = row & 255, h = c >> 6, d = c & 63; float* dst = (isv ? cv : ck) + ((size_t)((b * 32 + h) * 256 + s)) * 64 + d; *(f32x4*)dst = v0; *(f32x4*)(dst + 4) = v1; }
            else { bf16_t* dst = (isv ? Vl : Kl) + (size_t)(row - TOKC) * 2048 + c; *(u32x4*)dst = pack44(v0, v1); }
        } else { *(u32x4*)(Z + (size_t)row * 2048 + (col - 6144)) = pack44(silu4(v0), silu4(v1)); }
    }
};
struct EpiOut {
    const float* xp; const float* xs; float* X; const float* modl; const float* ssq; int first;
    __device__ __forceinline__ float rowscale(int row) const {
        if (!ssq) return 1.f;
        const f32x4* p = (const f32x4*)(ssq + (size_t)row * 32); float s = 0.f;
#pragma unroll
        for (int i = 0; i < 8; ++i) { f32x4 v = p[i]; s += (v[0] + v[1]) + (v[2] + v[3]); }
        return rsqrtf(s * (1.f / 2048.f) + EPSN);
    }
    __device__ __forceinline__ void operator()(int row, int col, f32x4 v0, f32x4 v1, float rs) const {
        const float* gp = modl + cond_idx(row) * 3072 + 2048 + col;
        const f32x4 g0 = *(const f32x4*)gp, g1 = *(const f32x4*)(gp + 4);
        const float* xin = (first ? (row < TOKC ? xp + (size_t)row * 1024 : xs + (size_t)(row - TOKC) * 1024) : X + (size_t)row * 1024) + col;
        const f32x4 x0 = *(const f32x4*)xin, x1 = *(const f32x4*)(xin + 4);
        float* o = X + (size_t)row * 1024 + col;
        *(f32x4*)o = x0 + g0 * (v0 * rs); *(f32x4*)(o + 4) = x1 + g1 * (v1 * rs);
    }
};
struct EpiGLU {
    const bf16_t* Yb; bf16_t* Uz; const float* bglu;
    __device__ __forceinline__ float rowscale(int) const { return 1.f; }
    __device__ __forceinline__ void operator()(int row, int col, f32x4 v0, f32x4 v1, float) const {
        f32x4 y0, y1, z0, z1; unpack44(*(const u32x4*)(Yb + (size_t)row * 2048 + col), y0, y1); unpack44(*(const u32x4*)(Uz + (size_t)row * 2048 + col), z0, z1);
        const f32x4 b0 = *(const f32x4*)(bglu + col), b1 = *(const f32x4*)(bglu + col + 4);
        f32x4 o0, o1;
#pragma unroll
        for (int i = 0; i < 4; ++i) { o0[i] = y0[i] * sigmf(v0[i] + b0[i]) * z0[i]; o1[i] = y1[i] * sigmf(v1[i] + b1[i]) * z1[i]; }
        *(u32x4*)(Uz + (size_t)row * 2048 + col) = pack44(o0, o1);
    }
};

__device__ __forceinline__ void prep_phase(const Params& p, char* smem) {
    int tid_ = threadIdx.x; asm volatile("" : "+v"(tid_));
    const int tid = tid_, lane = tid & 63, wid = tid >> 6;
    float* tile = (float*)smem;
    for (int T4 = blockIdx.x; T4 < (p.total_tiles >> 2); T4 += gridDim.x) {
        const int T = T4 * 4;
        int j = 0;
#pragma unroll
        for (int q = 1; q < 9; ++q) if (T >= p.jobs[q].tile0) j = q;
        const float* src = p.jobs[j].src; bf16_t* dst = p.jobs[j].dst; const int K = p.jobs[j].K, N = p.jobs[j].N;
        const int local = T - p.jobs[j].tile0, nkt = K >> 6, kt = local % nkt, nt = local / nkt, k0 = kt * 64, n0 = nt * 64;
        __syncthreads();
        if (n0 < N) {
            f32x4 v[8];
#pragma unroll
            for (int q = 0; q < 8; ++q) { const int idx = tid + NT * q, r = idx >> 4, c4 = idx & 15; v[q] = *(const f32x4*)(src + (size_t)(k0 + r) * N + n0 + c4 * 4); }
#pragma unroll
            for (int q = 0; q < 8; ++q) { const int idx = tid + NT * q, r = idx >> 4, c4 = idx & 15; float* tp = tile + (r >> 6) * 4160 + (r & 63) * 65 + c4 * 4;
                tp[0] = v[q][0]; tp[1] = v[q][1]; tp[2] = v[q][2]; tp[3] = v[q][3]; }
        }
        __syncthreads();
        {
            const int nn = tid >> 3, kc = tid & 7;
#pragma unroll
            for (int s = 0; s < 4; ++s) { float f[8];
#pragma unroll
                for (int i = 0; i < 8; ++i) f[i] = (n0 < N) ? tile[s * 4160 + (kc * 8 + i) * 65 + nn] : 0.f;
                *(u32x4*)(dst + (size_t)(n0 + nn) * K + k0 + s * 64 + kc * 8) = pack8(f); }
        }
    }
    __syncthreads();
    float* sc = (float*)smem;
    float* part = (float*)smem + 3072;
    for (int q = tid; q < 3072; q += NT) { const int ci = q >> 10, k = q & 1023; const float cv = ci == 0 ? p.in[7][k] : p.in[6][(ci - 1) * 1024 + k]; sc[q] = siluf(cv); }
    __syncthreads();
    float* MOD = (float*)(p.ws + WS_MOD);
    for (int it = blockIdx.x; it < 192; it += gridDim.x) {
        const int layer = it / 48, cg0 = (it % 48) * 64, col = cg0 + lane;
        const float* w = p.in[9] + (size_t)layer * 1024 * 3072 + col;
        float a0 = 0.f, a1 = 0.f, a2 = 0.f;
        for (int k = wid * 128; k < wid * 128 + 128; k += 16) { float wv[16];
#pragma unroll
            for (int u = 0; u < 16; ++u) wv[u] = w[(size_t)(k + u) * 3072];
#pragma unroll
            for (int u = 0; u < 16; ++u) { a0 += sc[k + u] * wv[u]; a1 += sc[1024 + k + u] * wv[u]; a2 += sc[2048 + k + u] * wv[u]; } }
        part[(wid * 3 + 0) * 64 + lane] = a0; part[(wid * 3 + 1) * 64 + lane] = a1; part[(wid * 3 + 2) * 64 + lane] = a2;
        __syncthreads();
        if (tid < 192) { const int ci = tid >> 6, l = tid & 63; float s = p.in[10][layer * 3072 + cg0 + l];
#pragma unroll
            for (int w8 = 0; w8 < 8; ++w8) s += part[(w8 * 3 + ci) * 64 + l];
            MOD[(layer * 3 + ci) * 3072 + cg0 + l] = s; }
        __syncthreads();
    }
}

__device__ __forceinline__ void norm_phase(const Params& p, int layer) {
    const int tid = otid(), lane = tid & 63, gw = blockIdx.x * 8 + (tid >> 6), nw = gridDim.x * 8;
    const float* g = p.in[8] + layer * 1024;
    const float* MOD = (const float*)(p.ws + WS_MOD) + layer * 3 * 3072;
    bf16_t* H = (bf16_t*)(p.ws + WS_H);
    for (int tb = gw; tb < TOK; tb += 3 * nw) {
        f32x4 v[3][4]; float ss[3];
#pragma unroll
        for (int r = 0; r < 3; ++r) { const int t = tb + r * nw; ss[r] = 0.f;
            if (t < TOK) { const float* xr = layer == 0 ? (t < TOKC ? p.in[0] + (size_t)t * 1024 : p.in[1] + (size_t)(t - TOKC) * 1024) : p.out + (size_t)t * 1024;
#pragma unroll
                for (int j = 0; j < 4; ++j) v[r][j] = *(const f32x4*)(xr + j * 256 + lane * 4); } }
#pragma unroll
        for (int r = 0; r < 3; ++r) { const int t = tb + r * nw;
            if (t < TOK) {
#pragma unroll
                for (int j = 0; j < 4; ++j) ss[r] += v[r][j][0] * v[r][j][0] + v[r][j][1] * v[r][j][1] + v[r][j][2] * v[r][j][2] + v[r][j][3] * v[r][j][3];
                ss[r] = wave_sum(ss[r]);
                const float rstd = rsqrtf(ss[r] * (1.f / 1024.f) + EPSN);
                const float* md = MOD + cond_idx(t) * 3072;
#pragma unroll
                for (int j = 0; j < 4; ++j) {
                    const int c = j * 256 + lane * 4;
                    const f32x4 gg = *(const f32x4*)(g + c), sh = *(const f32x4*)(md + c), scl = *(const f32x4*)(md + 1024 + c);
                    f32x4 h; for (int i = 0; i < 4; ++i) h[i] = v[r][j][i] * rstd * gg[i] * (1.f + scl[i]) + sh[i];
                    *(u32x2*)(H + (size_t)t * 1024 + c) = pack4(h);
                }
            } }
    }
}
__device__ __forceinline__ void final_phase(const Params& p) {
    const int tid = otid(), lane = tid & 63, gw = blockIdx.x * 8 + (tid >> 6), nw = gridDim.x * 8;
    const float* g = p.in[12];
    for (int tb = gw; tb < TOK; tb += 3 * nw) {
        f32x4 v[3][4];
#pragma unroll
        for (int r = 0; r < 3; ++r) { const int t = tb + r * nw;
            if (t < TOK) { const float* xr = p.out + (size_t)t * 1024;
#pragma unroll
                for (int j = 0; j < 4; ++j) v[r][j] = *(const f32x4*)(xr + j * 256 + lane * 4); } }
#pragma unroll
        for (int r = 0; r < 3; ++r) { const int t = tb + r * nw;
            if (t < TOK) { float ss = 0.f; float* xr = p.out + (size_t)t * 1024;
#pragma unroll
                for (int j = 0; j < 4; ++j) ss += v[r][j][0] * v[r][j][0] + v[r][j][1] * v[r][j][1] + v[r][j][2] * v[r][j][2] + v[r][j][3] * v[r][j][3];
                ss = wave_sum(ss);
                const float rstd = rsqrtf(ss * (1.f / 1024.f) + EPSN);
#pragma unroll
                for (int j = 0; j < 4; ++j) { const int c = j * 256 + lane * 4; const f32x4 gg = *(const f32x4*)(g + c); *(f32x4*)(xr + c) = v[r][j] * rstd * gg; } } }
    }
}

__device__ __forceinline__ void ssd_conv_phase(const Params& p, const bf16_t* Uxbc, bf16_t* XBC) {
    int tid_ = threadIdx.x; asm volatile("" : "+v"(tid_));
    const int tid = tid_, lane = tid & 63, wid = tid >> 6;
    float* DT = (float*)(p.ws + WS_DT);
    float* ACUM = (float*)(p.ws + WS_ACUM);
    for (int ch = blockIdx.x * 8 + wid; ch < NCHUNK; ch += gridDim.x * 8) {
        const int t0 = ch * 128, d = lane >> 5;
        const float a = -__expf(p.in[17][lane]);
        float acc = 0.f;
        for (int i = 0; i < 128; ++i) { const int l = d ? 127 - i : i; const float dtv = softplusf(DT[(size_t)(t0 + l) * 64 + lane]); DT[(size_t)(t0 + l) * 64 + lane] = dtv; acc += dtv * a; ACUM[(size_t)(t0 + l) * 64 + lane] = acc; }
    }
    const int chn = tid * 8;
    float w[5][8], bias[8];
#pragma unroll
    for (int j = 0; j < 5; ++j) { const f32x4 a = *(const f32x4*)(p.in[14] + j * 4096 + chn), b = *(const f32x4*)(p.in[14] + j * 4096 + chn + 4);
        w[j][0] = a[0]; w[j][1] = a[1]; w[j][2] = a[2]; w[j][3] = a[3]; w[j][4] = b[0]; w[j][5] = b[1]; w[j][6] = b[2]; w[j][7] = b[3]; }
    { const f32x4 a = *(const f32x4*)(p.in[15] + chn), b = *(const f32x4*)(p.in[15] + chn + 4);
      bias[0] = a[0]; bias[1] = a[1]; bias[2] = a[2]; bias[3] = a[3]; bias[4] = b[0]; bias[5] = b[1]; bias[6] = b[2]; bias[7] = b[3]; }
    for (int grp = blockIdx.x; grp < TOK / 8; grp += gridDim.x) {
        const int t0 = grp * 8;
        int s0, s1;
        if (t0 < TOKC) { s0 = t0 & ~255; s1 = s0 + 256; } else { s0 = TOKC + ((t0 - TOKC) & ~2047); s1 = s0 + 2048; }
        u32x4 rowv[12];
#pragma unroll
        for (int i = 0; i < 12; ++i) { const int tt = t0 - 2 + i; rowv[i] = (u32x4){0u, 0u, 0u, 0u};
            if (tt >= s0 && tt < s1) rowv[i] = *(const u32x4*)(Uxbc + (size_t)tt * 4096 + chn); }
#pragma unroll
        for (int o = 0; o < 8; ++o) {
            float acc[8];
#pragma unroll
            for (int i = 0; i < 8; ++i) acc[i] = bias[i];
#pragma unroll
            for (int j = 0; j < 5; ++j) { float f[8]; unpack8(rowv[o + j], f);
#pragma unroll
                for (int i = 0; i < 8; ++i) acc[i] += w[j][i] * f[i]; }
#pragma unroll
            for (int i = 0; i < 8; ++i) acc[i] = siluf(acc[i]);
            *(u32x4*)(XBC + (size_t)(t0 + o) * 4096 + chn) = pack8(acc);
        }
    }
}

__device__ __forceinline__ void ssd_state_phase(const Params& p, const bf16_t* XBC, bf16_t* SB, char* smem) {
    int tid_ = threadIdx.x; asm volatile("" : "+v"(tid_));
    const int tid = tid_, lane = tid & 63, wid = tid >> 6;
    const float* DT = (const float*)(p.ws + WS_DT);
    const float* ACUM = (const float*)(p.ws + WS_ACUM);
    bf16_t* Bt = (bf16_t*)smem;
    bf16_t* Xf = Bt + 128 * 136;
    bf16_t* Xb = Xf + 128 * 72;
    for (int item = blockIdx.x; item < NCHUNK * 8; item += gridDim.x) {
        const int ch = item >> 3, g = item & 7, t0 = ch * 128;
        __syncthreads();
#pragma unroll
        for (int j = 0; j < 4; ++j) { const int q = tid + NT * j, row = q >> 4, c = q & 15;
            *(u32x4*)(Bt + row * 136 + c * 8) = *(const u32x4*)(XBC + (size_t)(t0 + row) * 4096 + 2048 + g * 128 + c * 8); }
        for (int hh = 0; hh < 4; ++hh) {
            const int h = g * 4 + hh;
            __syncthreads();
            const float af_last = ACUM[(size_t)(t0 + 127) * 64 + h], sb_first = ACUM[(size_t)t0 * 64 + 32 + h];
#pragma unroll
            for (int j = 0; j < 2; ++j) { const int q = tid + NT * j, row = q >> 3, c = q & 7; const size_t tr = (size_t)(t0 + row);
                const float wf = __expf(af_last - ACUM[tr * 64 + h]) * DT[tr * 64 + h];
                const float wb = __expf(sb_first - ACUM[tr * 64 + 32 + h]) * DT[tr * 64 + 32 + h];
                float f[8], o[8]; unpack8(*(const u32x4*)(XBC + tr * 4096 + h * 64 + c * 8), f);
#pragma unroll
                for (int i = 0; i < 8; ++i) o[i] = f[i] * wf;
                *(u32x4*)(Xf + row * 72 + c * 8) = pack8(o);
#pragma unroll
                for (int i = 0; i < 8; ++i) o[i] = f[i] * wb;
                *(u32x4*)(Xb + row * 72 + c * 8) = pack8(o); }
            __syncthreads();
            const int dir = wid >> 2, nq = wid & 3;
            const bf16_t* Xd = dir ? Xb : Xf;
            f32x4 acc[4][2];
#pragma unroll
            for (int a = 0; a < 4; ++a) { acc[a][0] = (f32x4){0.f, 0.f, 0.f, 0.f}; acc[a][1] = (f32x4){0.f, 0.f, 0.f, 0.f}; }
#pragma unroll
            for (int ks = 0; ks < 4; ++ks) {
                bf16x8 xa[4], bb[2];
#pragma unroll
                for (int a = 0; a < 4; ++a) xa[a] = frag_tr(Xd, 72, ks * 32, a * 16, lane);
#pragma unroll
                for (int b = 0; b < 2; ++b) bb[b] = frag_tr(Bt, 136, ks * 32, nq * 32 + b * 16, lane);
#pragma unroll
                for (int a = 0; a < 4; ++a)
#pragma unroll
                    for (int b = 0; b < 2; ++b) acc[a][b] = mfma16(bb[b], xa[a], acc[a][b]);
            }
            bf16_t* dst = SB + ((size_t)((ch * 2 + dir) * 32 + h)) * 8192;
#pragma unroll
            for (int a = 0; a < 4; ++a)
#pragma unroll
                for (int b = 0; b < 2; ++b) { const int pp = a * 16 + (lane & 15), n = nq * 32 + b * 16 + (lane >> 4) * 4;
                    *(u32x2*)(dst + pp * 128 + n) = pack4(acc[a][b]); }
        }
    }
}

__device__ __forceinline__ void ssd_scan_phase(const Params& p, bf16_t* SB) {
    const int tid = otid();
    const float* ACUM = (const float*)(p.ws + WS_ACUM);
    for (int item = blockIdx.x; item < 34 * 64; item += gridDim.x) {
        const int seq = item >> 6, d = (item >> 5) & 1, h = item & 31;
        const int nc = seq < 32 ? 2 : 16, ch0 = seq < 32 ? seq * 2 : 64 + (seq - 32) * 16;
#pragma unroll
        for (int j = 0; j < 2; ++j) {
            const int e = (tid + NT * j) * 8;
            float st[8];
            if (seq >= 32) { const float* h0 = p.in[2] + ((size_t)(((seq - 32) * 2 + d) * 32 + h)) * 8192 + e; const f32x4 a = *(const f32x4*)h0, b = *(const f32x4*)(h0 + 4);
                st[0] = a[0]; st[1] = a[1]; st[2] = a[2]; st[3] = a[3]; st[4] = b[0]; st[5] = b[1]; st[6] = b[2]; st[7] = b[3]; }
            else {
#pragma unroll
                for (int i = 0; i < 8; ++i) st[i] = 0.f; }
            for (int ci = 0; ci < nc; ++ci) {
                const int c = d ? nc - 1 - ci : ci, ch = ch0 + c, t0 = ch * 128;
                const float tot = d ? ACUM[(size_t)t0 * 64 + 32 + h] : ACUM[(size_t)(t0 + 127) * 64 + h];
                bf16_t* ptr = SB + ((size_t)((ch * 2 + d) * 32 + h)) * 8192 + e;
                float s[8]; unpack8(*(const u32x4*)ptr, s);
                *(u32x4*)ptr = pack8(st);
                const float dec = __expf(tot);
#pragma unroll
                for (int i = 0; i < 8; ++i) st[i] = dec * st[i] + s[i];
            }
            if (seq < 32) { float* o = p.out + OUT_SSD + ((size_t)((seq * 2 + d) * 32 + h)) * 8192 + e;
                *(f32x4*)o = (f32x4){st[0], st[1], st[2], st[3]}; *(f32x4*)(o + 4) = (f32x4){st[4], st[5], st[6], st[7]}; }
        }
    }
}

template <bool DRY>
__device__ __forceinline__ void ssd_out_phase(const Params& p, const bf16_t* XBC, const bf16_t* SB, bf16_t* Uz, char* smem) {
    int tid_ = threadIdx.x; asm volatile("" : "+v"(tid_));
    const int tid = tid_, lane = tid & 63, wid = tid >> 6;
    const float* DT = (const float*)(p.ws + WS_DT);
    const float* ACUM = (const float*)(p.ws + WS_ACUM);
    float* SSQ = (float*)(p.ws + WS_SSQ);
    bf16_t* Ct = (bf16_t*)smem;
    bf16_t* R1 = Ct + 128 * 136;
    bf16_t* Mt = R1 + 128 * 136;
    bf16_t* Xt = Mt + 128 * 136;
    float* vec = (float*)(Xt + 128 * 72);
    for (int item = blockIdx.x; item < NCHUNK * 8; item += gridDim.x) {
        const int ch = item >> 3, g = item & 7, t0 = ch * 128;
        __syncthreads();
#pragma unroll
        for (int j = 0; j < 4; ++j) { const int q = tid + NT * j, row = q >> 4, c = q & 15; const bf16_t* src = XBC + (size_t)(t0 + row) * 4096 + g * 128 + c * 8;
            *(u32x4*)(R1 + row * 136 + c * 8) = *(const u32x4*)(src + 2048);
            *(u32x4*)(Ct + row * 136 + c * 8) = *(const u32x4*)(src + 3072); }
#pragma unroll
        for (int j = 0; j < 4; ++j) { const int idx = tid + NT * j, kind = idx >> 9, hh = (idx >> 7) & 3, l = idx & 127; const int h = g * 4 + hh;
            const float* srcp = (kind < 2 ? ACUM : DT) + (size_t)(t0 + l) * 64 + (kind & 1) * 32 + h;
            vec[idx] = *srcp; }
        __syncthreads();
        f32x4 gacc[8];
#pragma unroll
        for (int st = 0; st < 8; ++st) gacc[st] = (f32x4){0.f, 0.f, 0.f, 0.f};
#pragma unroll
        for (int ks = 0; ks < 4; ++ks) {
            const bf16x8 cf = frag_rm(Ct, 136, 16 * wid, ks * 32, lane);
#pragma unroll
            for (int st = 0; st < 8; ++st) gacc[st] = mfma16(frag_rm(R1, 136, st * 16, ks * 32, lane), cf, gacc[st]);
        }
        const int l = 16 * wid + (lane & 15);
        for (int hh = 0; hh < 4; ++hh) {
            const int h = g * 4 + hh;
            const float* Af = vec + hh * 128; const float* Sb = vec + 512 + hh * 128; const float* dtf = vec + 1024 + hh * 128; const float* dtb = vec + 1536 + hh * 128;
            __syncthreads();
#pragma unroll
            for (int j = 0; j < 2; ++j) { const int q = tid + NT * j, row = q >> 3, c = q & 7;
                *(u32x4*)(Xt + row * 72 + c * 8) = *(const u32x4*)(XBC + (size_t)(t0 + row) * 4096 + h * 64 + c * 8); }
#pragma unroll
            for (int j = 0; j < 4; ++j) { const int q = tid + NT * j, dd = q >> 10, row = (q >> 4) & 63, c = q & 15;
                *(u32x4*)(R1 + (dd * 64 + row) * 136 + c * 8) = *(const u32x4*)(SB + ((size_t)((ch * 2 + dd) * 32 + h)) * 8192 + row * 128 + c * 8); }
            {
                const float afl = Af[l], sbl = Sb[l];
#pragma unroll
                for (int st = 0; st < 8; ++st) {
                    f32x4 m;
#pragma unroll
                    for (int r = 0; r < 4; ++r) { const int s = st * 16 + (lane >> 4) * 4 + r;
                        float wgt = 0.f;
                        if (s <= l) wgt += __expf(afl - Af[s]) * dtf[s];
                        if (s >= l) wgt += __expf(sbl - Sb[s]) * dtb[s];
                        m[r] = gacc[st][r] * wgt; }
                    *(u32x2*)(Mt + l * 136 + st * 16 + (lane >> 4) * 4) = pack4(m);
                }
            }
            __syncthreads();
            f32x4 ad[4], af[4], ab[4];
#pragma unroll
            for (int a = 0; a < 4; ++a) { ad[a] = (f32x4){0.f, 0.f, 0.f, 0.f}; af[a] = ad[a]; ab[a] = ad[a]; }
#pragma unroll
            for (int ks = 0; ks < 4; ++ks) {
                const bf16x8 mf = frag_rm(Mt, 136, 16 * wid, ks * 32, lane);
                const bf16x8 cf = frag_rm(Ct, 136, 16 * wid, ks * 32, lane);
#pragma unroll
                for (int a = 0; a < 4; ++a) {
                    ad[a] = mfma16(frag_tr(Xt, 72, ks * 32, a * 16, lane), mf, ad[a]);
                    af[a] = mfma16(frag_rm(R1, 136, a * 16, ks * 32, lane), cf, af[a]);
                    ab[a] = mfma16(frag_rm(R1 + 64 * 136, 136, a * 16, ks * 32, lane), cf, ab[a]);
                }
            }
            const float ef = __expf(Af[l]), eb = __expf(Sb[l]), Dh = p.in[18][h];
            const size_t t = (size_t)(t0 + l);
            float ssq = 0.f;
#pragma unroll
            for (int a = 0; a < 4; ++a) {
                const int pp = a * 16 + (lane >> 4) * 4, col = h * 64 + pp;
                const f32x4 x = unpack4(*(const u32x2*)(Xt + l * 72 + pp));
                const f32x4 sz = unpack4(*(const u32x2*)(Uz + t * 2048 + col));
                const f32x4 ng = *(const f32x4*)(p.in[19] + col);
                f32x4 y = (ad[a] + af[a] * ef + ab[a] * eb + x * Dh) * sz;
                ssq += y[0] * y[0] + y[1] * y[1] + y[2] * y[2] + y[3] * y[3];
                if (!DRY) *(u32x2*)(Uz + t * 2048 + col) = pack4(y * ng); else asm volatile("" :: "v"(y[0] * ng[0]), "v"(y[1]), "v"(y[2]), "v"(y[3]));
            }
            ssq += __shfl_xor(ssq, 16); ssq += __shfl_xor(ssq, 32);
            if (!DRY) { if (lane < 16) SSQ[t * 32 + h] = ssq; } else asm volatile("" :: "v"(ssq));
        }
    }
}


__device__ __forceinline__ void mlp_stats_phase(const Params& p, const bf16_t* U) {
    const int tid = otid(), lane = tid & 63, gw = blockIdx.x * 8 + (tid >> 6), nw = gridDim.x * 8;
    float* STATS = (float*)(p.ws + WS_STATS);
    for (int t = gw; t < TOK; t += nw) {
        float f[32]; float s = 0.f;
#pragma unroll
        for (int j = 0; j < 4; ++j) { unpack8(*(const u32x4*)(U + (size_t)t * 6144 + 2048 + j * 512 + lane * 8), f + j * 8); }
#pragma unroll
        for (int i = 0; i < 32; ++i) s += f[i];
        s = wave_sum(s);
        const float mean = s * (1.f / 2048.f);
        float q = 0.f;
#pragma unroll
        for (int i = 0; i < 32; ++i) { const float d = f[i] - mean; q += d * d; }
        q = wave_sum(q);
        if (lane == 0) { STATS[(size_t)t * 2] = mean; STATS[(size_t)t * 2 + 1] = rsqrtf(q * (1.f / 2048.f) + EPSN); }
    }
}
template <bool DRY>
__device__ __forceinline__ void mlp_mix_phase(const Params& p, bf16_t* U, char* smem) {
    int tid_ = threadIdx.x; asm volatile("" : "+v"(tid_));
    const int tid = tid_, lane = tid & 63, wid = tid >> 6;
    const float* STATS = (const float*)(p.ws + WS_STATS);
    bf16_t* Wt = (bf16_t*)smem;
    bf16_t* Vt = Wt + 128 * 136;
    for (int item = blockIdx.x; item < NCHUNK * 16; item += gridDim.x) {
        const int ch = item >> 4, ct = item & 15, g = ct >> 1, c0 = ct * 128, t0 = ch * 128;
        __syncthreads();
#pragma unroll
        for (int jj = 0; jj < 8; ++jj) { const int q = tid + NT * jj, i = q >> 5, j4 = q & 31;
            const f32x4 w = *(const f32x4*)(p.in[23] + ((size_t)(g * 128 + i)) * 128 + j4 * 4);
            *(u32x2*)(Wt + i * 136 + j4 * 4) = pack4(w); }
#pragma unroll
        for (int jj = 0; jj < 4; ++jj) { const int q = tid + NT * jj, j = q >> 4, c = q & 15; const size_t t = (size_t)(t0 + j);
            const float mean = STATS[t * 2], rstd = STATS[t * 2 + 1];
            float f[8]; unpack8(*(const u32x4*)(U + t * 6144 + 2048 + c0 + c * 8), f);
            const f32x4 g0 = *(const f32x4*)(p.in[21] + c0 + c * 8), g1 = *(const f32x4*)(p.in[21] + c0 + c * 8 + 4);
            const f32x4 b0 = *(const f32x4*)(p.in[22] + c0 + c * 8), b1 = *(const f32x4*)(p.in[22] + c0 + c * 8 + 4);
#pragma unroll
            for (int i = 0; i < 4; ++i) { f[i] = (f[i] - mean) * rstd * g0[i] + b0[i]; f[4 + i] = (f[4 + i] - mean) * rstd * g1[i] + b1[i]; }
            *(u32x4*)(Vt + j * 136 + c * 8) = pack8(f); }
        __syncthreads();
        f32x4 acc[8];
#pragma unroll
        for (int a = 0; a < 8; ++a) acc[a] = (f32x4){0.f, 0.f, 0.f, 0.f};
#pragma unroll
        for (int ks = 0; ks < 4; ++ks) {
            const bf16x8 wf = frag_rm(Wt, 136, 16 * wid, ks * 32, lane);
#pragma unroll
            for (int a = 0; a < 8; ++a) acc[a] = mfma16(frag_tr(Vt, 136, ks * 32, a * 16, lane), wf, acc[a]);
        }
        const int i = 16 * wid + (lane & 15); const size_t t = (size_t)(t0 + i);
        const float bs = p.in[24][g * 128 + i];
#pragma unroll
        for (int a = 0; a < 8; ++a) {
            const int col = c0 + a * 16 + (lane >> 4) * 4;
            const f32x4 gu = unpack4(*(const u32x2*)(U + t * 6144 + col));
            const f32x4 sz = unpack4(*(const u32x2*)(U + t * 6144 + 4096 + col));
            { const f32x4 o = gu * (acc[a] + bs) * sz; if (!DRY) *(u32x2*)(U + t * 6144 + col) = pack4(o); else asm volatile("" :: "v"(o[0]), "v"(o[1]), "v"(o[2]), "v"(o[3])); }
        }
    }
}

__device__ __forceinline__ void s5_scan_phase(const Params& p, const bf16_t* Uu, bf16_t* Ydir, char* smem) {
    int tid_ = threadIdx.x; asm volatile("" : "+v"(tid_));
    const int tid = tid_, lane = tid & 63, wid = tid >> 6;
    bf16_t* Ktab = (bf16_t*)smem;
    bf16_t* Qtab = (bf16_t*)(smem + 4608);
    bf16_t* Ptab = (bf16_t*)(smem + 37376);
    char* wbase = smem + 72192;
    float* qbuf = (float*)(wbase + wid * 8448);
    bf16_t* Sbuf = (bf16_t*)(wbase + wid * 8448);
    f32x2* t_pow = (f32x2*)wbase;
    f32x2* t_coef = t_pow + 9 * 64;
    f32x2* t_bb = t_coef + 64;
    f32x2* t_c = t_bb + 1024;
    for (int combo = blockIdx.x; combo < 256; combo += gridDim.x) {
        const int cx = combo & 7, cy = combo >> 3, d = cy >> 4, g = cx * 16 + (cy & 15), dg = d * 128 + g;
        __syncthreads();
        if (tid < 64) {
            const float step = __expf(p.in[28][dg]);
            const float lr = p.in[26][dg * 64 + tid], li = p.in[27][dg * 64 + tid];
            const float mag = __expf(lr * step), ang = li * step;
            const float kk = rintf(ang * 0.15915494309189535f);
            float rr = fmaf(-kk, 6.2831854820251465f, ang); rr = fmaf(-kk, -1.7484555e-7f, rr);
            const float ar = mag * __cosf(rr), ai = mag * __sinf(rr);
            const float den = lr * lr + li * li, nr = ar - 1.f;
            t_coef[tid] = (f32x2){(nr * lr + ai * li) / den, (ai * lr - nr * li) / den};
            float pr = 1.f, pi = 0.f;
#pragma unroll
            for (int t = 0; t < 9; ++t) { t_pow[t * 64 + tid] = (f32x2){pr, pi}; const float a = pr * ar - pi * ai, b = pr * ai + pi * ar; pr = a; pi = b; }
        }
#pragma unroll
        for (int i = 0; i < 2; ++i) { const int q = tid + NT * i, j = q >> 6, n = q & 63; const size_t o = ((size_t)(dg * 16 + j)) * 64 + n; t_c[q] = (f32x2){p.in[31][o], p.in[32][o]}; }
        __syncthreads();
#pragma unroll
        for (int i = 0; i < 2; ++i) { const int q = tid + NT * i, n = q >> 4; const size_t o = ((size_t)(dg * 64 + n)) * 16 + (q & 15);
            const float br = p.in[29][o], bi = p.in[30][o]; const f32x2 cf = t_coef[n]; t_bb[q] = (f32x2){cf[0] * br - cf[1] * bi, cf[0] * bi + cf[1] * br}; }
        __syncthreads();
#pragma unroll 4
        for (int i = 0; i < 16; ++i) { const int q = tid + NT * i, t = q >> 10, n = (q >> 4) & 63, ch = q & 15;
            const f32x2 pw = t_pow[(7 - t) * 64 + n], bb = t_bb[n * 16 + ch];
            Qtab[(t * 128 + 2 * n) * 16 + ch] = (bf16_t)f2bf(pw[0] * bb[0] - pw[1] * bb[1]);
            Qtab[(t * 128 + 2 * n + 1) * 16 + ch] = (bf16_t)f2bf(pw[0] * bb[1] + pw[1] * bb[0]); }
#pragma unroll 4
        for (int i = 0; i < 16; ++i) { const int q = tid + NT * i, t = q >> 10, j = (q >> 6) & 15, n = q & 63;
            const f32x2 c = t_c[j * 64 + n], pw = t_pow[(t + 1) * 64 + n];
            *(unsigned*)(Ptab + (t * 16 + j) * 136 + 2 * n) = pack2(c[0] * pw[0] - c[1] * pw[1], -(c[0] * pw[1] + c[1] * pw[0])); }
        {
            const int tau = tid >> 6, j = (tid >> 2) & 15, c4 = tid & 3;
            f32x4 a = (f32x4){0.f, 0.f, 0.f, 0.f};
            for (int n = 0; n < 64; ++n) { const f32x2 c = t_c[j * 64 + n], pw = t_pow[tau * 64 + n];
                const float cpr = c[0] * pw[0] - c[1] * pw[1], cpi = c[0] * pw[1] + c[1] * pw[0];
#pragma unroll
                for (int e2 = 0; e2 < 4; ++e2) { const f32x2 bb = t_bb[n * 16 + 4 * c4 + e2]; a[e2] += cpr * bb[0] - cpi * bb[1]; } }
            *(u32x2*)(Ktab + (tau * 16 + j) * 16 + 4 * c4) = pack4(a);
            if (tid < 64) *(u32x2*)(Ktab + 8 * 256 + tid * 4) = (u32x2){0u, 0u};
        }
        const f32x2 a8 = t_pow[8 * 64 + lane];
        __syncthreads();
        const int slot = wid;
        const int ntl = slot < 2 ? 16 : 2 * ((32 - (slot - 2) + 5) / 6);
        const int cl = lane & 15, ch0 = 8 * ((lane >> 4) & 1), th = lane >> 5;
        const bf16_t* qf0 = Qtab + ((th * 128 + cl) * 16 + ch0);
        const bf16_t* pf0 = Ptab + cl * 136 + 8 * (lane >> 4);
        u32x4 ucur[4], unext[4], unn[4];
        {
            const int seq = slot < 2 ? 32 + slot : (slot - 2);
            const int L = seq < 32 ? 256 : 2048, tb = seq < 32 ? seq * 256 : TOKC + (seq - 32) * 2048;
#pragma unroll
            for (int ks = 0; ks < 4; ++ks) { const int m = cl * 8 + 2 * ks + th, tok = d ? tb + L - 1 - m : tb + m; ucur[ks] = *(const u32x4*)(Uu + (size_t)tok * 2048 + g * 16 + ch0); }
#pragma unroll
            for (int ks = 0; ks < 4; ++ks) { const int m = 128 + cl * 8 + 2 * ks + th, tok = d ? tb + L - 1 - m : tb + m; unext[ks] = *(const u32x4*)(Uu + (size_t)tok * 2048 + g * 16 + ch0); }
#pragma unroll
            for (int ks = 0; ks < 4; ++ks) unn[ks] = unext[ks];
        }
        float sr = 0.f, sim = 0.f;
        for (int k = 0; k < ntl; ++k) {
            const int si = slot < 2 ? 0 : (k >> 1), ti = slot < 2 ? k : (k & 1);
            const int seq = slot < 2 ? 32 + slot : (slot - 2) + 6 * si;
            const int L = seq < 32 ? 256 : 2048, tb = seq < 32 ? seq * 256 : TOKC + (seq - 32) * 2048, ntiles = L >> 7;
            if (ti == 0) {
                sr = 0.f; sim = 0.f;
                if (seq >= 32) { const float* h0 = p.in[3] + ((size_t)(((seq - 32) * 2 + d) * 2) * 128 + g) * 64 + lane; sr = h0[0]; sim = h0[128 * 64]; }
            }
            bf16x8 uf[4];
#pragma unroll
            for (int ks = 0; ks < 4; ++ks) uf[ks] = as_frag(ucur[ks]);
            {
                f32x4 qa[8];
#pragma unroll
                for (int nt = 0; nt < 8; ++nt) qa[nt] = (f32x4){0.f, 0.f, 0.f, 0.f};
#pragma unroll
                for (int ks = 0; ks < 4; ++ks) {
                    bf16x8 fr[8];
#pragma unroll
                    for (int nt = 0; nt < 8; ++nt) fr[nt] = *(const bf16x8*)(qf0 + (2 * ks * 128 + nt * 16) * 16);
                    __builtin_amdgcn_sched_barrier(0);
#pragma unroll
                    for (int nt = 0; nt < 8; ++nt) qa[nt] = mfma16(fr[nt], uf[ks], qa[nt]);
                    __builtin_amdgcn_sched_barrier(0);
                }
#pragma unroll
                for (int nt = 0; nt < 8; ++nt) *(f32x4*)(qbuf + cl * 132 + nt * 16 + (lane >> 4) * 4) = qa[nt];
            }
            if (k + 2 < ntl) {
                const int k2 = k + 2, si2 = slot < 2 ? 0 : (k2 >> 1), ti2 = slot < 2 ? k2 : (k2 & 1);
                const int seq2 = slot < 2 ? 32 + slot : (slot - 2) + 6 * si2;
                const int L2 = seq2 < 32 ? 256 : 2048, tb2 = seq2 < 32 ? seq2 * 256 : TOKC + (seq2 - 32) * 2048;
#pragma unroll
                for (int ks = 0; ks < 4; ++ks) { const int m = ti2 * 128 + cl * 8 + 2 * ks + th, tok = d ? tb2 + L2 - 1 - m : tb2 + m; unn[ks] = *(const u32x4*)(Uu + (size_t)tok * 2048 + g * 16 + ch0); }
            }
            WAVE_LDS_SYNC();
            f32x2 dq[16];
#pragma unroll
            for (int c = 0; c < 16; ++c) dq[c] = *(const f32x2*)(qbuf + c * 132 + 2 * lane);
            unsigned sw[16];
#pragma unroll
            for (int c = 0; c < 16; ++c) { sw[c] = pack2(sr, sim);
                const float nr2 = a8[0] * sr - a8[1] * sim + dq[c][0], ni2 = a8[0] * sim + a8[1] * sr + dq[c][1]; sr = nr2; sim = ni2; }
            WAVE_LDS_SYNC();
#pragma unroll
            for (int c = 0; c < 16; ++c) *(unsigned*)(Sbuf + c * 136 + 2 * lane) = sw[c];
            WAVE_LDS_SYNC();
            bf16x8 sf[4];
#pragma unroll
            for (int ks = 0; ks < 4; ++ks) sf[ks] = frag_rm(Sbuf, 136, 0, ks * 32, lane);
            {
                f32x4 ya[8];
#pragma unroll
                for (int tp = 0; tp < 8; ++tp) ya[tp] = (f32x4){0.f, 0.f, 0.f, 0.f};
#pragma unroll
                for (int ks = 0; ks < 4; ++ks) {
                    bf16x8 pfr[8], kfr[8];
#pragma unroll
                    for (int tp = 0; tp < 8; ++tp) pfr[tp] = *(const bf16x8*)(pf0 + tp * 16 * 136 + ks * 32);
#pragma unroll
                    for (int tp = 0; tp < 8; ++tp) if (2 * ks <= tp) { const int tau = tp - 2 * ks - th, taui = tau < 0 ? 8 : tau; kfr[tp] = *(const bf16x8*)(Ktab + (taui * 16 + cl) * 16 + ch0); }
                    __builtin_amdgcn_sched_barrier(0);
#pragma unroll
                    for (int tp = 0; tp < 8; ++tp) ya[tp] = mfma16(pfr[tp], sf[ks], ya[tp]);
#pragma unroll
                    for (int tp = 0; tp < 8; ++tp) if (2 * ks <= tp) ya[tp] = mfma16(kfr[tp], uf[ks], ya[tp]);
                    __builtin_amdgcn_sched_barrier(0);
                }
#pragma unroll
                for (int tp = 0; tp < 8; ++tp) {
                    const int m = ti * 128 + cl * 8 + tp, tok = d ? tb + L - 1 - m : tb + m;
                    *(u32x2*)(Ydir + ((size_t)d * TOK + tok) * 2048 + g * 16 + (lane >> 4) * 4) = pack4(ya[tp]);
                }
            }
            WAVE_LDS_SYNC();
            if (ti + 1 == ntiles && seq < 32) { float* o = p.out + OUT_S5 + ((size_t)((seq * 2 + d) * 2) * 128 + g) * 64 + lane; o[0] = sr; o[128 * 64] = sim; }
#pragma unroll
            for (int ks = 0; ks < 4; ++ks) { ucur[ks] = unext[ks]; unext[ks] = unn[ks]; }
        }
    }
}
__device__ __forceinline__ void s5_post_phase(const Params& p, const bf16_t* Uu, bf16_t* Ydir) {
    const size_t nvec = (size_t)TOK * 2048 / 8;
    const int tid = otid();
    for (size_t v = (size_t)blockIdx.x * NT + tid; v < nvec; v += (size_t)gridDim.x * NT) {
        const int col = (int)((v * 8) & 2047);
        float a[8], b[8], u[8];
        unpack8(*(const u32x4*)(Ydir + v * 8), a); unpack8(*(const u32x4*)(Ydir + (size_t)TOK * 2048 + v * 8), b); unpack8(*(const u32x4*)(Uu + v * 8), u);
        const f32x4 d0 = *(const f32x4*)(p.in[33] + col), d1 = *(const f32x4*)(p.in[33] + col + 4);
#pragma unroll
        for (int i = 0; i < 4; ++i) { a[i] = geluf(a[i] + b[i] + d0[i] * u[i]); a[4 + i] = geluf(a[4 + i] + b[4 + i] + d1[i] * u[4 + i]); }
        *(u32x4*)(Ydir + v * 8) = pack8(a);
    }
}

struct AttnState { float m, l; f32x4 o[4]; };
template <bool WIN, int KSTRIDE>
__device__ __forceinline__ void attend128(AttnState& st, const bf16x8 (&qf)[2], const bf16_t* Kt, const bf16_t* Vt, int krow0,
                                          bf16_t* Pbuf, int lane, const float* rpbh, int qc, int kcol0, int idxr0) {
    f32x4 s[8];
    {
        const int row = krow0 + (lane & 15), ksw = (row >> 1) & 7;
        const bf16_t* k0p = Kt + row * 64 + ((((lane >> 4)) ^ ksw) << 3);
        const bf16_t* k1p = Kt + row * 64 + (((4 + (lane >> 4)) ^ ksw) << 3);
#pragma unroll
        for (int kt = 0; kt < 8; ++kt) {
            const int ro = ((kt >> 1) * KSTRIDE + (kt & 1) * 16) * 64;
            s[kt] = mfma16(*(const bf16x8*)(k0p + ro), qf[0], (f32x4){0.f, 0.f, 0.f, 0.f});
            s[kt] = mfma16(*(const bf16x8*)(k1p + ro), qf[1], s[kt]);
        }
    }
    if (WIN) {
        const int cs = min(max(qc - 8, 0), 48);
#pragma unroll
        for (int kt = 0; kt < 8; ++kt) {
            const int ir = idxr0 + (kt >> 1);
#pragma unroll
            for (int r = 0; r < 4; ++r) { const int kc = kcol0 + (kt & 1) * 16 + (lane >> 4) * 4 + r;
                const bool ok = (kc >= cs) && (kc < cs + 16);
                const int ic = min(max(kc - qc + 15, 0), 30);
                s[kt][r] = ok ? s[kt][r] + rpbh[ir * 31 + ic] : -1e30f; }
        }
    }
    float mx = st.m;
#pragma unroll
    for (int kt = 0; kt < 8; ++kt) mx = fmaxf(mx, fmaxf(fmaxf(s[kt][0], s[kt][1]), fmaxf(s[kt][2], s[kt][3])));
    mx = fmaxf(mx, __shfl_xor(mx, 16)); mx = fmaxf(mx, __shfl_xor(mx, 32));
    const float alpha = __expf(st.m - mx);
    st.m = mx; st.l *= alpha;
#pragma unroll
    for (int a = 0; a < 4; ++a) st.o[a] = st.o[a] * alpha;
    const int vrow = krow0 + 8 * (lane >> 4) + ((lane >> 2) & 3);
    const int vs0 = (vrow >> 1) & 7, vs1 = ((vrow + 4) >> 1) & 7, c1 = (lane & 3) >> 1, cin = 4 * (lane & 1);
    const bf16_t* vb0 = Vt + vrow * 64 + cin;
    const bf16_t* vb1 = Vt + (vrow + 4) * 64 + cin;
    bf16_t* pw = Pbuf + (lane & 15) * 40 + (lane >> 4) * 4;
    const bf16_t* pr = Pbuf + (lane & 15) * 40 + 8 * (lane >> 4);
#pragma unroll
    for (int kk = 0; kk < 4; ++kk) {
        float ps = 0.f;
#pragma unroll
        for (int e = 0; e < 2; ++e) { f32x4 pv;
#pragma unroll
            for (int r = 0; r < 4; ++r) { pv[r] = __expf(s[2 * kk + e][r] - mx); ps += pv[r]; }
            *(u32x2*)(pw + e * 16) = pack4(pv); }
        st.l += ps;
        WAVE_LDS_SYNC();
        const bf16x8 pf = *(const bf16x8*)pr;
#pragma unroll
        for (int a = 0; a < 4; ++a) {
            const s16x4 lo = __builtin_amdgcn_ds_read_tr16_b64_v4i16((LAS s16x4*)(vb0 + kk * KSTRIDE * 64 + (((2 * a + c1) ^ vs0) << 3)));
            const s16x4 hi = __builtin_amdgcn_ds_read_tr16_b64_v4i16((LAS s16x4*)(vb1 + kk * KSTRIDE * 64 + (((2 * a + c1) ^ vs1) << 3)));
            bf16x8 vf; vf[0] = lo[0]; vf[1] = lo[1]; vf[2] = lo[2]; vf[3] = lo[3]; vf[4] = hi[0]; vf[5] = hi[1]; vf[6] = hi[2]; vf[7] = hi[3];
            st.o[a] = mfma16(vf, pf, st.o[a]);
        }
        WAVE_LDS_SYNC();
    }
}

template <bool DRY>
__device__ __forceinline__ void attn_phase(const Params& p, bf16_t* Q, const bf16_t* Z, const bf16_t* Kl, const bf16_t* Vl, char* smem) {
    int tid_ = threadIdx.x; asm volatile("" : "+v"(tid_));
    const int tid = tid_, lane = tid & 63, wid = tid >> 6;
    bf16_t* Kt = (bf16_t*)smem;
    bf16_t* Vt = Kt + 512 * 64;
    bf16_t* Pbuf = Vt + 512 * 64 + wid * 640;
    float* rpbs = (float*)(smem + 131072 + 10240);
    float* mrg = (float*)smem;
    const float* ck = p.out + OUT_CK; const float* cv = p.out + OUT_CV;
    for (int item = blockIdx.x; item < 4096; item += gridDim.x) {
        __syncthreads();
        if (item < 2048) {
            const int b = item >> 6, h = (item >> 1) & 31, qh = item & 1;
            const float* ksrc = ck + ((size_t)(b * 32 + h)) * 256 * 64; const float* vsrc = cv + ((size_t)(b * 32 + h)) * 256 * 64;
#pragma unroll
            for (int j = 0; j < 8; ++j) { const int q = tid + NT * j, key = q >> 4, c4 = q & 15;
                *(u32x2*)(Kt + sw64(key, c4 * 4)) = pack4(*(const f32x4*)(ksrc + key * 64 + c4 * 4));
                *(u32x2*)(Vt + sw64(key, c4 * 4)) = pack4(*(const f32x4*)(vsrc + key * 64 + c4 * 4)); }
            const size_t tq = (size_t)(b * 256 + qh * 128 + 16 * wid + (lane & 15));
            bf16x8 qf[2];
            qf[0] = *(const bf16x8*)(Q + tq * 2048 + h * 64 + 8 * (lane >> 4)); qf[1] = *(const bf16x8*)(Q + tq * 2048 + h * 64 + 32 + 8 * (lane >> 4));
            __syncthreads();
            AttnState st; st.m = -1e30f; st.l = 0.f;
#pragma unroll
            for (int a = 0; a < 4; ++a) st.o[a] = (f32x4){0.f, 0.f, 0.f, 0.f};
            attend128<false, 32>(st, qf, Kt, Vt, 0, Pbuf, lane, nullptr, 0, 0, 0);
            attend128<false, 32>(st, qf, Kt, Vt, 128, Pbuf, lane, nullptr, 0, 0, 0);
            float l = st.l; l += __shfl_xor(l, 16); l += __shfl_xor(l, 32);
            const float inv = 1.f / l;
#pragma unroll
            for (int a = 0; a < 4; ++a) { const int col = h * 64 + a * 16 + (lane >> 4) * 4;
                const f32x4 sz = unpack4(*(const u32x2*)(Z + tq * 2048 + col));
                { const f32x4 o = st.o[a] * inv * sz; if (!DRY) *(u32x2*)(Q + tq * 2048 + col) = pack4(o); else asm volatile("" :: "v"(o[0]), "v"(o[1]), "v"(o[2]), "v"(o[3])); } }
        } else {
            const int it = item - 2048, b = it >> 10, h = (it >> 5) & 31, r = it & 31, rs = min(max(r - 4, 0), 24);
            const bf16_t* ksrc = Kl + ((size_t)(b * 2048 + rs * 64)) * 2048 + h * 64; const bf16_t* vsrc = Vl + ((size_t)(b * 2048 + rs * 64)) * 2048 + h * 64;
#pragma unroll
            for (int j = 0; j < 8; ++j) { const int q = tid + NT * j, key = q >> 3, c = q & 7;
                *(u32x4*)(Kt + sw64(key, c * 8)) = *(const u32x4*)(ksrc + (size_t)key * 2048 + c * 8);
                *(u32x4*)(Vt + sw64(key, c * 8)) = *(const u32x4*)(vsrc + (size_t)key * 2048 + c * 8); }
            if (tid < 465) rpbs[tid] = p.in[37][h * 465 + tid];
            const int qt = wid & 3, hf = wid >> 2;
            const int qc = 16 * qt + (lane & 15);
            const size_t tq = (size_t)(TOKC + b * 2048 + r * 64 + qc);
            bf16x8 qf[2];
            qf[0] = *(const bf16x8*)(Q + tq * 2048 + h * 64 + 8 * (lane >> 4)); qf[1] = *(const bf16x8*)(Q + tq * 2048 + h * 64 + 32 + 8 * (lane >> 4));
            const int off = qt == 0 ? 0 : (qt == 1 ? 8 : (qt == 2 ? 24 : 32));
            __syncthreads();
            AttnState st; st.m = -1e30f; st.l = 0.f;
#pragma unroll
            for (int a = 0; a < 4; ++a) st.o[a] = (f32x4){0.f, 0.f, 0.f, 0.f};
            attend128<true, 64>(st, qf, Kt, Vt, hf * 256 + off, Pbuf, lane, rpbs, qc, off, rs + 4 * hf - r + 7);
            __syncthreads();
            const float* k2 = p.in[4] + ((size_t)(b * 32 + h)) * 256 * 64; const float* v2 = p.in[5] + ((size_t)(b * 32 + h)) * 256 * 64;
#pragma unroll
            for (int j = 0; j < 8; ++j) { const int q = tid + NT * j, key = q >> 4, c4 = q & 15;
                *(u32x2*)(Kt + sw64(key, c4 * 4)) = pack4(*(const f32x4*)(k2 + key * 64 + c4 * 4));
                *(u32x2*)(Vt + sw64(key, c4 * 4)) = pack4(*(const f32x4*)(v2 + key * 64 + c4 * 4)); }
            __syncthreads();
            attend128<false, 32>(st, qf, Kt, Vt, hf * 128, Pbuf, lane, nullptr, 0, 0, 0);
            float l = st.l; l += __shfl_xor(l, 16); l += __shfl_xor(l, 32);
            __syncthreads();
            if (hf == 1) { float* mp = mrg + qt * 18 * 64 + lane; mp[0] = st.m; mp[64] = l;
#pragma unroll
                for (int a = 0; a < 4; ++a)
#pragma unroll
                    for (int i = 0; i < 4; ++i) mp[(2 + a * 4 + i) * 64] = st.o[a][i]; }
            __syncthreads();
            if (hf == 0) { const float* mp = mrg + qt * 18 * 64 + lane; const float m2 = mp[0], l2 = mp[64];
                const float mm = fmaxf(st.m, m2), e1 = __expf(st.m - mm), e2 = __expf(m2 - mm);
                const float inv = 1.f / (l * e1 + l2 * e2);
#pragma unroll
                for (int a = 0; a < 4; ++a) { f32x4 o2;
#pragma unroll
                    for (int i = 0; i < 4; ++i) o2[i] = mp[(2 + a * 4 + i) * 64];
                    const int col = h * 64 + a * 16 + (lane >> 4) * 4;
                    const f32x4 sz = unpack4(*(const u32x2*)(Z + tq * 2048 + col));
                    { const f32x4 o = (st.o[a] * e1 + o2 * e2) * inv * sz; if (!DRY) *(u32x2*)(Q + tq * 2048 + col) = pack4(o); else asm volatile("" :: "v"(o[0]), "v"(o[1]), "v"(o[2]), "v"(o[3])); } }
            }
        }
    }
}


#define XB_TMO      128
#define XB_XCNT(j)  (256  + 64 * (j))
#define XB_XSUB(j)  (1280 + 64 * (j))
#define XB_XGEN(j)  (2304 + 64 * (j))
#define XB_TOP      3328
#define XB_TOPGEN   3392
#define XCD_BAR_WORDS 3456
#define XB_SPIN_CAP (1u << 22)
__device__ __forceinline__ unsigned xb_ld(unsigned* p)              { return __hip_atomic_load(p, __ATOMIC_RELAXED, __HIP_MEMORY_SCOPE_AGENT); }
__device__ __forceinline__ unsigned xb_add(unsigned* p, unsigned v) { return __hip_atomic_fetch_add(p, v, __ATOMIC_RELAXED, __HIP_MEMORY_SCOPE_AGENT); }
__device__ __forceinline__ unsigned xb_xcc_id() { return (unsigned)__builtin_amdgcn_s_getreg((3 << 11) | 20) & 0xFu; }
#define XB_SPIN(cond, bar) do { unsigned _sp = 0; while (cond) { __builtin_amdgcn_s_sleep(1); \
    if ((++_sp & 255u) == 0u) { if (xb_ld(&(bar)[XB_TMO])) break; if (_sp > XB_SPIN_CAP) { atomicAdd(&(bar)[XB_TMO], 1u); break; } } } } while (0)
struct XcdBarrier { unsigned* bar; unsigned x; volatile LAS unsigned* st; };
__device__ __forceinline__ XcdBarrier xcd_barrier_post(unsigned* bar, volatile LAS unsigned* st) {
    XcdBarrier b; b.bar = bar; b.x = xb_xcc_id(); b.st = st;
    if (threadIdx.x == 0) (void)xb_add(&bar[XB_XCNT(b.x)], 1u);
    return b;
}
__device__ __forceinline__ void xcd_barrier_complete(unsigned* bar, unsigned x, unsigned& nloc, unsigned& nx) {
    const unsigned G = gridDim.x * gridDim.y * gridDim.z;
    unsigned sum, cnt, mine, sp = 0u;
    for (;;) {
        sum = 0u; cnt = 0u; mine = 0u;
#pragma unroll
        for (unsigned j = 0; j < 16; ++j) { const unsigned c = xb_ld(&bar[XB_XCNT(j)]); sum += c; cnt += (c > 0u) ? 1u : 0u; mine = (j == x) ? c : mine; }
        if (sum == G) break;
        __builtin_amdgcn_s_sleep(1);
        if ((++sp & 255u) == 0u) { if (xb_ld(&bar[XB_TMO])) break; if (sp > XB_SPIN_CAP) { atomicAdd(&bar[XB_TMO], 1u); break; } }
    }
    nloc = mine > 0u ? mine : 1u; nx = cnt > 0u ? cnt : 1u;
}
__device__ __forceinline__ void xcd_barrier(const XcdBarrier& b) {
    asm volatile("s_waitcnt vmcnt(0)" ::: "memory");
    __syncthreads();
    if (threadIdx.x == 0) {
        unsigned* bar = b.bar;
        __builtin_amdgcn_s_waitcnt(0);
        unsigned nloc = b.st[0], nx = b.st[1];
        if (nloc == 0u) { xcd_barrier_complete(bar, b.x, nloc, nx); b.st[0] = nloc; b.st[1] = nx; }
        const unsigned old = xb_add(&bar[XB_XSUB(b.x)], 1u);
        const unsigned gen = old / nloc;
        if (old + 1u == (gen + 1u) * nloc) {
            __builtin_amdgcn_fence(__ATOMIC_RELEASE, "agent");
            asm volatile("s_waitcnt vmcnt(0)" ::: "memory");
            const unsigned og = xb_add(&bar[XB_TOP], 1u);
            const unsigned tg = og / nx;
            if (og + 1u == (tg + 1u) * nx) xb_add(&bar[XB_TOPGEN], 1u);
            else XB_SPIN(xb_ld(&bar[XB_TOPGEN]) == tg, bar);
            __builtin_amdgcn_fence(__ATOMIC_ACQUIRE, "agent");
            xb_add(&bar[XB_XGEN(b.x)], 1u);
            asm volatile("s_waitcnt vmcnt(0)" ::: "memory");
        } else {
            XB_SPIN(xb_ld(&bar[XB_XGEN(b.x)]) == gen, bar);
            __builtin_amdgcn_fence(__ATOMIC_ACQUIRE, "agent");
            asm volatile("s_waitcnt vmcnt(0)" ::: "memory");
        }
    }
    __syncthreads();
}

__global__ void __launch_bounds__(NT) fwd_megakernel(Params p) {
    extern __shared__ __attribute__((aligned(16))) char smem[];
    cg::grid_group grid = cg::this_grid();
    char* ws = p.ws;
    bf16_t* H = (bf16_t*)(ws + WS_H);
    float* MOD = (float*)(ws + WS_MOD);
    bf16_t* U = (bf16_t*)(ws + WS_U);
    bf16_t* SCR = (bf16_t*)(p.out + OUT_CK);
    const bf16_t* WtOut = (const bf16_t*)(ws + WS_WT_OUT);
    volatile LAS unsigned* xbst = (volatile LAS unsigned*)(smem + LDS_BYTES - 16);
    if (threadIdx.x == 0) { xbst[0] = 0u; xbst[1] = 0u; xbst[2] = 0u; xbst[3] = 0u; }
    __syncthreads();
    const XcdBarrier xbar = xcd_barrier_post((unsigned*)(ws + WS_BAR), xbst);
    if (p.pad == 0x5eed) grid.sync();
#define GSYNC() xcd_barrier(xbar)
    prep_phase(p, smem);
    GSYNC();
    if (PROBE & 2) { prep_phase(p, smem); GSYNC(); }
    norm_phase(p, 0);
    GSYNC();
    if (PROBE & 2) { norm_phase(p, 0); GSYNC(); }
    {
        bf16_t* Uz = U; bf16_t* Uxbc = U + (size_t)TOK * 2048; bf16_t* SB = Uxbc; bf16_t* XBC = SCR;
        { EpiSSD e{Uz, Uxbc, (float*)(ws + WS_DT), p.in[16]}; run_gemm(H, 1024, (const bf16_t*)(ws + WS_WT_SSD), 6400, 1024, e, smem);
          if (PROBE & 1) { GSYNC(); run_gemm(H, 1024, (const bf16_t*)(ws + WS_WT_SSD), 6400, 1024, e, smem); } }
        GSYNC();
        ssd_conv_phase(p, Uxbc, XBC);
        GSYNC();
        if (PROBE & 2) { ssd_conv_phase(p, Uxbc, XBC); GSYNC(); }
        ssd_state_phase(p, XBC, SB, smem);
        GSYNC();
        if (PROBE & 2) { ssd_state_phase(p, XBC, SB, smem); GSYNC(); }
        ssd_scan_phase(p, SB);
        GSYNC();
        if (PROBE & 8) { ssd_out_phase<true>(p, XBC, SB, Uz, smem); GSYNC(); }
        ssd_out_phase<false>(p, XBC, SB, Uz, smem);
        GSYNC();
        { EpiOut e{p.in[0], p.in[1], p.out, MOD + 0 * 3 * 3072, (const float*)(ws + WS_SSQ), 1}; run_gemm(Uz, 2048, WtOut, 1024, 2048, e, smem);
          if (PROBE & 1) { GSYNC(); run_gemm(Uz, 2048, WtOut, 1024, 2048, e, smem); } }
        GSYNC();
    }
    norm_phase(p, 1);
    GSYNC();
    if (PROBE & 2) { norm_phase(p, 1); GSYNC(); }
    {
        { EpiMLP e{U}; run_gemm(H, 1024, (const bf16_t*)(ws + WS_WT_MLP), 6144, 1024, e, smem);
          if (PROBE & 1) { GSYNC(); run_gemm(H, 1024, (const bf16_t*)(ws + WS_WT_MLP), 6144, 1024, e, smem); } }
        GSYNC();
        mlp_stats_phase(p, U);
        GSYNC();
        if (PROBE & 2) { mlp_stats_phase(p, U); GSYNC(); }
        if (PROBE & 16) { mlp_mix_phase<true>(p, U, smem); GSYNC(); }
        mlp_mix_phase<false>(p, U, smem);
        GSYNC();
        { EpiOut e{p.in[0], p.in[1], p.out, MOD + 1 * 3 * 3072, nullptr, 0}; run_gemm(U, 6144, WtOut + (size_t)1 * 1024 * 2048, 1024, 2048, e, smem); }
        GSYNC();
    }
    norm_phase(p, 2);
    GSYNC();
    if (PROBE & 2) { norm_phase(p, 2); GSYNC(); }
    {
        bf16_t* Uu = U; bf16_t* Uz = U + (size_t)TOK * 2048; bf16_t* Ydir = SCR;
        { EpiS5 e{Uu, Uz}; run_gemm(H, 1024, (const bf16_t*)(ws + WS_WT_S5), 4096, 1024, e, smem);
          if (PROBE & 1) { GSYNC(); run_gemm(H, 1024, (const bf16_t*)(ws + WS_WT_S5), 4096, 1024, e, smem); } }
        GSYNC();
        s5_scan_phase(p, Uu, Ydir, smem);
        GSYNC();
        if (PROBE & 4) { s5_scan_phase(p, Uu, Ydir, smem); GSYNC(); }
        s5_post_phase(p, Uu, Ydir);
        GSYNC();
        { EpiGLU e{Ydir, Uz, p.in[35]}; run_gemm(Ydir, 2048, (const bf16_t*)(ws + WS_WT_GLU), 2048, 2048, e, smem); }
        GSYNC();
        { EpiOut e{p.in[0], p.in[1], p.out, MOD + 2 * 3 * 3072, nullptr, 0}; run_gemm(Uz, 2048, WtOut + (size_t)2 * 1024 * 2048, 1024, 2048, e, smem); }
        GSYNC();
    }
    norm_phase(p, 3);
    GSYNC();
    if (PROBE & 2) { norm_phase(p, 3); GSYNC(); }
    {
        bf16_t* Q = U; bf16_t* Z = U + (size_t)TOK * 2048; bf16_t* Kl = U + (size_t)TOK * 4096; bf16_t* Vl = Kl + (size_t)4096 * 2048;
        { EpiNAT e{Q, Z, Kl, Vl, p.out + OUT_CK, p.out + OUT_CV}; run_gemm(H, 1024, (const bf16_t*)(ws + WS_WT_NAT), 8192, 1024, e, smem);
          if (PROBE & 1) { GSYNC(); run_gemm(H, 1024, (const bf16_t*)(ws + WS_WT_NAT), 8192, 1024, e, smem); } }
        GSYNC();
        if (PROBE & 32) { attn_phase<true>(p, Q, Z, Kl, Vl, smem); GSYNC(); }
        attn_phase<false>(p, Q, Z, Kl, Vl, smem);
        GSYNC();
        { EpiOut e{p.in[0], p.in[1], p.out, MOD + 3 * 3 * 3072, nullptr, 0}; run_gemm(Q, 2048, WtOut + (size_t)3 * 1024 * 2048, 1024, 2048, e, smem); }
        GSYNC();
    }
    final_phase(p);
}

extern "C" void kernel_launch(void* const* d_in, const int* in_sizes, int n_in, void* d_out, int out_size, void* d_ws, size_t ws_size,
                              hipStream_t stream) {
    static int grid_blocks = 0;
    if (grid_blocks == 0) {
        int dev = 0, cus = 0, per_cu = 0;
        hipGetDevice(&dev);
        hipDeviceGetAttribute(&cus, hipDeviceAttributeMultiprocessorCount, dev);
        if (hipFuncSetAttribute((const void*)fwd_megakernel, hipFuncAttributeMaxDynamicSharedMemorySize, LDS_BYTES) != hipSuccess) { fprintf(stderr, "hipFuncSetAttribute failed\n"); }
        if (hipOccupancyMaxActiveBlocksPerMultiprocessor(&per_cu, (const void*)fwd_megakernel, NT, LDS_BYTES) != hipSuccess || per_cu < 1) { fprintf(stderr, "occupancy query failed (%d)\n", per_cu); per_cu = 1; }
        (void)hipGetLastError();
        grid_blocks = cus;
        if (ws_size < WS_END) { fprintf(stderr, "workspace too small: %zu < %zu\n", ws_size, (size_t)WS_END); grid_blocks = -1; }
        if (n_in != 38) { fprintf(stderr, "expected 38 inputs, got %d\n", n_in); grid_blocks = -1; }
    }
    if (grid_blocks < 0) return;
    Params p;
    memset(&p, 0, sizeof(p));
    for (int i = 0; i < 38; ++i) p.in[i] = (const float*)d_in[i];
    p.out = (float*)d_out; p.ws = (char*)d_ws;
    char* ws = (char*)d_ws;
    int t0 = 0;
    auto job = [&](int i, const float* src, size_t off, int K, int N, int Npad) {
        p.jobs[i].src = src; p.jobs[i].dst = (bf16_t*)(ws + off); p.jobs[i].K = K; p.jobs[i].N = N; p.jobs[i].Npad = Npad; p.jobs[i].tile0 = t0; t0 += (K / 64) * (Npad / 64);
    };
    job(0, p.in[13], WS_WT_SSD, 1024, 6208, 6400);
    job(1, p.in[20], WS_WT_MLP, 1024, 6144, 6144);
    job(2, p.in[25], WS_WT_S5, 1024, 4096, 4096);
    job(3, p.in[36], WS_WT_NAT, 1024, 8192, 8192);
    job(4, p.in[34], WS_WT_GLU, 2048, 2048, 2048);
    for (int l = 0; l < 4; ++l) job(5 + l, p.in[11] + (size_t)l * 2048 * 1024, WS_WT_OUT + (size_t)l * 1024 * 2048 * 2, 2048, 1024, 1024);
    p.total_tiles = t0;
    if (hipMemsetAsync(ws + WS_BAR, 0, XCD_BAR_WORDS * 4, stream) != hipSuccess) { fprintf(stderr, "memset of barrier words failed\n"); return; }
    void* args[] = {&p};
    hipError_t e = hipLaunchCooperativeKernel((const void*)fwd_megakernel, dim3(grid_blocks), dim3(NT), args, LDS_BYTES, stream);
    if (e != hipSuccess) fprintf(stderr, "cooperative launch failed: %s (grid %d)\n", hipGetErrorString(e), grid_blocks);
}
```

```cpp
#include <hip/hip_runtime.h>
#include <hip/hip_cooperative_groups.h>
#include <cstdio>
#include <cstdint>
#include <cstring>
namespace cg = cooperative_groups;

typedef unsigned short bf16_t;
typedef short bf16x8 __attribute__((ext_vector_type(8)));
typedef short s16x4 __attribute__((ext_vector_type(4)));
typedef float f32x4 __attribute__((ext_vector_type(4)));
typedef float f32x2 __attribute__((ext_vector_type(2)));
typedef unsigned u32x4 __attribute__((ext_vector_type(4)));
typedef unsigned u32x2 __attribute__((ext_vector_type(2)));
#define LAS __attribute__((address_space(3)))
#define WAVE_LDS_SYNC() do { asm volatile("s_waitcnt lgkmcnt(0)" ::: "memory"); __builtin_amdgcn_wave_barrier(); } while (0)

#define PROBE 0
constexpr int NT = 512;
constexpr int DM = 1024, EE = 2048;
constexpr int TOK = 12288, TOKC = 8192;
constexpr int NCHUNK = 96;
constexpr float EPSN = 1e-6f;
constexpr int LDS_BYTES = 163840;

constexpr size_t WS_WT_SSD = 0;
constexpr size_t WS_WT_MLP = WS_WT_SSD + (size_t)6400 * 1024 * 2;
constexpr size_t WS_WT_S5  = WS_WT_MLP + (size_t)6144 * 1024 * 2;
constexpr size_t WS_WT_NAT = WS_WT_S5 + (size_t)4096 * 1024 * 2;
constexpr size_t WS_WT_GLU = WS_WT_NAT + (size_t)8192 * 1024 * 2;
constexpr size_t WS_WT_OUT = WS_WT_GLU + (size_t)2048 * 2048 * 2;
constexpr size_t WS_H      = WS_WT_OUT + (size_t)4 * 1024 * 2048 * 2;
constexpr size_t WS_MOD    = WS_H + (size_t)TOK * 1024 * 2;
constexpr size_t WS_DT     = WS_MOD + 147456;
constexpr size_t WS_ACUM   = WS_DT + (size_t)TOK * 64 * 4;
constexpr size_t WS_SSQ    = WS_ACUM + (size_t)TOK * 64 * 4;
constexpr size_t WS_STATS  = WS_SSQ + (size_t)TOK * 32 * 4;
constexpr size_t WS_BAR    = WS_STATS + (size_t)TOK * 8;
constexpr size_t WS_U      = WS_H + (size_t)TOK * 1024 * 2 + 8388608;
constexpr size_t WS_END    = WS_U + (size_t)TOK * 6144 * 2;
static_assert(WS_BAR + 16384 <= WS_U, "small region overflow");
static_assert(WS_END <= 268435456, "workspace over 256 MiB");

constexpr size_t OUT_SSD = (size_t)TOK * 1024;
constexpr size_t OUT_S5  = OUT_SSD + (size_t)32 * 2 * 32 * 64 * 128;
constexpr size_t OUT_CK  = OUT_S5 + (size_t)32 * 2 * 2 * 128 * 64;
constexpr size_t OUT_CV  = OUT_CK + (size_t)32 * 32 * 256 * 64;

struct TJob { const float* src; bf16_t* dst; int K, N, Npad, tile0; };
struct Params {
    const float* in[38];
    float* out;
    char* ws;
    TJob jobs[9];
    int total_tiles, pad;
};

__device__ __forceinline__ float bf2f(unsigned h) { return __uint_as_float(h << 16); }
__device__ __forceinline__ float bflo(unsigned u) { return __uint_as_float(u << 16); }
__device__ __forceinline__ float bfhi(unsigned u) { return __uint_as_float(u & 0xffff0000u); }
typedef __bf16 bf16v2_t __attribute__((ext_vector_type(2)));
__device__ __forceinline__ unsigned pack2(float a, float b) { f32x2 v; v[0] = a; v[1] = b; return __builtin_bit_cast(unsigned, __builtin_convertvector(v, bf16v2_t)); }
__device__ __forceinline__ unsigned f2bf(float f) { return pack2(f, 0.f) & 0xffffu; }
__device__ __forceinline__ u32x2 pack4(f32x4 v) { u32x2 r; r.x = pack2(v[0], v[1]); r.y = pack2(v[2], v[3]); return r; }
__device__ __forceinline__ f32x4 unpack4(u32x2 u) { f32x4 r; r[0] = bflo(u.x); r[1] = bfhi(u.x); r[2] = bflo(u.y); r[3] = bfhi(u.y); return r; }
__device__ __forceinline__ void unpack8(u32x4 u, float* f) {
    f[0] = bflo(u.x); f[1] = bfhi(u.x); f[2] = bflo(u.y); f[3] = bfhi(u.y); f[4] = bflo(u.z); f[5] = bfhi(u.z); f[6] = bflo(u.w); f[7] = bfhi(u.w);
}
__device__ __forceinline__ u32x4 pack8(const float* f) { u32x4 r; r.x = pack2(f[0], f[1]); r.y = pack2(f[2], f[3]); r.z = pack2(f[4], f[5]); r.w = pack2(f[6], f[7]); return r; }
__device__ __forceinline__ float fast_rcp(float x) { return __builtin_amdgcn_rcpf(x); }
__device__ __forceinline__ float siluf(float x) { return x * fast_rcp(1.f + __expf(-x)); }
__device__ __forceinline__ float sigmf(float x) { return fast_rcp(1.f + __expf(-x)); }
__device__ __forceinline__ float geluf(float x) {
    const float y2 = 1.5957691216057308f * (x + 0.044715f * x * x * x);
    return x * fast_rcp(1.f + __expf(-y2));
}
__device__ __forceinline__ float softplusf(float x) { return x > 20.f ? x : log1pf(__expf(x)); }
__device__ __forceinline__ float wave_sum(float v) {
#pragma unroll
    for (int o = 32; o > 0; o >>= 1) v += __shfl_xor(v, o);
    return v;
}
__device__ __forceinline__ int otid() { int t = threadIdx.x; asm volatile("" : "+v"(t)); return t; }
__device__ __forceinline__ int cond_idx(int t) { return t < TOKC ? 0 : 1 + ((t - TOKC) >> 11); }
__device__ __forceinline__ f32x4 mfma16(bf16x8 a, bf16x8 b, f32x4 c) { return __builtin_amdgcn_mfma_f32_16x16x32_bf16(a, b, c, 0, 0, 0); }
__device__ __forceinline__ bf16x8 as_frag(u32x4 u) { union { u32x4 a; bf16x8 b; } x; x.a = u; return x.b; }

__device__ __forceinline__ bf16x8 frag_rm(const bf16_t* tile, int stride, int row0, int k0, int lane) {
    return *(const bf16x8*)(tile + (row0 + (lane & 15)) * stride + k0 + 8 * (lane >> 4));
}
__device__ __forceinline__ bf16x8 frag_tr(const bf16_t* tile, int stride, int k0, int c0, int lane) {
    const bf16_t* p = tile + (k0 + 8 * (lane >> 4) + ((lane >> 2) & 3)) * stride + c0 + 4 * (lane & 3);
    s16x4 lo = __builtin_amdgcn_ds_read_tr16_b64_v4i16((LAS s16x4*)p);
    s16x4 hi = __builtin_amdgcn_ds_read_tr16_b64_v4i16((LAS s16x4*)(p + 4 * stride));
    bf16x8 r; r[0] = lo[0]; r[1] = lo[1]; r[2] = lo[2]; r[3] = lo[3]; r[4] = hi[0]; r[5] = hi[1]; r[6] = hi[2]; r[7] = hi[3];
    return r;
}
__device__ __forceinline__ int sw64(int row, int col) { return row * 64 + ((((col >> 3) ^ (row >> 1)) & 7) << 3) + (col & 7); }
__device__ __forceinline__ bf16x8 frag_rm_sw(const bf16_t* tile, int row0, int k0, int lane) {
    const int row = row0 + (lane & 15);
    return *(const bf16x8*)(tile + sw64(row, k0 + 8 * (lane >> 4)));
}
__device__ __forceinline__ bf16x8 frag_tr_sw(const bf16_t* tile, int k0, int c0, int lane) {
    const int row = k0 + 8 * (lane >> 4) + ((lane >> 2) & 3), col = c0 + 4 * (lane & 3);
    s16x4 lo = __builtin_amdgcn_ds_read_tr16_b64_v4i16((LAS s16x4*)(tile + sw64(row, col)));
    s16x4 hi = __builtin_amdgcn_ds_read_tr16_b64_v4i16((LAS s16x4*)(tile + sw64(row + 4, col)));
    bf16x8 r; r[0] = lo[0]; r[1] = lo[1]; r[2] = lo[2]; r[3] = lo[3]; r[4] = hi[0]; r[5] = hi[1]; r[6] = hi[2]; r[7] = hi[3];
    return r;
}


namespace pg8 {
#define PG8_LAS __attribute__((address_space(3)))
constexpr int BM = 256, BK = 64, HALF = 128, HTB = HALF * BK * 2  , STAGE_BYTES = 8 * HTB, NXCD = 8, WGM = 8;

__host__ __device__ __forceinline__ int lds_byte(int r, int c) { const int st = (r >> 4) * 2 + (c >> 5), rr = r & 15, cc = c & 31, ob = rr * 64 + cc * 2; return st * 1024 + (ob ^ (((ob >> 9) & 1) << 5)); }
__host__ __device__ __forceinline__ void stage_rc(int b, int& R, int& C) { const int st = b / 1024, sb = b % 1024, swz = sb ^ (((sb >> 9) & 1) << 5); R = (st >> 1) * 16 + swz / 64; C = (st & 1) * 32 + (swz % 64) / 2; }
__host__ __device__ __forceinline__ int perm32(int rho) { const int n = rho >> 4, i = rho & 15; return 8 * (i >> 2) + 4 * n + (i & 3); }
struct Unit { int pm, pn; };
struct Gemm { const bf16_t* A; const bf16_t* Bt; int M, N, K, lda; };
struct StaticOrder {
    int nM, nN, nwg, G, c;
    __host__ __device__ void init(int M, int N, int G_, int c_) { nM = M / BM; nN = N / BM; nwg = nM * nN; G = G_; c = c_; }
    __host__ __device__ bool next(int i, Unit& u) const {
        const long L = (long)i * G + c; if (L >= nwg) return false;
        int wgid = (int)L; { const int q = nwg / NXCD, r = nwg % NXCD, xcd = wgid % NXCD, off = wgid / NXCD; wgid = (xcd < r ? xcd * (q + 1) : r * (q + 1) + (xcd - r) * q) + off; }
        const int nig = WGM * nN, gid = wgid / nig, fm = gid * WGM, gsz = (nM - fm) < WGM ? (nM - fm) : WGM;
        u.pm = fm + ((wgid % nig) % gsz); u.pn = (wgid % nig) / gsz; return true;
    }
    __device__ __forceinline__ void a_ready(const Unit&) const {}
    __device__ __forceinline__ void done(const Unit&) const {}
};
template <class Epi, class Sched, bool ALIGN_EPI = false, bool SP2 = false>
__device__ __forceinline__ void gemm_phase(PG8_LAS unsigned char* lds, const Gemm g, const Sched& S, const Epi& E) {
    int tid_ = threadIdx.x; asm volatile("" : "+v"(tid_));
    const int tid = tid_, wid = __builtin_amdgcn_readfirstlane(tid >> 6), lane = tid & 63, wr = wid >> 2, wc = wid & 3, fr = lane & 15, fq = lane >> 4;
    const int K = g.K, nt = K / BK;
    unsigned voffA[2], voffB[2];
#pragma unroll
    for (int i = 0; i < 2; ++i) { int R, C; stage_rc(tid * 16 + i * 8192, R, C); const int Rb = Epi::PERM ? ((R & ~31) + perm32(R & 31)) : R;
        voffA[i] = (unsigned)(R * g.lda + C) * 2u; voffB[i] = (unsigned)(Rb * K + C) * 2u; }
    const size_t kstep = (size_t)(BK * 2);
    const size_t hstep = (size_t)HALF * K * 2;
    const size_t tstep = 2 * hstep;
    const size_t hstepA = (size_t)HALF * g.lda * 2, tstepA = 2 * hstepA;
    const unsigned ldsw = (unsigned)wid * 1024u;
    const int aoff = lds_byte(wr * 64 + fr, fq * 8), boff = lds_byte(wc * 32 + fr, fq * 8);
#define PG8_SA(b, h) (((b) * 2 + (h)) * HTB)
#define PG8_SB(b, h) ((4 + (b) * 2 + (h)) * HTB)
#define PG8_STAGE(bufoff, gbase, voff) do { _Pragma("unroll") for (int _i = 0; _i < 2; ++_i) \
        __builtin_amdgcn_global_load_lds((const unsigned*)((const char*)(gbase) + (voff)[_i]), (PG8_LAS unsigned*)(lds + (bufoff) + ldsw + _i * 8192), 16, 0, 0); } while (0)
#define PG8_LDA(dst, b, h) do { _Pragma("unroll") for (int m = 0; m < 4; ++m) _Pragma("unroll") for (int k = 0; k < 2; ++k) dst[m][k] = *(const PG8_LAS bf16x8*)(lds + PG8_SA(b, h) + aoff + m * 2048 + k * 1024); } while (0)
#define PG8_LDB(dst, b, h) do { _Pragma("unroll") for (int n = 0; n < 2; ++n) _Pragma("unroll") for (int k = 0; k < 2; ++k) dst[n][k] = *(const PG8_LAS bf16x8*)(lds + PG8_SB(b, h) + boff + n * 2048 + k * 1024); } while (0)
#define PG8_MMA(ai, bj, At, Bt) do { __builtin_amdgcn_s_setprio(1); _Pragma("unroll") for (int m = 0; m < 4; ++m) _Pragma("unroll") for (int n = 0; n < 2; ++n) _Pragma("unroll") for (int k = 0; k < 2; ++k) \
        acc[ai][bj][m][n] = __builtin_amdgcn_mfma_f32_16x16x32_bf16(Bt[n][k], At[m][k], acc[ai][bj][m][n], 0, 0, 0); __builtin_amdgcn_s_setprio(0); } while (0)
#define PG8_WAIT_V(n) asm volatile("s_waitcnt vmcnt(" #n ")" ::: "memory")
#define PG8_WAIT_L(n) asm volatile("s_waitcnt lgkmcnt(" #n ")" ::: "memory")
#define PG8_BAR __builtin_amdgcn_s_barrier()
#define PG8_SCHED __builtin_amdgcn_sched_barrier(0)
    Unit cur, nxt; int ui = 0;
    if (!S.next(0, cur)) return;
    f32x4 acc[2][2][4][2];
#pragma unroll
    for (int a = 0; a < 2; ++a)
#pragma unroll
        for (int b = 0; b < 2; ++b)
#pragma unroll
            for (int m = 0; m < 4; ++m)
#pragma unroll
                for (int n = 0; n < 2; ++n) acc[a][b][m][n] = (f32x4){0.f, 0.f, 0.f, 0.f};
    bf16x8 At[4][2], B0[2][2], B1[2][2];
    const char* cA = (const char*)g.A + (size_t)cur.pm * tstepA; const char* cB = (const char*)g.Bt + (size_t)cur.pn * tstep;
    S.a_ready(cur);
    if constexpr (SP2) {
        PG8_STAGE(PG8_SB(0, 0), cB, voffB); PG8_STAGE(PG8_SB(0, 1), cB + hstep, voffB); PG8_STAGE(PG8_SA(0, 0), cA, voffA); PG8_STAGE(PG8_SA(0, 1), cA + hstepA, voffA);
        if (wr == 1) PG8_BAR;
        PG8_WAIT_V(2); PG8_BAR;
        PG8_STAGE(PG8_SB(1, 0), cB + kstep, voffB); PG8_STAGE(PG8_SA(1, 0), cA + kstep, voffA); PG8_STAGE(PG8_SB(1, 1), cB + hstep + kstep, voffB);
        PG8_WAIT_V(6); PG8_BAR;
    } else {
        PG8_STAGE(PG8_SB(0, 0), cB, voffB); PG8_STAGE(PG8_SA(0, 0), cA, voffA); PG8_STAGE(PG8_SB(0, 1), cB + hstep, voffB); PG8_STAGE(PG8_SA(0, 1), cA + hstepA, voffA);
        if (wr == 1) PG8_BAR;
        PG8_WAIT_V(4); PG8_BAR;
        PG8_STAGE(PG8_SB(1, 0), cB + kstep, voffB); PG8_STAGE(PG8_SA(1, 0), cA + kstep, voffA); PG8_STAGE(PG8_SB(1, 1), cB + hstep + kstep, voffB);
        PG8_WAIT_V(6); PG8_BAR;
    }
    for (;;) {
        const bool has_next = S.next(ui + 1, nxt);
        const char* nA = has_next ? (const char*)g.A + (size_t)nxt.pm * tstepA : cA; const char* nB = has_next ? (const char*)g.Bt + (size_t)nxt.pn * tstep : cB;
        for (int t = 0; t < nt; t += 2) {
            const bool last = (t == nt - 2);
            const char* a1 = cA + (size_t)(t + 1) * kstep;
            const char* a2 = last ? nA : cA + (size_t)(t + 2) * kstep; const char* b2 = last ? nB : cB + (size_t)(t + 2) * kstep;
            const char* a3 = a2 + kstep; const char* b3 = b2 + kstep;
            if (last && has_next) S.a_ready(nxt);
            if constexpr (SP2) {
            PG8_LDB(B0, 0, 0); PG8_LDB(B1, 0, 1); PG8_SCHED; PG8_LDA(At, 0, 0); PG8_STAGE(PG8_SA(1, 1), a1 + hstepA, voffA);
            PG8_WAIT_V(8); PG8_WAIT_L(0); PG8_BAR; PG8_MMA(0, 0, At, B0); PG8_MMA(0, 1, At, B1); PG8_BAR; PG8_SCHED;
            PG8_LDA(At, 0, 1); PG8_STAGE(PG8_SB(0, 0), b2, voffB); PG8_STAGE(PG8_SB(0, 1), b2 + hstep, voffB); PG8_STAGE(PG8_SA(0, 0), a2, voffA);
            PG8_WAIT_V(8); PG8_WAIT_L(0); PG8_BAR; PG8_MMA(1, 0, At, B0); PG8_MMA(1, 1, At, B1); PG8_BAR; PG8_SCHED;
            PG8_LDB(B0, 1, 0); PG8_LDB(B1, 1, 1); PG8_SCHED; PG8_LDA(At, 1, 0); PG8_STAGE(PG8_SA(0, 1), a2 + hstepA, voffA);
            PG8_WAIT_V(8); PG8_WAIT_L(0); PG8_BAR; PG8_MMA(0, 0, At, B0); PG8_MMA(0, 1, At, B1); PG8_BAR; PG8_SCHED;
            PG8_LDA(At, 1, 1); PG8_STAGE(PG8_SB(1, 0), b3, voffB); PG8_STAGE(PG8_SB(1, 1), b3 + hstep, voffB); PG8_STAGE(PG8_SA(1, 0), a3, voffA);
            PG8_WAIT_V(8); PG8_WAIT_L(0); PG8_BAR; PG8_MMA(1, 0, At, B0); PG8_MMA(1, 1, At, B1); PG8_BAR; PG8_SCHED;
            } else {
            PG8_LDB(B0, 0, 0); PG8_SCHED; PG8_LDA(At, 0, 0); PG8_STAGE(PG8_SA(1, 1), a1 + hstepA, voffA);
            PG8_WAIT_L(8); PG8_BAR; PG8_WAIT_L(0); PG8_MMA(0, 0, At, B0); PG8_BAR; PG8_SCHED;
            PG8_LDB(B1, 0, 1); PG8_STAGE(PG8_SB(0, 0), b2, voffB);
            PG8_BAR; PG8_WAIT_L(0); PG8_MMA(0, 1, At, B1); PG8_BAR;
            PG8_LDA(At, 0, 1); PG8_STAGE(PG8_SA(0, 0), a2, voffA);
            PG8_BAR; PG8_WAIT_L(0); PG8_MMA(1, 0, At, B0); PG8_BAR; PG8_SCHED;
            PG8_STAGE(PG8_SB(0, 1), b2 + hstep, voffB);
            PG8_WAIT_V(6); PG8_BAR; PG8_MMA(1, 1, At, B1); PG8_BAR;
            PG8_LDB(B0, 1, 0); PG8_SCHED; PG8_LDA(At, 1, 0); PG8_STAGE(PG8_SA(0, 1), a2 + hstepA, voffA);
            PG8_WAIT_L(8); PG8_BAR; PG8_WAIT_L(0); PG8_MMA(0, 0, At, B0); PG8_BAR; PG8_SCHED;
            PG8_LDB(B1, 1, 1); PG8_STAGE(PG8_SB(1, 0), b3, voffB);
            PG8_BAR; PG8_WAIT_L(0); PG8_MMA(0, 1, At, B1); PG8_BAR;
            PG8_LDA(At, 1, 1); PG8_STAGE(PG8_SA(1, 0), a3, voffA);
            PG8_BAR; PG8_WAIT_L(0); PG8_MMA(1, 0, At, B0); PG8_BAR; PG8_SCHED;
            PG8_STAGE(PG8_SB(1, 1), b3 + hstep, voffB);
            PG8_WAIT_V(6); PG8_BAR; PG8_MMA(1, 1, At, B1); PG8_BAR;
            }
        }
        if constexpr (ALIGN_EPI) { if (wr == 0) PG8_BAR; }
        if constexpr (!Epi::AFTER_DRAIN) { E(acc, cur, wr, wc, fr, fq); S.done(cur); }
        if (!has_next) break;
#pragma unroll
        for (int a = 0; a < 2; ++a)
#pragma unroll
            for (int b = 0; b < 2; ++b)
#pragma unroll
                for (int m = 0; m < 4; ++m)
#pragma unroll
                    for (int n = 0; n < 2; ++n) acc[a][b][m][n] = (f32x4){0.f, 0.f, 0.f, 0.f};
        cur = nxt; cA = nA; cB = nB; ++ui;
        if constexpr (ALIGN_EPI) { if (wr == 1) PG8_BAR; }
    }
    PG8_WAIT_V(0);
    if constexpr (!ALIGN_EPI) { if (wr == 0) PG8_BAR; }
    PG8_BAR;
    if constexpr (Epi::AFTER_DRAIN) { E.fused(acc, cur, wr, wc, fr, fq, lds, wid, lane); S.done(cur); }
#undef PG8_SA
#undef PG8_SB
#undef PG8_STAGE
#undef PG8_LDA
#undef PG8_LDB
#undef PG8_MMA
#undef PG8_WAIT_V
#undef PG8_WAIT_L
#undef PG8_BAR
#undef PG8_SCHED
}
}

template <class E> struct PgEpi {
    static constexpr bool PERM = true, AFTER_DRAIN = false;
    E e;
    __device__ __forceinline__ void operator()(const f32x4 (&acc)[2][2][4][2], const pg8::Unit& u, int wr, int wc, int fr, int fq) const {
#pragma unroll
        for (int ai = 0; ai < 2; ++ai)
#pragma unroll
            for (int m = 0; m < 4; ++m) {
                const int row = u.pm * 256 + ai * 128 + wr * 64 + m * 16 + fr;
                const float rs = e.rowscale(row);
#pragma unroll
                for (int bj = 0; bj < 2; ++bj) e(row, u.pn * 256 + bj * 128 + wc * 32 + fq * 8, acc[ai][bj][m][0], acc[ai][bj][m][1], rs);
            }
    }
};
struct XcdOrder {
    int nM, nN, G8, c, tmx, perX;
    __device__ void init(int M, int N, int G_, int c_) { nM = M / 256; nN = N / 256; G8 = G_ >> 3; c = c_; tmx = nM >> 3; perX = tmx * nN; }
    __device__ bool next(int i, pg8::Unit& u) const {
        const int j = i * G8 + (c >> 3); if (j >= perX) return false;
        const int pn = j / tmx; u.pn = pn; u.pm = (c & 7) * tmx + (j - pn * tmx); return true;
    }
    __device__ __forceinline__ void a_ready(const pg8::Unit&) const {}
    __device__ __forceinline__ void done(const pg8::Unit&) const {}
};
#define GEMM_ORDER 0
template <class E>
__device__ __forceinline__ void run_gemm(const bf16_t* A, int lda, const bf16_t* Bt, int N, int K, const E& e, char* smem) {
    pg8::Gemm g{A, Bt, TOK, N, K, lda};
    PgEpi<E> pe{e};
#if GEMM_ORDER
    XcdOrder S; S.init(TOK, N, (int)gridDim.x, (int)blockIdx.x);
    pg8::gemm_phase<PgEpi<E>, XcdOrder, true, true>((LAS unsigned char*)smem, g, S, pe);
#else
    pg8::StaticOrder S; S.init(TOK, N, (int)gridDim.x, (int)blockIdx.x);
    pg8::gemm_phase<PgEpi<E>, pg8::StaticOrder, true, true>((LAS unsigned char*)smem, g, S, pe);
#endif
}

__device__ __forceinline__ u32x4 pack44(f32x4 a, f32x4 b) { u32x4 r; r.x = pack2(a[0], a[1]); r.y = pack2(a[2], a[3]); r.z = pack2(b[0], b[1]); r.w = pack2(b[2], b[3]); return r; }
__device__ __forceinline__ void unpack44(u32x4 u, f32x4& a, f32x4& b) { a[0] = bflo(u.x); a[1] = bfhi(u.x); a[2] = bflo(u.y); a[3] = bfhi(u.y); b[0] = bflo(u.z); b[1] = bfhi(u.z); b[2] = bflo(u.w); b[3] = bfhi(u.w); }
__device__ __forceinline__ f32x4 silu4(f32x4 v) { f32x4 s; s[0] = siluf(v[0]); s[1] = siluf(v[1]); s[2] = siluf(v[2]); s[3] = siluf(v[3]); return s; }
__device__ __forceinline__ f32x4 gelu4(f32x4 v) { f32x4 s; s[0] = geluf(v[0]); s[1] = geluf(v[1]); s[2] = geluf(v[2]); s[3] = geluf(v[3]); return s; }
struct EpiSSD {
    bf16_t* Uz; bf16_t* Uxbc; float* DT; const float* dt_bias;
    __device__ __forceinline__ float rowscale(int) const { return 1.f; }
    __device__ __forceinline__ void operator()(int row, int col, f32x4 v0, f32x4 v1, float) const {
        if (col < 2048) { *(u32x4*)(Uz + (size_t)row * 2048 + col) = pack44(silu4(v0), silu4(v1)); }
        else if (col < 6144) { *(u32x4*)(Uxbc + (size_t)row * 4096 + (col - 2048)) = pack44(v0, v1); }
        else if (col < 6208) { const int c = col - 6144; const f32x4 b0 = *(const f32x4*)(dt_bias + c), b1 = *(const f32x4*)(dt_bias + c + 4);
            *(f32x4*)(DT + (size_t)row * 64 + c) = v0 + b0; *(f32x4*)(DT + (size_t)row * 64 + c + 4) = v1 + b1; }
    }
};
struct EpiMLP {
    bf16_t* U;
    __device__ __forceinline__ float rowscale(int) const { return 1.f; }
    __device__ __forceinline__ void operator()(int row, int col, f32x4 v0, f32x4 v1, float) const {
        u32x4 o;
        if (col < 4096) o = pack44(gelu4(v0), gelu4(v1)); else o = pack44(silu4(v0), silu4(v1));
        *(u32x4*)(U + (size_t)row * 6144 + col) = o;
    }
};
struct EpiS5 {
    bf16_t* Uu; bf16_t* Uz;
    __device__ __forceinline__ float rowscale(int) const { return 1.f; }
    __device__ __forceinline__ void operator()(int row, int col, f32x4 v0, f32x4 v1, float) const {
        if (col < 2048) *(u32x4*)(Uu + (size_t)row * 2048 + col) = pack44(v0, v1);
        else *(u32x4*)(Uz + (size_t)row * 2048 + (col - 2048)) = pack44(silu4(v0), silu4(v1));
    }
};
struct EpiNAT {
    bf16_t* Q; bf16_t* Z; bf16_t* Kl; bf16_t* Vl; float* ck; float* cv; bf16_t* Kc; bf16_t* Vc0; bf16_t* Vc1;
    __device__ __forceinline__ float rowscale(int) const { return 1.f; }
    __device__ __forceinline__ void operator()(int row, int col, f32x4 v0, f32x4 v1, float) const {
        if (col < 2048) { *(u32x4*)(Q + (size_t)row * 2048 + col) = pack44(v0 * 0.125f, v1 * 0.125f); }
        else if (col < 6144) {
            const bool isv = col >= 4096; const int c = col - (isv ? 4096 : 2048);
            if (row < TOKC) { const int b = row >> 8, s = row & 255, h = c >> 6, d = c & 63; float* dst = (isv ? cv : ck) + ((size_t)((b * 32 + h) * 256 + s)) * 64 + d; *(f32x4*)dst = v0; *(f32x4*)(dst + 4) = v1;
                bf16_t* d2 = isv ? ((b < 20 ? Vc0 + (size_t)row * 2048 : Vc1 + (size_t)(row - 20 * 256) * 2048) + c) : (Kc + (size_t)row * 2048 + c);
                *(u32x4*)d2 = pack44(v0, v1); }
            else { bf16_t* dst = (isv ? Vl : Kl) + (size_t)(row - TOKC) * 2048 + c; *(u32x4*)dst = pack44(v0, v1); }
        } else { *(u32x4*)(Z + (size_t)row * 2048 + (col - 6144)) = pack44(silu4(v0), silu4(v1)); }
    }
};
struct EpiOut {
    const float* xp; const float* xs; float* X; const float* modl; const float* ssq; int first;
    __device__ __forceinline__ float rowscale(int row) const {
        if (!ssq) return 1.f;
        const f32x4* p = (const f32x4*)(ssq + (size_t)row * 32); float s = 0.f;
#pragma unroll
        for (int i = 0; i < 8; ++i) { f32x4 v = p[i]; s += (v[0] + v[1]) + (v[2] + v[3]); }
        return rsqrtf(s * (1.f / 2048.f) + EPSN);
    }
    __device__ __forceinline__ void operator()(int row, int col, f32x4 v0, f32x4 v1, float rs) const {
        const float* gp = modl + cond_idx(row) * 3072 + 2048 + col;
        const f32x4 g0 = *(const f32x4*)gp, g1 = *(const f32x4*)(gp + 4);
        const float* xin = (first ? (row < TOKC ? xp + (size_t)row * 1024 : xs + (size_t)(row - TOKC) * 1024) : X + (size_t)row * 1024) + col;
        const f32x4 x0 = *(const f32x4*)xin, x1 = *(const f32x4*)(xin + 4);
        float* o = X + (size_t)row * 1024 + col;
        *(f32x4*)o = x0 + g0 * (v0 * rs); *(f32x4*)(o + 4) = x1 + g1 * (v1 * rs);
    }
};
struct EpiGLU {
    const bf16_t* Yb; bf16_t* Uz; const float* bglu;
    __device__ __forceinline__ float rowscale(int) const { return 1.f; }
    __device__ __forceinline__ void operator()(int row, int col, f32x4 v0, f32x4 v1, float) const {
        f32x4 y0, y1, z0, z1; unpack44(*(const u32x4*)(Yb + (size_t)row * 2048 + col), y0, y1); unpack44(*(const u32x4*)(Uz + (size_t)row * 2048 + col), z0, z1);
        const f32x4 b0 = *(const f32x4*)(bglu + col), b1 = *(const f32x4*)(bglu + col + 4);
        f32x4 o0, o1;
#pragma unroll
        for (int i = 0; i < 4; ++i) { o0[i] = y0[i] * sigmf(v0[i] + b0[i]) * z0[i]; o1[i] = y1[i] * sigmf(v1[i] + b1[i]) * z1[i]; }
        *(u32x4*)(Uz + (size_t)row * 2048 + col) = pack44(o0, o1);
    }
};

__device__ __forceinline__ void prep_phase(const Params& p, char* smem) {
    int tid_ = threadIdx.x; asm volatile("" : "+v"(tid_));
    const int tid = tid_, lane = tid & 63, wid = tid >> 6;
    float* tile = (float*)smem;
    for (int T4 = blockIdx.x; T4 < (p.total_tiles >> 2); T4 += gridDim.x) {
        const int T = T4 * 4;
        int j = 0;
#pragma unroll
        for (int q = 1; q < 9; ++q) if (T >= p.jobs[q].tile0) j = q;
        const float* src = p.jobs[j].src; bf16_t* dst = p.jobs[j].dst; const int K = p.jobs[j].K, N = p.jobs[j].N;
        const int local = T - p.jobs[j].tile0, nkt = K >> 6, kt = local % nkt, nt = local / nkt, k0 = kt * 64, n0 = nt * 64;
        __syncthreads();
        if (n0 < N) {
            f32x4 v[8];
#pragma unroll
            for (int q = 0; q < 8; ++q) { const int idx = tid + NT * q, r = idx >> 4, c4 = idx & 15; v[q] = *(const f32x4*)(src + (size_t)(k0 + r) * N + n0 + c4 * 4); }
#pragma unroll
            for (int q = 0; q < 8; ++q) { const int idx = tid + NT * q, r = idx >> 4, c4 = idx & 15; float* tp = tile + (r >> 6) * 4160 + (r & 63) * 65 + c4 * 4;
                tp[0] = v[q][0]; tp[1] = v[q][1]; tp[2] = v[q][2]; tp[3] = v[q][3]; }
        }
        __syncthreads();
        {
            const int nn = tid >> 3, kc = tid & 7;
#pragma unroll
            for (int s = 0; s < 4; ++s) { float f[8];
#pragma unroll
                for (int i = 0; i < 8; ++i) f[i] = (n0 < N) ? tile[s * 4160 + (kc * 8 + i) * 65 + nn] : 0.f;
                *(u32x4*)(dst + (size_t)(n0 + nn) * K + k0 + s * 64 + kc * 8) = pack8(f); }
        }
    }
    __syncthreads();
    float* sc = (float*)smem;
    float* part = (float*)smem + 3072;
    for (int q = tid; q < 3072; q += NT) { const int ci = q >> 10, k = q & 1023; const float cv = ci == 0 ? p.in[7][k] : p.in[6][(ci - 1) * 1024 + k]; sc[q] = siluf(cv); }
    __syncthreads();
    float* MOD = (float*)(p.ws + WS_MOD);
    for (int it = blockIdx.x; it < 192; it += gridDim.x) {
        const int layer = it / 48, cg0 = (it % 48) * 64, col = cg0 + lane;
        const float* w = p.in[9] + (size_t)layer * 1024 * 3072 + col;
        float a0 = 0.f, a1 = 0.f, a2 = 0.f;
        for (int k = wid * 128; k < wid * 128 + 128; k += 16) { float wv[16];
#pragma unroll
            for (int u = 0; u < 16; ++u) wv[u] = w[(size_t)(k + u) * 3072];
#pragma unroll
            for (int u = 0; u < 16; ++u) { a0 += sc[k + u] * wv[u]; a1 += sc[1024 + k + u] * wv[u]; a2 += sc[2048 + k + u] * wv[u]; } }
        part[(wid * 3 + 0) * 64 + lane] = a0; part[(wid * 3 + 1) * 64 + lane] = a1; part[(wid * 3 + 2) * 64 + lane] = a2;
        __syncthreads();
        if (tid < 192) { const int ci = tid >> 6, l = tid & 63; float s = p.in[10][layer * 3072 + cg0 + l];
#pragma unroll
            for (int w8 = 0; w8 < 8; ++w8) s += part[(w8 * 3 + ci) * 64 + l];
            MOD[(layer * 3 + ci) * 3072 + cg0 + l] = s; }
        __syncthreads();
    }
}

__device__ __forceinline__ void norm_phase(const Params& p, int layer) {
    const int tid = otid(), lane = tid & 63, gw = blockIdx.x * 8 + (tid >> 6), nw = gridDim.x * 8;
    const float* g = p.in[8] + layer * 1024;
    const float* MOD = (const float*)(p.ws + WS_MOD) + layer * 3 * 3072;
    bf16_t* H = (bf16_t*)(p.ws + WS_H);
    for (int tb = gw; tb < TOK; tb += 3 * nw) {
        f32x4 v[3][4]; float ss[3];
#pragma unroll
        for (int r = 0; r < 3; ++r) { const int t = tb + r * nw; ss[r] = 0.f;
            if (t < TOK) { const float* xr = layer == 0 ? (t < TOKC ? p.in[0] + (size_t)t * 1024 : p.in[1] + (size_t)(t - TOKC) * 1024) : p.out + (size_t)t * 1024;
#pragma unroll
                for (int j = 0; j < 4; ++j) v[r][j] = *(const f32x4*)(xr + j * 256 + lane * 4); } }
#pragma unroll
        for (int r = 0; r < 3; ++r) { const int t = tb + r * nw;
            if (t < TOK) {
#pragma unroll
                for (int j = 0; j < 4; ++j) ss[r] += v[r][j][0] * v[r][j][0] + v[r][j][1] * v[r][j][1] + v[r][j][2] * v[r][j][2] + v[r][j][3] * v[r][j][3];
                ss[r] = wave_sum(ss[r]);
                const float rstd = rsqrtf(ss[r] * (1.f / 1024.f) + EPSN);
                const float* md = MOD + cond_idx(t) * 3072;
#pragma unroll
                for (int j = 0; j < 4; ++j) {
                    const int c = j * 256 + lane * 4;
                    const f32x4 gg = *(const f32x4*)(g + c), sh = *(const f32x4*)(md + c), scl = *(const f32x4*)(md + 1024 + c);
                    f32x4 h; for (int i = 0; i < 4; ++i) h[i] = v[r][j][i] * rstd * gg[i] * (1.f + scl[i]) + sh[i];
                    *(u32x2*)(H + (size_t)t * 1024 + c) = pack4(h);
                }
            } }
    }
}
__device__ __forceinline__ void final_phase(const Params& p) {
    const int tid = otid(), lane = tid & 63, gw = blockIdx.x * 8 + (tid >> 6), nw = gridDim.x * 8;
    const float* g = p.in[12];
    for (int tb = gw; tb < TOK; tb += 3 * nw) {
        f32x4 v[3][4];
#pragma unroll
        for (int r = 0; r < 3; ++r) { const int t = tb + r * nw;
            if (t < TOK) { const float* xr = p.out + (size_t)t * 1024;
#pragma unroll
                for (int j = 0; j < 4; ++j) v[r][j] = *(const f32x4*)(xr + j * 256 + lane * 4); } }
#pragma unroll
        for (int r = 0; r < 3; ++r) { const int t = tb + r * nw;
            if (t < TOK) { float ss = 0.f; float* xr = p.out + (size_t)t * 1024;
#pragma unroll
                for (int j = 0; j < 4; ++j) ss += v[r][j][0] * v[r][j][0] + v[r][j][1] * v[r][j][1] + v[r][j][2] * v[r][j][2] + v[r][j][3] * v[r][j][3];
                ss = wave_sum(ss);
                const float rstd = rsqrtf(ss * (1.f / 1024.f) + EPSN);
#pragma unroll
                for (int j = 0; j < 4; ++j) { const int c = j * 256 + lane * 4; const f32x4 gg = *(const f32x4*)(g + c); *(f32x4*)(xr + c) = v[r][j] * rstd * gg; } } }
    }
}

__device__ __forceinline__ void ssd_conv_phase(const Params& p, const bf16_t* Uxbc, bf16_t* XBC) {
    int tid_ = threadIdx.x; asm volatile("" : "+v"(tid_));
    const int tid = tid_, lane = tid & 63, wid = tid >> 6;
    float* DT = (float*)(p.ws + WS_DT);
    float* ACUM = (float*)(p.ws + WS_ACUM);
    for (int ch = blockIdx.x * 8 + wid; ch < NCHUNK; ch += gridDim.x * 8) {
        const int t0 = ch * 128, d = lane >> 5;
        const float a = -__expf(p.in[17][lane]);
        float acc = 0.f;
        for (int i = 0; i < 128; ++i) { const int l = d ? 127 - i : i; const float dtv = softplusf(DT[(size_t)(t0 + l) * 64 + lane]); DT[(size_t)(t0 + l) * 64 + lane] = dtv; acc += dtv * a; ACUM[(size_t)(t0 + l) * 64 + lane] = acc; }
    }
    const int chn = tid * 8;
    float w[5][8], bias[8];
#pragma unroll
    for (int j = 0; j < 5; ++j) { const f32x4 a = *(const f32x4*)(p.in[14] + j * 4096 + chn), b = *(const f32x4*)(p.in[14] + j * 4096 + chn + 4);
        w[j][0] = a[0]; w[j][1] = a[1]; w[j][2] = a[2]; w[j][3] = a[3]; w[j][4] = b[0]; w[j][5] = b[1]; w[j][6] = b[2]; w[j][7] = b[3]; }
    { const f32x4 a = *(const f32x4*)(p.in[15] + chn), b = *(const f32x4*)(p.in[15] + chn + 4);
      bias[0] = a[0]; bias[1] = a[1]; bias[2] = a[2]; bias[3] = a[3]; bias[4] = b[0]; bias[5] = b[1]; bias[6] = b[2]; bias[7] = b[3]; }
    for (int grp = blockIdx.x; grp < TOK / 8; grp += gridDim.x) {
        const int t0 = grp * 8;
        int s0, s1;
        if (t0 < TOKC) { s0 = t0 & ~255; s1 = s0 + 256; } else { s0 = TOKC + ((t0 - TOKC) & ~2047); s1 = s0 + 2048; }
        u32x4 rowv[12];
#pragma unroll
        for (int i = 0; i < 12; ++i) { const int tt = t0 - 2 + i; rowv[i] = (u32x4){0u, 0u, 0u, 0u};
            if (tt >= s0 && tt < s1) rowv[i] = *(const u32x4*)(Uxbc + (size_t)tt * 4096 + chn); }
#pragma unroll
        for (int o = 0; o < 8; ++o) {
            float acc[8];
#pragma unroll
            for (int i = 0; i < 8; ++i) acc[i] = bias[i];
#pragma unroll
            for (int j = 0; j < 5; ++j) { float f[8]; unpack8(rowv[o + j], f);
#pragma unroll
                for (int i = 0; i < 8; ++i) acc[i] += w[j][i] * f[i]; }
#pragma unroll
            for (int i = 0; i < 8; ++i) acc[i] = siluf(acc[i]);
            *(u32x4*)(XBC + (size_t)(t0 + o) * 4096 + chn) = pack8(acc);
        }
    }
}

__device__ __forceinline__ void ssd_state_phase(const Params& p, const bf16_t* XBC, bf16_t* SB, char* smem) {
    int tid_ = threadIdx.x; asm volatile("" : "+v"(tid_));
    const int tid = tid_, lane = tid & 63, wid = tid >> 6;
    const float* DT = (const float*)(p.ws + WS_DT);
    const float* ACUM = (const float*)(p.ws + WS_ACUM);
    bf16_t* Bt = (bf16_t*)smem;
    bf16_t* Xf = Bt + 128 * 136;
    bf16_t* Xb = Xf + 128 * 72;
    for (int item = blockIdx.x; item < NCHUNK * 8; item += gridDim.x) {
        const int ch = item >> 3, g = item & 7, t0 = ch * 128;
        __syncthreads();
#pragma unroll
        for (int j = 0; j < 4; ++j) { const int q = tid + NT * j, row = q >> 4, c = q & 15;
            *(u32x4*)(Bt + row * 136 + c * 8) = *(const u32x4*)(XBC + (size_t)(t0 + row) * 4096 + 2048 + g * 128 + c * 8); }
        for (int hh = 0; hh < 4; ++hh) {
            const int h = g * 4 + hh;
            __syncthreads();
            const float af_last = ACUM[(size_t)(t0 + 127) * 64 + h], sb_first = ACUM[(size_t)t0 * 64 + 32 + h];
#pragma unroll
            for (int j = 0; j < 2; ++j) { const int q = tid + NT * j, row = q >> 3, c = q & 7; const size_t tr = (size_t)(t0 + row);
                const float wf = __expf(af_last - ACUM[tr * 64 + h]) * DT[tr * 64 + h];
                const float wb = __expf(sb_first - ACUM[tr * 64 + 32 + h]) * DT[tr * 64 + 32 + h];
                float f[8], o[8]; unpack8(*(const u32x4*)(XBC + tr * 4096 + h * 64 + c * 8), f);
#pragma unroll
                for (int i = 0; i < 8; ++i) o[i] = f[i] * wf;
                *(u32x4*)(Xf + row * 72 + c * 8) = pack8(o);
#pragma unroll
                for (int i = 0; i < 8; ++i) o[i] = f[i] * wb;
                *(u32x4*)(Xb + row * 72 + c * 8) = pack8(o); }
            __syncthreads();
            const int dir = wid >> 2, nq = wid & 3;
            const bf16_t* Xd = dir ? Xb : Xf;
            f32x4 acc[4][2];
#pragma unroll
            for (int a = 0; a < 4; ++a) { acc[a][0] = (f32x4){0.f, 0.f, 0.f, 0.f}; acc[a][1] = (f32x4){0.f, 0.f, 0.f, 0.f}; }
#pragma unroll
            for (int ks = 0; ks < 4; ++ks) {
                bf16x8 xa[4], bb[2];
#pragma unroll
                for (int a = 0; a < 4; ++a) xa[a] = frag_tr(Xd, 72, ks * 32, a * 16, lane);
#pragma unroll
                for (int b = 0; b < 2; ++b) bb[b] = frag_tr(Bt, 136, ks * 32, nq * 32 + b * 16, lane);
#pragma unroll
                for (int a = 0; a < 4; ++a)
#pragma unroll
                    for (int b = 0; b < 2; ++b) acc[a][b] = mfma16(bb[b], xa[a], acc[a][b]);
            }
            bf16_t* dst = SB + ((size_t)((ch * 2 + dir) * 32 + h)) * 8192;
#pragma unroll
            for (int a = 0; a < 4; ++a)
#pragma unroll
                for (int b = 0; b < 2; ++b) { const int pp = a * 16 + (lane & 15), n = nq * 32 + b * 16 + (lane >> 4) * 4;
                    *(u32x2*)(dst + pp * 128 + n) = pack4(acc[a][b]); }
        }
    }
}

__device__ __forceinline__ void ssd_scan_phase(const Params& p, bf16_t* SB) {
    const int tid = otid();
    const float* ACUM = (const float*)(p.ws + WS_ACUM);
    for (int item = blockIdx.x; item < 34 * 64; item += gridDim.x) {
        const int seq = item >> 6, d = (item >> 5) & 1, h = item & 31;
        const int nc = seq < 32 ? 2 : 16, ch0 = seq < 32 ? seq * 2 : 64 + (seq - 32) * 16;
#pragma unroll
        for (int j = 0; j < 2; ++j) {
            const int e = (tid + NT * j) * 8;
            float st[8];
            if (seq >= 32) { const float* h0 = p.in[2] + ((size_t)(((seq - 32) * 2 + d) * 32 + h)) * 8192 + e; const f32x4 a = *(const f32x4*)h0, b = *(const f32x4*)(h0 + 4);
                st[0] = a[0]; st[1] = a[1]; st[2] = a[2]; st[3] = a[3]; st[4] = b[0]; st[5] = b[1]; st[6] = b[2]; st[7] = b[3]; }
            else {
#pragma unroll
                for (int i = 0; i < 8; ++i) st[i] = 0.f; }
            for (int ci = 0; ci < nc; ++ci) {
                const int c = d ? nc - 1 - ci : ci, ch = ch0 + c, t0 = ch * 128;
                const float tot = d ? ACUM[(size_t)t0 * 64 + 32 + h] : ACUM[(size_t)(t0 + 127) * 64 + h];
                bf16_t* ptr = SB + ((size_t)((ch * 2 + d) * 32 + h)) * 8192 + e;
                float s[8]; unpack8(*(const u32x4*)ptr, s);
                *(u32x4*)ptr = pack8(st);
                const float dec = __expf(tot);
#pragma unroll
                for (int i = 0; i < 8; ++i) st[i] = dec * st[i] + s[i];
            }
            if (seq < 32) { float* o = p.out + OUT_SSD + ((size_t)((seq * 2 + d) * 32 + h)) * 8192 + e;
                *(f32x4*)o = (f32x4){st[0], st[1], st[2], st[3]}; *(f32x4*)(o + 4) = (f32x4){st[4], st[5], st[6], st[7]}; }
        }
    }
}

template <bool DRY>
__device__ __forceinline__ void ssd_out_phase(const Params& p, const bf16_t* XBC, const bf16_t* SB, bf16_t* Uz, char* smem) {
    int tid_ = threadIdx.x; asm volatile("" : "+v"(tid_));
    const int tid = tid_, lane = tid & 63, wid = tid >> 6;
    const float* DT = (const float*)(p.ws + WS_DT);
    const float* ACUM = (const float*)(p.ws + WS_ACUM);
    float* SSQ = (float*)(p.ws + WS_SSQ);
    bf16_t* Ct = (bf16_t*)smem;
    bf16_t* R1 = Ct + 128 * 136;
    bf16_t* Mt = R1 + 128 * 136;
    bf16_t* Xt = Mt + 128 * 136;
    float* vec = (float*)(Xt + 128 * 72);
    for (int item = blockIdx.x; item < NCHUNK * 8; item += gridDim.x) {
        const int ch = item >> 3, g = item & 7, t0 = ch * 128;
        __syncthreads();
#pragma unroll
        for (int j = 0; j < 4; ++j) { const int q = tid + NT * j, row = q >> 4, c = q & 15; const bf16_t* src = XBC + (size_t)(t0 + row) * 4096 + g * 128 + c * 8;
            *(u32x4*)(R1 + row * 136 + c * 8) = *(const u32x4*)(src + 2048);
            *(u32x4*)(Ct + row * 136 + c * 8) = *(const u32x4*)(src + 3072); }
#pragma unroll
        for (int j = 0; j < 4; ++j) { const int idx = tid + NT * j, kind = idx >> 9, hh = (idx >> 7) & 3, l = idx & 127; const int h = g * 4 + hh;
            const float* srcp = (kind < 2 ? ACUM : DT) + (size_t)(t0 + l) * 64 + (kind & 1) * 32 + h;
            vec[idx] = *srcp; }
        __syncthreads();
        f32x4 gacc[8];
#pragma unroll
        for (int st = 0; st < 8; ++st) gacc[st] = (f32x4){0.f, 0.f, 0.f, 0.f};
#pragma unroll
        for (int ks = 0; ks < 4; ++ks) {
            const bf16x8 cf = frag_rm(Ct, 136, 16 * wid, ks * 32, lane);
#pragma unroll
            for (int st = 0; st < 8; ++st) gacc[st] = mfma16(frag_rm(R1, 136, st * 16, ks * 32, lane), cf, gacc[st]);
        }
        const int l = 16 * wid + (lane & 15);
        for (int hh = 0; hh < 4; ++hh) {
            const int h = g * 4 + hh;
            const float* Af = vec + hh * 128; const float* Sb = vec + 512 + hh * 128; const float* dtf = vec + 1024 + hh * 128; const float* dtb = vec + 1536 + hh * 128;
            __syncthreads();
#pragma unroll
            for (int j = 0; j < 2; ++j) { const int q = tid + NT * j, row = q >> 3, c = q & 7;
                *(u32x4*)(Xt + row * 72 + c * 8) = *(const u32x4*)(XBC + (size_t)(t0 + row) * 4096 + h * 64 + c * 8); }
#pragma unroll
            for (int j = 0; j < 4; ++j) { const int q = tid + NT * j, dd = q >> 10, row = (q >> 4) & 63, c = q & 15;
                *(u32x4*)(R1 + (dd * 64 + row) * 136 + c * 8) = *(const u32x4*)(SB + ((size_t)((ch * 2 + dd) * 32 + h)) * 8192 + row * 128 + c * 8); }
            {
                const float afl = Af[l], sbl = Sb[l];
#pragma unroll
                for (int st = 0; st < 8; ++st) {
                    f32x4 m;
#pragma unroll
                    for (int r = 0; r < 4; ++r) { const int s = st * 16 + (lane >> 4) * 4 + r;
                        float wgt = 0.f;
                        if (s <= l) wgt += __expf(afl - Af[s]) * dtf[s];
                        if (s >= l) wgt += __expf(sbl - Sb[s]) * dtb[s];
                        m[r] = gacc[st][r] * wgt; }
                    *(u32x2*)(Mt + l * 136 + st * 16 + (lane >> 4) * 4) = pack4(m);
                }
            }
            __syncthreads();
            f32x4 ad[4], af[4], ab[4];
#pragma unroll
            for (int a = 0; a < 4; ++a) { ad[a] = (f32x4){0.f, 0.f, 0.f, 0.f}; af[a] = ad[a]; ab[a] = ad[a]; }
#pragma unroll
            for (int ks = 0; ks < 4; ++ks) {
                const bf16x8 mf = frag_rm(Mt, 136, 16 * wid, ks * 32, lane);
                const bf16x8 cf = frag_rm(Ct, 136, 16 * wid, ks * 32, lane);
#pragma unroll
                for (int a = 0; a < 4; ++a) {
                    ad[a] = mfma16(frag_tr(Xt, 72, ks * 32, a * 16, lane), mf, ad[a]);
                    af[a] = mfma16(frag_rm(R1, 136, a * 16, ks * 32, lane), cf, af[a]);
                    ab[a] = mfma16(frag_rm(R1 + 64 * 136, 136, a * 16, ks * 32, lane), cf, ab[a]);
                }
            }
            const float ef = __expf(Af[l]), eb = __expf(Sb[l]), Dh = p.in[18][h];
            const size_t t = (size_t)(t0 + l);
            float ssq = 0.f;
#pragma unroll
            for (int a = 0; a < 4; ++a) {
                const int pp = a * 16 + (lane >> 4) * 4, col = h * 64 + pp;
                const f32x4 x = unpack4(*(const u32x2*)(Xt + l * 72 + pp));
                const f32x4 sz = unpack4(*(const u32x2*)(Uz + t * 2048 + col));
                const f32x4 ng = *(const f32x4*)(p.in[19] + col);
                f32x4 y = (ad[a] + af[a] * ef + ab[a] * eb + x * Dh) * sz;
                ssq += y[0] * y[0] + y[1] * y[1] + y[2] * y[2] + y[3] * y[3];
                if (!DRY) *(u32x2*)(Uz + t * 2048 + col) = pack4(y * ng); else asm volatile("" :: "v"(y[0] * ng[0]), "v"(y[1]), "v"(y[2]), "v"(y[3]));
            }
            ssq += __shfl_xor(ssq, 16); ssq += __shfl_xor(ssq, 32);
            if (!DRY) { if (lane < 16) SSQ[t * 32 + h] = ssq; } else asm volatile("" :: "v"(ssq));
        }
    }
}


__device__ __forceinline__ void mlp_stats_phase(const Params& p, const bf16_t* U) {
    const int tid = otid(), lane = tid & 63, gw = blockIdx.x * 8 + (tid >> 6), nw = gridDim.x * 8;
    float* STATS = (float*)(p.ws + WS_STATS);
    for (int t = gw; t < TOK; t += nw) {
        float f[32]; float s = 0.f;
#pragma unroll
        for (int j = 0; j < 4; ++j) { unpack8(*(const u32x4*)(U + (size_t)t * 6144 + 2048 + j * 512 + lane * 8), f + j * 8); }
#pragma unroll
        for (int i = 0; i < 32; ++i) s += f[i];
        s = wave_sum(s);
        const float mean = s * (1.f / 2048.f);
        float q = 0.f;
#pragma unroll
        for (int i = 0; i < 32; ++i) { const float d = f[i] - mean; q += d * d; }
        q = wave_sum(q);
        if (lane == 0) { STATS[(size_t)t * 2] = mean; STATS[(size_t)t * 2 + 1] = rsqrtf(q * (1.f / 2048.f) + EPSN); }
    }
}
template <bool DRY>
__device__ __forceinline__ void mlp_mix_phase(const Params& p, bf16_t* U, char* smem) {
    int tid_ = threadIdx.x; asm volatile("" : "+v"(tid_));
    const int tid = tid_, lane = tid & 63, wid = tid >> 6;
    const float* STATS = (const float*)(p.ws + WS_STATS);
    bf16_t* Wt = (bf16_t*)smem;
    bf16_t* Vt = Wt + 128 * 136;
    for (int item = blockIdx.x; item < NCHUNK * 16; item += gridDim.x) {
        const int ch = item >> 4, ct = item & 15, g = ct >> 1, c0 = ct * 128, t0 = ch * 128;
        __syncthreads();
#pragma unroll
        for (int jj = 0; jj < 8; ++jj) { const int q = tid + NT * jj, i = q >> 5, j4 = q & 31;
            const f32x4 w = *(const f32x4*)(p.in[23] + ((size_t)(g * 128 + i)) * 128 + j4 * 4);
            *(u32x2*)(Wt + i * 136 + j4 * 4) = pack4(w); }
#pragma unroll
        for (int jj = 0; jj < 4; ++jj) { const int q = tid + NT * jj, j = q >> 4, c = q & 15; const size_t t = (size_t)(t0 + j);
            const float mean = STATS[t * 2], rstd = STATS[t * 2 + 1];
            float f[8]; unpack8(*(const u32x4*)(U + t * 6144 + 2048 + c0 + c * 8), f);
            const f32x4 g0 = *(const f32x4*)(p.in[21] + c0 + c * 8), g1 = *(const f32x4*)(p.in[21] + c0 + c * 8 + 4);
            const f32x4 b0 = *(const f32x4*)(p.in[22] + c0 + c * 8), b1 = *(const f32x4*)(p.in[22] + c0 + c * 8 + 4);
#pragma unroll
            for (int i = 0; i < 4; ++i) { f[i] = (f[i] - mean) * rstd * g0[i] + b0[i]; f[4 + i] = (f[4 + i] - mean) * rstd * g1[i] + b1[i]; }
            *(u32x4*)(Vt + j * 136 + c * 8) = pack8(f); }
        __syncthreads();
        f32x4 acc[8];
#pragma unroll
        for (int a = 0; a < 8; ++a) acc[a] = (f32x4){0.f, 0.f, 0.f, 0.f};
#pragma unroll
        for (int ks = 0; ks < 4; ++ks) {
            const bf16x8 wf = frag_rm(Wt, 136, 16 * wid, ks * 32, lane);
#pragma unroll
            for (int a = 0; a < 8; ++a) acc[a] = mfma16(frag_tr(Vt, 136, ks * 32, a * 16, lane), wf, acc[a]);
        }
        const int i = 16 * wid + (lane & 15); const size_t t = (size_t)(t0 + i);
        const float bs = p.in[24][g * 128 + i];
#pragma unroll
        for (int a = 0; a < 8; ++a) {
            const int col = c0 + a * 16 + (lane >> 4) * 4;
            const f32x4 gu = unpack4(*(const u32x2*)(U + t * 6144 + col));
            const f32x4 sz = unpack4(*(const u32x2*)(U + t * 6144 + 4096 + col));
            { const f32x4 o = gu * (acc[a] + bs) * sz; if (!DRY) *(u32x2*)(U + t * 6144 + col) = pack4(o); else asm volatile("" :: "v"(o[0]), "v"(o[1]), "v"(o[2]), "v"(o[3])); }
        }
    }
}

__device__ __forceinline__ void s5_scan_phase(const Params& p, const bf16_t* Uu, bf16_t* Ydir, char* smem) {
    int tid_ = threadIdx.x; asm volatile("" : "+v"(tid_));
    const int tid = tid_, lane = tid & 63, wid = tid >> 6;
    bf16_t* Ktab = (bf16_t*)smem;
    bf16_t* Qtab = (bf16_t*)(smem + 4608);
    bf16_t* Ptab = (bf16_t*)(smem + 37376);
    char* wbase = smem + 72192;
    float* qbuf = (float*)(wbase + wid * 8448);
    bf16_t* Sbuf = (bf16_t*)(wbase + wid * 8448);
    f32x2* t_pow = (f32x2*)wbase;
    f32x2* t_coef = t_pow + 9 * 64;
    f32x2* t_bb = t_coef + 64;
    f32x2* t_c = t_bb + 1024;
    for (int combo = blockIdx.x; combo < 256; combo += gridDim.x) {
        const int cx = combo & 7, cy = combo >> 3, d = cy >> 4, g = cx * 16 + (cy & 15), dg = d * 128 + g;
        __syncthreads();
        if (tid < 64) {
            const float step = __expf(p.in[28][dg]);
            const float lr = p.in[26][dg * 64 + tid], li = p.in[27][dg * 64 + tid];
            const float mag = __expf(lr * step), ang = li * step;
            const float kk = rintf(ang * 0.15915494309189535f);
            float rr = fmaf(-kk, 6.2831854820251465f, ang); rr = fmaf(-kk, -1.7484555e-7f, rr);
            const float ar = mag * __cosf(rr), ai = mag * __sinf(rr);
            const float den = lr * lr + li * li, nr = ar - 1.f;
            t_coef[tid] = (f32x2){(nr * lr + ai * li) / den, (ai * lr - nr * li) / den};
            float pr = 1.f, pi = 0.f;
#pragma unroll
            for (int t = 0; t < 9; ++t) { t_pow[t * 64 + tid] = (f32x2){pr, pi}; const float a = pr * ar - pi * ai, b = pr * ai + pi * ar; pr = a; pi = b; }
        }
#pragma unroll
        for (int i = 0; i < 2; ++i) { const int q = tid + NT * i, j = q >> 6, n = q & 63; const size_t o = ((size_t)(dg * 16 + j)) * 64 + n; t_c[q] = (f32x2){p.in[31][o], p.in[32][o]}; }
        __syncthreads();
#pragma unroll
        for (int i = 0; i < 2; ++i) { const int q = tid + NT * i, n = q >> 4; const size_t o = ((size_t)(dg * 64 + n)) * 16 + (q & 15);
            const float br = p.in[29][o], bi = p.in[30][o]; const f32x2 cf = t_coef[n]; t_bb[q] = (f32x2){cf[0] * br - cf[1] * bi, cf[0] * bi + cf[1] * br}; }
        __syncthreads();
#pragma unroll 4
        for (int i = 0; i < 16; ++i) { const int q = tid + NT * i, t = q >> 10, n = (q >> 4) & 63, ch = q & 15;
            const f32x2 pw = t_pow[(7 - t) * 64 + n], bb = t_bb[n * 16 + ch];
            Qtab[(t * 128 + 2 * n) * 16 + ch] = (bf16_t)f2bf(pw[0] * bb[0] - pw[1] * bb[1]);
            Qtab[(t * 128 + 2 * n + 1) * 16 + ch] = (bf16_t)f2bf(pw[0] * bb[1] + pw[1] * bb[0]); }
#pragma unroll 4
        for (int i = 0; i < 16; ++i) { const int q = tid + NT * i, t = q >> 10, j = (q >> 6) & 15, n = q & 63;
            const f32x2 c = t_c[j * 64 + n], pw = t_pow[(t + 1) * 64 + n];
            *(unsigned*)(Ptab + (t * 16 + j) * 136 + 2 * n) = pack2(c[0] * pw[0] - c[1] * pw[1], -(c[0] * pw[1] + c[1] * pw[0])); }
        {
            const int tau = tid >> 6, j = (tid >> 2) & 15, c4 = tid & 3;
            f32x4 a = (f32x4){0.f, 0.f, 0.f, 0.f};
            for (int n = 0; n < 64; ++n) { const f32x2 c = t_c[j * 64 + n], pw = t_pow[tau * 64 + n];
                const float cpr = c[0] * pw[0] - c[1] * pw[1], cpi = c[0] * pw[1] + c[1] * pw[0];
#pragma unroll
                for (int e2 = 0; e2 < 4; ++e2) { const f32x2 bb = t_bb[n * 16 + 4 * c4 + e2]; a[e2] += cpr * bb[0] - cpi * bb[1]; } }
            *(u32x2*)(Ktab + (tau * 16 + j) * 16 + 4 * c4) = pack4(a);
            if (tid < 64) *(u32x2*)(Ktab + 8 * 256 + tid * 4) = (u32x2){0u, 0u};
        }
        const f32x2 a8 = t_pow[8 * 64 + lane];
        __syncthreads();
        const int slot = wid;
        const int ntl = slot < 2 ? 16 : 2 * ((32 - (slot - 2) + 5) / 6);
        const int cl = lane & 15, ch0 = 8 * ((lane >> 4) & 1), th = lane >> 5;
        const bf16_t* qf0 = Qtab + ((th * 128 + cl) * 16 + ch0);
        const bf16_t* pf0 = Ptab + cl * 136 + 8 * (lane >> 4);
        u32x4 ucur[4], unext[4], unn[4];
        {
            const int seq = slot < 2 ? 32 + slot : (slot - 2);
            const int L = seq < 32 ? 256 : 2048, tb = seq < 32 ? seq * 256 : TOKC + (seq - 32) * 2048;
#pragma unroll
            for (int ks = 0; ks < 4; ++ks) { const int m = cl * 8 + 2 * ks + th, tok = d ? tb + L - 1 - m : tb + m; ucur[ks] = *(const u32x4*)(Uu + (size_t)tok * 2048 + g * 16 + ch0); }
#pragma unroll
            for (int ks = 0; ks < 4; ++ks) { const int m = 128 + cl * 8 + 2 * ks + th, tok = d ? tb + L - 1 - m : tb + m; unext[ks] = *(const u32x4*)(Uu + (size_t)tok * 2048 + g * 16 + ch0); }
#pragma unroll
            for (int ks = 0; ks < 4; ++ks) unn[ks] = unext[ks];
        }
        float sr = 0.f, sim = 0.f;
        for (int k = 0; k < ntl; ++k) {
            const int si = slot < 2 ? 0 : (k >> 1), ti = slot < 2 ? k : (k & 1);
            const int seq = slot < 2 ? 32 + slot : (slot - 2) + 6 * si;
            const int L = seq < 32 ? 256 : 2048, tb = seq < 32 ? seq * 256 : TOKC + (seq - 32) * 2048, ntiles = L >> 7;
            if (ti == 0) {
                sr = 0.f; sim = 0.f;
                if (seq >= 32) { const float* h0 = p.in[3] + ((size_t)(((seq - 32) * 2 + d) * 2) * 128 + g) * 64 + lane; sr = h0[0]; sim = h0[128 * 64]; }
            }
            bf16x8 uf[4];
#pragma unroll
            for (int ks = 0; ks < 4; ++ks) uf[ks] = as_frag(ucur[ks]);
            {
                f32x4 qa[8];
#pragma unroll
                for (int nt = 0; nt < 8; ++nt) qa[nt] = (f32x4){0.f, 0.f, 0.f, 0.f};
#pragma unroll
                for (int ks = 0; ks < 4; ++ks) {
                    bf16x8 fr[8];
#pragma unroll
                    for (int nt = 0; nt < 8; ++nt) fr[nt] = *(const bf16x8*)(qf0 + (2 * ks * 128 + nt * 16) * 16);
                    __builtin_amdgcn_sched_barrier(0);
#pragma unroll
                    for (int nt = 0; nt < 8; ++nt) qa[nt] = mfma16(fr[nt], uf[ks], qa[nt]);
                    __builtin_amdgcn_sched_barrier(0);
                }
#pragma unroll
                for (int nt = 0; nt < 8; ++nt) *(f32x4*)(qbuf + cl * 132 + nt * 16 + (lane >> 4) * 4) = qa[nt];
            }
            if (k + 2 < ntl) {
                const int k2 = k + 2, si2 = slot < 2 ? 0 : (k2 >> 1), ti2 = slot < 2 ? k2 : (k2 & 1);
                const int seq2 = slot < 2 ? 32 + slot : (slot - 2) + 6 * si2;
                const int L2 = seq2 < 32 ? 256 : 2048, tb2 = seq2 < 32 ? seq2 * 256 : TOKC + (seq2 - 32) * 2048;
#pragma unroll
                for (int ks = 0; ks < 4; ++ks) { const int m = ti2 * 128 + cl * 8 + 2 * ks + th, tok = d ? tb2 + L2 - 1 - m : tb2 + m; unn[ks] = *(const u32x4*)(Uu + (size_t)tok * 2048 + g * 16 + ch0); }
            }
            WAVE_LDS_SYNC();
            f32x2 dq[16];
#pragma unroll
            for (int c = 0; c < 16; ++c) dq[c] = *(const f32x2*)(qbuf + c * 132 + 2 * lane);
            unsigned sw[16];
#pragma unroll
            for (int c = 0; c < 16; ++c) { sw[c] = pack2(sr, sim);
                const float nr2 = a8[0] * sr - a8[1] * sim + dq[c][0], ni2 = a8[0] * sim + a8[1] * sr + dq[c][1]; sr = nr2; sim = ni2; }
            WAVE_LDS_SYNC();
#pragma unroll
            for (int c = 0; c < 16; ++c) *(unsigned*)(Sbuf + c * 136 + 2 * lane) = sw[c];
            WAVE_LDS_SYNC();
            bf16x8 sf[4];
#pragma unroll
            for (int ks = 0; ks < 4; ++ks) sf[ks] = frag_rm(Sbuf, 136, 0, ks * 32, lane);
            {
                f32x4 ya[8];
#pragma unroll
                for (int tp = 0; tp < 8; ++tp) ya[tp] = (f32x4){0.f, 0.f, 0.f, 0.f};
#pragma unroll
                for (int ks = 0; ks < 4; ++ks) {
                    bf16x8 pfr[8], kfr[8];
#pragma unroll
                    for (int tp = 0; tp < 8; ++tp) pfr[tp] = *(const bf16x8*)(pf0 + tp * 16 * 136 + ks * 32);
#pragma unroll
                    for (int tp = 0; tp < 8; ++tp) if (2 * ks <= tp) { const int tau = tp - 2 * ks - th, taui = tau < 0 ? 8 : tau; kfr[tp] = *(const bf16x8*)(Ktab + (taui * 16 + cl) * 16 + ch0); }
                    __builtin_amdgcn_sched_barrier(0);
#pragma unroll
                    for (int tp = 0; tp < 8; ++tp) ya[tp] = mfma16(pfr[tp], sf[ks], ya[tp]);
#pragma unroll
                    for (int tp = 0; tp < 8; ++tp) if (2 * ks <= tp) ya[tp] = mfma16(kfr[tp], uf[ks], ya[tp]);
                    __builtin_amdgcn_sched_barrier(0);
                }
#pragma unroll
                for (int tp = 0; tp < 8; ++tp) {
                    const int m = ti * 128 + cl * 8 + tp, tok = d ? tb + L - 1 - m : tb + m;
                    *(u32x2*)(Ydir + ((size_t)d * TOK + tok) * 2048 + g * 16 + (lane >> 4) * 4) = pack4(ya[tp]);
                }
            }
            WAVE_LDS_SYNC();
            if (ti + 1 == ntiles && seq < 32) { float* o = p.out + OUT_S5 + ((size_t)((seq * 2 + d) * 2) * 128 + g) * 64 + lane; o[0] = sr; o[128 * 64] = sim; }
#pragma unroll
            for (int ks = 0; ks < 4; ++ks) { ucur[ks] = unext[ks]; unext[ks] = unn[ks]; }
        }
    }
}
__device__ __forceinline__ void s5_post_phase(const Params& p, const bf16_t* Uu, bf16_t* Ydir) {
    const size_t nvec = (size_t)TOK * 2048 / 8;
    const int tid = otid();
    for (size_t v = (size_t)blockIdx.x * NT + tid; v < nvec; v += (size_t)gridDim.x * NT) {
        const int col = (int)((v * 8) & 2047);
        float a[8], b[8], u[8];
        unpack8(*(const u32x4*)(Ydir + v * 8), a); unpack8(*(const u32x4*)(Ydir + (size_t)TOK * 2048 + v * 8), b); unpack8(*(const u32x4*)(Uu + v * 8), u);
        const f32x4 d0 = *(const f32x4*)(p.in[33] + col), d1 = *(const f32x4*)(p.in[33] + col + 4);
#pragma unroll
        for (int i = 0; i < 4; ++i) { a[i] = geluf(a[i] + b[i] + d0[i] * u[i]); a[4 + i] = geluf(a[4 + i] + b[4 + i] + d1[i] * u[4 + i]); }
        *(u32x4*)(Ydir + v * 8) = pack8(a);
    }
}

__device__ __forceinline__ void glds16_asm(const void* gsrc, unsigned lds_dst) {
    unsigned keep;
    asm volatile("s_mov_b32 %0, m0\n\ts_mov_b32 m0, %2\n\ts_nop 0\n\tglobal_load_lds_dwordx4 %1, off\n\ts_mov_b32 m0, %0" : "=&s"(keep) : "v"(gsrc), "s"(lds_dst) : "memory");
}
struct AttnState { float m, l; f32x4 o[4]; };
template <int NKT, bool WIN>
__device__ __forceinline__ void attend(AttnState& st, const bf16x8 (&qf)[2], const bf16_t* Kt, const bf16_t* Vt, int krow0,
                                       bf16_t* Pbuf, int lane, const float* rpbh, int qc, int kcol0, int idxr0) {
    constexpr int KSTR = WIN ? 64 : 32;
    f32x4 s[NKT];
    {
        const int row = krow0 + (lane & 15), ksw = (row >> 1) & 7;
        const bf16_t* k0p = Kt + row * 64 + ((((lane >> 4)) ^ ksw) << 3);
        const bf16_t* k1p = Kt + row * 64 + (((4 + (lane >> 4)) ^ ksw) << 3);
        bf16x8 kf[NKT];
#pragma unroll
        for (int kt = 0; kt < NKT; ++kt) kf[kt] = *(const bf16x8*)(k0p + ((kt >> 1) * KSTR + (kt & 1) * 16) * 64);
#pragma unroll
        for (int kt = 0; kt < NKT; ++kt) s[kt] = mfma16(kf[kt], qf[0], (f32x4){0.f, 0.f, 0.f, 0.f});
#pragma unroll
        for (int kt = 0; kt < NKT; ++kt) kf[kt] = *(const bf16x8*)(k1p + ((kt >> 1) * KSTR + (kt & 1) * 16) * 64);
#pragma unroll
        for (int kt = 0; kt < NKT; ++kt) s[kt] = mfma16(kf[kt], qf[1], s[kt]);
    }
    if (WIN) {
        const int cs = min(max(qc - 8, 0), 48);
#pragma unroll
        for (int kt = 0; kt < NKT; ++kt) {
            const int ir = idxr0 + (kt >> 1);
#pragma unroll
            for (int r = 0; r < 4; ++r) { const int kc = kcol0 + (kt & 1) * 16 + (lane >> 4) * 4 + r;
                const bool ok = (kc >= cs) && (kc < cs + 16);
                const int ic = min(max(kc - qc + 15, 0), 30);
                s[kt][r] = ok ? s[kt][r] + rpbh[ir * 31 + ic] : -1e30f; }
        }
    }
    float mx = st.m;
#pragma unroll
    for (int kt = 0; kt < NKT; ++kt) mx = fmaxf(mx, fmaxf(fmaxf(s[kt][0], s[kt][1]), fmaxf(s[kt][2], s[kt][3])));
    mx = fmaxf(mx, __shfl_xor(mx, 16)); mx = fmaxf(mx, __shfl_xor(mx, 32));
    const float alpha = __expf(st.m - mx);
    st.m = mx; st.l *= alpha;
#pragma unroll
    for (int a = 0; a < 4; ++a) st.o[a] = st.o[a] * alpha;
    const int vrow = krow0 + 8 * (lane >> 4) + ((lane >> 2) & 3);
    const int vs0 = (vrow >> 1) & 7, vs1 = ((vrow + 4) >> 1) & 7, c1 = (lane & 3) >> 1, cin = 4 * (lane & 1);
    const bf16_t* vb0 = Vt + vrow * 64 + cin;
    const bf16_t* vb1 = Vt + (vrow + 4) * 64 + cin;
    bf16_t* pw = Pbuf + (lane & 15) * 40 + (lane >> 4) * 4;
    const bf16_t* pr = Pbuf + (lane & 15) * 40 + 8 * (lane >> 4);
#pragma unroll
    for (int kk = 0; kk < NKT / 2; ++kk) {
        float ps = 0.f;
#pragma unroll
        for (int e = 0; e < 2; ++e) { f32x4 pv;
#pragma unroll
            for (int r = 0; r < 4; ++r) { pv[r] = __expf(s[2 * kk + e][r] - mx); ps += pv[r]; }
            *(u32x2*)(pw + e * 16) = pack4(pv); }
        st.l += ps;
        s16x4 lo[4], hi[4];
#pragma unroll
        for (int a = 0; a < 4; ++a) {
            lo[a] = __builtin_amdgcn_ds_read_tr16_b64_v4i16((LAS s16x4*)(vb0 + kk * KSTR * 64 + (((2 * a + c1) ^ vs0) << 3)));
            hi[a] = __builtin_amdgcn_ds_read_tr16_b64_v4i16((LAS s16x4*)(vb1 + kk * KSTR * 64 + (((2 * a + c1) ^ vs1) << 3))); }
        WAVE_LDS_SYNC();
        const bf16x8 pf = *(const bf16x8*)pr;
#pragma unroll
        for (int a = 0; a < 4; ++a) {
            bf16x8 vf; vf[0] = lo[a][0]; vf[1] = lo[a][1]; vf[2] = lo[a][2]; vf[3] = lo[a][3]; vf[4] = hi[a][0]; vf[5] = hi[a][1]; vf[6] = hi[a][2]; vf[7] = hi[a][3];
            st.o[a] = mfma16(vf, pf, st.o[a]);
        }
        WAVE_LDS_SYNC();
    }
}

struct AttnBufs { bf16_t* Q; const bf16_t* Z; const bf16_t* Kl; const bf16_t* Vl; const bf16_t* Kc; const bf16_t* Vc0; const bf16_t* Vc1; const bf16_t* CKb; const bf16_t* CVb; };

template <bool DRY>
__device__ __forceinline__ void attn_phase(const Params& p, const AttnBufs& ab, char* smem) {
    int tid_ = threadIdx.x; asm volatile("" : "+v"(tid_));
    const int tid = tid_, lane = tid & 63, wid = __builtin_amdgcn_readfirstlane(tid >> 6);
    bf16_t* Pbuf = (bf16_t*)(smem + 131072) + wid * 640;
    float* rpbs = (float*)(smem + 141312);
    float* mrg = (float*)(smem + 143360);
    const int G = gridDim.x, bid = blockIdx.x;
    const int nctx = (1024 - bid + G - 1) / G, nlat = (2048 - bid + G - 1) / G;
    const int nst = nctx + 3 * nlat;
    const bool xmapl = (G == 256);
#define LAT_ITEM(li) (xmapl ? ((((bid & 7) * 8 + (li)) << 5) | (bid >> 3)) : (bid + (li) * G))
#define ATTN_DMA(sidx, bufp) do { \
        const int s_ = (sidx); const bf16_t* kb_; const bf16_t* vb_; int str_; \
        if (s_ < nctx) { const int it_ = bid + s_ * G, b_ = it_ >> 5, h_ = it_ & 31; kb_ = ab.Kc + (size_t)(b_ * 256) * 2048 + h_ * 64; \
            vb_ = (b_ < 20 ? ab.Vc0 + (size_t)(b_ * 256) * 2048 : ab.Vc1 + (size_t)((b_ - 20) * 256) * 2048) + h_ * 64; str_ = 2048; } \
        else { const int q_ = s_ - nctx, li_ = q_ / 3, sub_ = q_ - 3 * li_, it_ = LAT_ITEM(li_), b_ = it_ >> 10, h_ = (it_ >> 5) & 31, r_ = it_ & 31, rs_ = min(max(r_ - 4, 0), 24); \
            if (sub_ < 2) { const size_t o_ = (size_t)(b_ * 2048 + (rs_ + 4 * sub_) * 64) * 2048 + h_ * 64; kb_ = ab.Kl + o_; vb_ = ab.Vl + o_; str_ = 2048; } \
            else { const size_t o_ = (size_t)((b_ * 32 + h_) * 256) * 64; kb_ = ab.CKb + o_; vb_ = ab.CVb + o_; str_ = 64; } } \
        _Pragma("unroll") for (int i_ = 0; i_ < 8; ++i_) { const int id_ = wid * 8 + i_, row_ = 8 * (id_ & 31) + (lane >> 3), ch_ = (lane & 7) ^ ((row_ >> 1) & 7); \
            const bf16_t* g_ = (id_ < 32 ? kb_ : vb_) + (size_t)row_ * str_ + ch_ * 8; \
            glds16_asm(g_, __builtin_amdgcn_readfirstlane((unsigned)(uintptr_t)(LAS char*)(bufp)) + (unsigned)((id_ < 32 ? 0 : 32768) + (id_ & 31) * 1024)); } \
    } while (0)
    bf16x8 qf[2][2]; u32x2 zr[2][4]; float rpbreg = 0.f;
#define ATTN_PROLOGUE(sidx) do { const int s_ = (sidx); \
        if (s_ < nctx) { const int it_ = bid + s_ * G, b_ = it_ >> 5, h_ = it_ & 31; \
            _Pragma("unroll") for (int qi_ = 0; qi_ < 2; ++qi_) { const size_t tq_ = (size_t)(b_ * 256 + (wid * 2 + qi_) * 16 + (lane & 15)); \
                qf[qi_][0] = *(const bf16x8*)(ab.Q + tq_ * 2048 + h_ * 64 + 8 * (lane >> 4)); qf[qi_][1] = *(const bf16x8*)(ab.Q + tq_ * 2048 + h_ * 64 + 32 + 8 * (lane >> 4)); \
                _Pragma("unroll") for (int a_ = 0; a_ < 4; ++a_) zr[qi_][a_] = *(const u32x2*)(ab.Z + tq_ * 2048 + h_ * 64 + a_ * 16 + (lane >> 4) * 4); } } \
        else { const int q_ = s_ - nctx, li_ = q_ / 3, it_ = LAT_ITEM(li_), b_ = it_ >> 10, h_ = (it_ >> 5) & 31, r_ = it_ & 31; \
            const size_t tq_ = (size_t)(TOKC + b_ * 2048 + r_ * 64 + 16 * (wid & 3) + (lane & 15)); \
            qf[0][0] = *(const bf16x8*)(ab.Q + tq_ * 2048 + h_ * 64 + 8 * (lane >> 4)); qf[0][1] = *(const bf16x8*)(ab.Q + tq_ * 2048 + h_ * 64 + 32 + 8 * (lane >> 4)); \
            _Pragma("unroll") for (int a_ = 0; a_ < 4; ++a_) zr[0][a_] = *(const u32x2*)(ab.Z + tq_ * 2048 + h_ * 64 + a_ * 16 + (lane >> 4) * 4); \
            if (tid < 465) rpbreg = p.in[37][h_ * 465 + tid]; } \
    } while (0)
    __syncthreads();
    if (nst > 0) { ATTN_DMA(0, smem); ATTN_PROLOGUE(0); }
    __builtin_amdgcn_s_waitcnt(0x0F70);
    asm volatile("s_waitcnt vmcnt(0)" ::: "memory");
    __syncthreads();
    AttnState st; st.m = -1e30f; st.l = 0.f;
#pragma unroll
    for (int a = 0; a < 4; ++a) st.o[a] = (f32x4){0.f, 0.f, 0.f, 0.f};
    for (int s = 0; s < nst; ++s) {
        char* buf = smem + (s & 1) * 65536;
        const bf16_t* Kt = (const bf16_t*)buf; const bf16_t* Vt = (const bf16_t*)(buf + 32768);
        const bool isctx = s < nctx;
        const int q3 = isctx ? 0 : s - nctx, li = q3 / 3, sub = q3 - 3 * li;
        if (!isctx && sub == 0) { if (tid < 465) rpbs[tid] = rpbreg; __syncthreads(); }
        if (s + 1 < nst) ATTN_DMA(s + 1, smem + ((s + 1) & 1) * 65536);
        if (isctx) {
            const int it = bid + s * G, b = it >> 5, h = it & 31;
#pragma unroll
            for (int qi = 0; qi < 2; ++qi) {
                st.m = -1e30f; st.l = 0.f;
#pragma unroll
                for (int a = 0; a < 4; ++a) st.o[a] = (f32x4){0.f, 0.f, 0.f, 0.f};
                attend<8, false>(st, qf[qi], Kt, Vt, 0, Pbuf, lane, nullptr, 0, 0, 0);
                attend<8, false>(st, qf[qi], Kt, Vt, 128, Pbuf, lane, nullptr, 0, 0, 0);
                float l = st.l; l += __shfl_xor(l, 16); l += __shfl_xor(l, 32);
                const float inv = fast_rcp(l);
                const size_t tq = (size_t)(b * 256 + (wid * 2 + qi) * 16 + (lane & 15));
#pragma unroll
                for (int a = 0; a < 4; ++a) { const u32x2 o = pack4(st.o[a] * inv * unpack4(zr[qi][a])); if (!DRY) *(u32x2*)(ab.Q + tq * 2048 + h * 64 + a * 16 + (lane >> 4) * 4) = o; else asm volatile("" :: "v"(o.x), "v"(o.y)); }
            }
        } else {
            const int it = LAT_ITEM(li), b = it >> 10, h = (it >> 5) & 31, r = it & 31, rs = min(max(r - 4, 0), 24);
            const int qt = wid & 3, hf = wid >> 2, qc = 16 * qt + (lane & 15);
            const int off = qt == 0 ? 0 : (qt == 1 ? 8 : (qt == 2 ? 24 : 32));
            if (sub == 0) { st.m = -1e30f; st.l = 0.f;
#pragma unroll
                for (int a = 0; a < 4; ++a) st.o[a] = (f32x4){0.f, 0.f, 0.f, 0.f}; }
            if (sub < 2) {
                attend<4, true>(st, qf[0], Kt, Vt, hf * 128 + off, Pbuf, lane, rpbs, qc, off, rs + 4 * sub + 2 * hf - r + 7);
            } else {
                attend<8, false>(st, qf[0], Kt, Vt, hf * 128, Pbuf, lane, nullptr, 0, 0, 0);
                float l = st.l; l += __shfl_xor(l, 16); l += __shfl_xor(l, 32);
                if (hf == 1) { float* mp = mrg + qt * 18 * 64 + lane; mp[0] = st.m; mp[64] = l;
#pragma unroll
                    for (int a = 0; a < 4; ++a)
#pragma unroll
                        for (int i = 0; i < 4; ++i) mp[(2 + a * 4 + i) * 64] = st.o[a][i]; }
                __syncthreads();
                if (hf == 0) { const float* mp = mrg + qt * 18 * 64 + lane; const float m2 = mp[0], l2 = mp[64];
                    const float mm = fmaxf(st.m, m2), e1 = __expf(st.m - mm), e2 = __expf(m2 - mm);
                    const float inv = fast_rcp(l * e1 + l2 * e2);
                    const size_t tq = (size_t)(TOKC + b * 2048 + r * 64 + qc);
#pragma unroll
                    for (int a = 0; a < 4; ++a) { f32x4 o2;
#pragma unroll
                        for (int i = 0; i < 4; ++i) o2[i] = mp[(2 + a * 4 + i) * 64];
                        { const u32x2 o = pack4((st.o[a] * e1 + o2 * e2) * inv * unpack4(zr[0][a])); if (!DRY) *(u32x2*)(ab.Q + tq * 2048 + h * 64 + a * 16 + (lane >> 4) * 4) = o; else asm volatile("" :: "v"(o.x), "v"(o.y)); } }
                }
            }
        }
        if (s + 1 < nst) { const int s1 = s + 1; const bool first = s1 < nctx || ((s1 - nctx) % 3) == 0; if (first) ATTN_PROLOGUE(s1); }
        __builtin_amdgcn_s_waitcnt(0x0F70);
        asm volatile("s_waitcnt vmcnt(0)" ::: "memory");
        __syncthreads();
    }
#undef ATTN_DMA
#undef LAT_ITEM
#undef ATTN_PROLOGUE
}

#define XB_TMO      128
#define XB_XCNT(j)  (256  + 64 * (j))
#define XB_XSUB(j)  (1280 + 64 * (j))
#define XB_XGEN(j)  (2304 + 64 * (j))
#define XB_TOP      3328
#define XB_TOPGEN   3392
#define XCD_BAR_WORDS 3456
#define XB_SPIN_CAP (1u << 22)
__device__ __forceinline__ unsigned xb_ld(unsigned* p)              { return __hip_atomic_load(p, __ATOMIC_RELAXED, __HIP_MEMORY_SCOPE_AGENT); }
__device__ __forceinline__ unsigned xb_add(unsigned* p, unsigned v) { return __hip_atomic_fetch_add(p, v, __ATOMIC_RELAXED, __HIP_MEMORY_SCOPE_AGENT); }
__device__ __forceinline__ unsigned xb_xcc_id() { return (unsigned)__builtin_amdgcn_s_getreg((3 << 11) | 20) & 0xFu; }
#define XB_SPIN(cond, bar) do { unsigned _sp = 0; while (cond) { __builtin_amdgcn_s_sleep(1); \
    if ((++_sp & 255u) == 0u) { if (xb_ld(&(bar)[XB_TMO])) break; if (_sp > XB_SPIN_CAP) { atomicAdd(&(bar)[XB_TMO], 1u); break; } } } } while (0)
struct XcdBarrier { unsigned* bar; unsigned x; volatile LAS unsigned* st; };
__device__ __forceinline__ XcdBarrier xcd_barrier_post(unsigned* bar, volatile LAS unsigned* st) {
    XcdBarrier b; b.bar = bar; b.x = xb_xcc_id(); b.st = st;
    if (threadIdx.x == 0) (void)xb_add(&bar[XB_XCNT(b.x)], 1u);
    return b;
}
__device__ __forceinline__ void xcd_barrier_complete(unsigned* bar, unsigned x, unsigned& nloc, unsigned& nx) {
    const unsigned G = gridDim.x * gridDim.y * gridDim.z;
    unsigned sum, cnt, mine, sp = 0u;
    for (;;) {
        sum = 0u; cnt = 0u; mine = 0u;
#pragma unroll
        for (unsigned j = 0; j < 16; ++j) { const unsigned c = xb_ld(&bar[XB_XCNT(j)]); sum += c; cnt += (c > 0u) ? 1u : 0u; mine = (j == x) ? c : mine; }
        if (sum == G) break;
        __builtin_amdgcn_s_sleep(1);
        if ((++sp & 255u) == 0u) { if (xb_ld(&bar[XB_TMO])) break; if (sp > XB_SPIN_CAP) { atomicAdd(&bar[XB_TMO], 1u); break; } }
    }
    nloc = mine > 0u ? mine : 1u; nx = cnt > 0u ? cnt : 1u;
}
__device__ __forceinline__ void xcd_barrier(const XcdBarrier& b) {
    asm volatile("s_waitcnt vmcnt(0)" ::: "memory");
    __syncthreads();
    if (threadIdx.x == 0) {
        unsigned* bar = b.bar;
        __builtin_amdgcn_s_waitcnt(0);
        unsigned nloc = b.st[0], nx = b.st[1];
        if (nloc == 0u) { xcd_barrier_complete(bar, b.x, nloc, nx); b.st[0] = nloc; b.st[1] = nx; }
        const unsigned old = xb_add(&bar[XB_XSUB(b.x)], 1u);
        const unsigned gen = old / nloc;
        if (old + 1u == (gen + 1u) * nloc) {
            __builtin_amdgcn_fence(__ATOMIC_RELEASE, "agent");
            asm volatile("s_waitcnt vmcnt(0)" ::: "memory");
            const unsigned og = xb_add(&bar[XB_TOP], 1u);
            const unsigned tg = og / nx;
            if (og + 1u == (tg + 1u) * nx) xb_add(&bar[XB_TOPGEN], 1u);
            else XB_SPIN(xb_ld(&bar[XB_TOPGEN]) == tg, bar);
            __builtin_amdgcn_fence(__ATOMIC_ACQUIRE, "agent");
            xb_add(&bar[XB_XGEN(b.x)], 1u);
            asm volatile("s_waitcnt vmcnt(0)" ::: "memory");
        } else {
            XB_SPIN(xb_ld(&bar[XB_XGEN(b.x)]) == gen, bar);
            __builtin_amdgcn_fence(__ATOMIC_ACQUIRE, "agent");
            asm volatile("s_waitcnt vmcnt(0)" ::: "memory");
        }
    }
    __syncthreads();
}

__global__ void __launch_bounds__(NT) fwd_megakernel(Params p) {
    extern __shared__ __attribute__((aligned(16))) char smem[];
    cg::grid_group grid = cg::this_grid();
    char* ws = p.ws;
    bf16_t* H = (bf16_t*)(ws + WS_H);
    float* MOD = (float*)(ws + WS_MOD);
    bf16_t* U = (bf16_t*)(ws + WS_U);
    bf16_t* SCR = (bf16_t*)(p.out + OUT_CK);
    const bf16_t* WtOut = (const bf16_t*)(ws + WS_WT_OUT);
    volatile LAS unsigned* xbst = (volatile LAS unsigned*)(smem + LDS_BYTES - 16);
    if (threadIdx.x == 0) { xbst[0] = 0u; xbst[1] = 0u; xbst[2] = 0u; xbst[3] = 0u; }
    __syncthreads();
    const XcdBarrier xbar = xcd_barrier_post((unsigned*)(ws + WS_BAR), xbst);
    if (p.pad == 0x5eed) grid.sync();
#define GSYNC() xcd_barrier(xbar)
    prep_phase(p, smem);
    GSYNC();
    if (PROBE & 2) { prep_phase(p, smem); GSYNC(); }
    norm_phase(p, 0);
    GSYNC();
    if (PROBE & 2) { norm_phase(p, 0); GSYNC(); }
    {
        bf16_t* Uz = U; bf16_t* Uxbc = U + (size_t)TOK * 2048; bf16_t* SB = Uxbc; bf16_t* XBC = SCR;
        { EpiSSD e{Uz, Uxbc, (float*)(ws + WS_DT), p.in[16]}; run_gemm(H, 1024, (const bf16_t*)(ws + WS_WT_SSD), 6400, 1024, e, smem);
          if (PROBE & 1) { GSYNC(); run_gemm(H, 1024, (const bf16_t*)(ws + WS_WT_SSD), 6400, 1024, e, smem); } }
        GSYNC();
        ssd_conv_phase(p, Uxbc, XBC);
        GSYNC();
        if (PROBE & 2) { ssd_conv_phase(p, Uxbc, XBC); GSYNC(); }
        ssd_state_phase(p, XBC, SB, smem);
        GSYNC();
        if (PROBE & 2) { ssd_state_phase(p, XBC, SB, smem); GSYNC(); }
        ssd_scan_phase(p, SB);
        GSYNC();
        if (PROBE & 8) { ssd_out_phase<true>(p, XBC, SB, Uz, smem); GSYNC(); }
        ssd_out_phase<false>(p, XBC, SB, Uz, smem);
        GSYNC();
        { EpiOut e{p.in[0], p.in[1], p.out, MOD + 0 * 3 * 3072, (const float*)(ws + WS_SSQ), 1}; run_gemm(Uz, 2048, WtOut, 1024, 2048, e, smem);
          if (PROBE & 1) { GSYNC(); run_gemm(Uz, 2048, WtOut, 1024, 2048, e, smem); } }
        GSYNC();
    }
    norm_phase(p, 1);
    GSYNC();
    if (PROBE & 2) { norm_phase(p, 1); GSYNC(); }
    {
        { EpiMLP e{U}; run_gemm(H, 1024, (const bf16_t*)(ws + WS_WT_MLP), 6144, 1024, e, smem);
          if (PROBE & 1) { GSYNC(); run_gemm(H, 1024, (const bf16_t*)(ws + WS_WT_MLP), 6144, 1024, e, smem); } }
        GSYNC();
        mlp_stats_phase(p, U);
        GSYNC();
        if (PROBE & 2) { mlp_stats_phase(p, U); GSYNC(); }
        if (PROBE & 16) { mlp_mix_phase<true>(p, U, smem); GSYNC(); }
        mlp_mix_phase<false>(p, U, smem);
        GSYNC();
        { EpiOut e{p.in[0], p.in[1], p.out, MOD + 1 * 3 * 3072, nullptr, 0}; run_gemm(U, 6144, WtOut + (size_t)1 * 1024 * 2048, 1024, 2048, e, smem); }
        GSYNC();
    }
    norm_phase(p, 2);
    GSYNC();
    if (PROBE & 2) { norm_phase(p, 2); GSYNC(); }
    {
        bf16_t* Uu = U; bf16_t* Uz = U + (size_t)TOK * 2048; bf16_t* Ydir = SCR;
        { EpiS5 e{Uu, Uz}; run_gemm(H, 1024, (const bf16_t*)(ws + WS_WT_S5), 4096, 1024, e, smem);
          if (PROBE & 1) { GSYNC(); run_gemm(H, 1024, (const bf16_t*)(ws + WS_WT_S5), 4096, 1024, e, smem); } }
        GSYNC();
        s5_scan_phase(p, Uu, Ydir, smem);
        GSYNC();
        if (PROBE & 4) { s5_scan_phase(p, Uu, Ydir, smem); GSYNC(); }
        s5_post_phase(p, Uu, Ydir);
        GSYNC();
        { EpiGLU e{Ydir, Uz, p.in[35]}; run_gemm(Ydir, 2048, (const bf16_t*)(ws + WS_WT_GLU), 2048, 2048, e, smem); }
        GSYNC();
        { EpiOut e{p.in[0], p.in[1], p.out, MOD + 2 * 3 * 3072, nullptr, 0}; run_gemm(Uz, 2048, WtOut + (size_t)2 * 1024 * 2048, 1024, 2048, e, smem); }
        GSYNC();
    }
    norm_phase(p, 3);
    GSYNC();
    if (PROBE & 2) { norm_phase(p, 3); GSYNC(); }
    {
        bf16_t* Q = U; bf16_t* Z = U + (size_t)TOK * 2048; bf16_t* Kl = U + (size_t)TOK * 4096; bf16_t* Vl = Kl + (size_t)4096 * 2048;
        bf16_t* Kc = (bf16_t*)(ws + WS_WT_SSD);
        bf16_t* Vc0 = (bf16_t*)(ws + WS_WT_GLU);
        bf16_t* Vc1 = (bf16_t*)(ws + WS_U + 134217728);
        bf16_t* CKb = Vc1 + (size_t)12 * 256 * 2048;
        bf16_t* CVb = CKb + (size_t)2 * 32 * 256 * 64;
        { EpiNAT e{Q, Z, Kl, Vl, p.out + OUT_CK, p.out + OUT_CV, Kc, Vc0, Vc1}; run_gemm(H, 1024, (const bf16_t*)(ws + WS_WT_NAT), 8192, 1024, e, smem);
          if (PROBE & 1) { GSYNC(); run_gemm(H, 1024, (const bf16_t*)(ws + WS_WT_NAT), 8192, 1024, e, smem); }
          { const int t2 = otid(); for (int v = blockIdx.x * NT + t2; v < 2 * 131072; v += gridDim.x * NT) { const int w = v >= 131072; const size_t o = (size_t)(v - w * 131072) * 8;
                const float* sp = (w ? p.in[5] : p.in[4]) + o; const f32x4 a = *(const f32x4*)sp, b2 = *(const f32x4*)(sp + 4); *(u32x4*)((w ? CVb : CKb) + o) = pack44(a, b2); } } }
        GSYNC();
        { const AttnBufs ab{Q, Z, Kl, Vl, Kc, Vc0, Vc1, CKb, CVb};
          if (PROBE & 32) { attn_phase<true>(p, ab, smem); GSYNC(); }
          attn_phase<false>(p, ab, smem); }
        GSYNC();
        { EpiOut e{p.in[0], p.in[1], p.out, MOD + 3 * 3 * 3072, nullptr, 0}; run_gemm(Q, 2048, WtOut + (size_t)3 * 1024 * 2048, 1024, 2048, e, smem); }
        GSYNC();
    }
    final_phase(p);
}

extern "C" void kernel_launch(void* const* d_in, const int* in_sizes, int n_in, void* d_out, int out_size, void* d_ws, size_t ws_size,
                              hipStream_t stream) {
    static int grid_blocks = 0;
    if (grid_blocks == 0) {
        int dev = 0, cus = 0, per_cu = 0;
        hipGetDevice(&dev);
        hipDeviceGetAttribute(&cus, hipDeviceAttributeMultiprocessorCount, dev);
        if (hipFuncSetAttribute((const void*)fwd_megakernel, hipFuncAttributeMaxDynamicSharedMemorySize, LDS_BYTES) != hipSuccess) { fprintf(stderr, "hipFuncSetAttribute failed\n"); }
        if (hipOccupancyMaxActiveBlocksPerMultiprocessor(&per_cu, (const void*)fwd_megakernel, NT, LDS_BYTES) != hipSuccess || per_cu < 1) { fprintf(stderr, "occupancy query failed (%d)\n", per_cu); per_cu = 1; }
        (void)hipGetLastError();
        grid_blocks = cus;
        if (ws_size < WS_END) { fprintf(stderr, "workspace too small: %zu < %zu\n", ws_size, (size_t)WS_END); grid_blocks = -1; }
        if (n_in != 38) { fprintf(stderr, "expected 38 inputs, got %d\n", n_in); grid_blocks = -1; }
    }
    if (grid_blocks < 0) return;
    Params p;
    memset(&p, 0, sizeof(p));
    for (int i = 0; i < 38; ++i) p.in[i] = (const float*)d_in[i];
    p.out = (float*)d_out; p.ws = (char*)d_ws;
    char* ws = (char*)d_ws;
    int t0 = 0;
    auto job = [&](int i, const float* src, size_t off, int K, int N, int Npad) {
        p.jobs[i].src = src; p.jobs[i].dst = (bf16_t*)(ws + off); p.jobs[i].K = K; p.jobs[i].N = N; p.jobs[i].Npad = Npad; p.jobs[i].tile0 = t0; t0 += (K / 64) * (Npad / 64);
    };
    job(0, p.in[13], WS_WT_SSD, 1024, 6208, 6400);
    job(1, p.in[20], WS_WT_MLP, 1024, 6144, 6144);
    job(2, p.in[25], WS_WT_S5, 1024, 4096, 4096);
    job(3, p.in[36], WS_WT_NAT, 1024, 8192, 8192);
    job(4, p.in[34], WS_WT_GLU, 2048, 2048, 2048);
    for (int l = 0; l < 4; ++l) job(5 + l, p.in[11] + (size_t)l * 2048 * 1024, WS_WT_OUT + (size_t)l * 1024 * 2048 * 2, 2048, 1024, 1024);
    p.total_tiles = t0;
    if (hipMemsetAsync(ws + WS_BAR, 0, XCD_BAR_WORDS * 4, stream) != hipSuccess) { fprintf(stderr, "memset of barrier words failed\n"); return; }
    void* args[] = {&p};
    hipError_t e = hipLaunchCooperativeKernel((const void*)fwd_megakernel, dim3(grid_blocks), dim3(NT), args, LDS_BYTES, stream);
    if (e != hipSuccess) fprintf(stderr, "cooperative launch failed: %s (grid %d)\n", hipGetErrorString(e), grid_blocks);
}
```

```cpp
#include <hip/hip_runtime.h>
#include <hip/hip_cooperative_groups.h>
#include <cstdio>
#include <cstdint>
#include <cstring>
namespace cg = cooperative_groups;

typedef unsigned short bf16_t;
typedef short bf16x8 __attribute__((ext_vector_type(8)));
typedef short s16x4 __attribute__((ext_vector_type(4)));
typedef float f32x4 __attribute__((ext_vector_type(4)));
typedef float f32x2 __attribute__((ext_vector_type(2)));
typedef unsigned u32x4 __attribute__((ext_vector_type(4)));
typedef unsigned u32x2 __attribute__((ext_vector_type(2)));
#define LAS __attribute__((address_space(3)))
#define WAVE_LDS_SYNC() do { asm volatile("s_waitcnt lgkmcnt(0)" ::: "memory"); __builtin_amdgcn_wave_barrier(); } while (0)

#define PROBE 0
constexpr int NT = 512;
constexpr int DM = 1024, EE = 2048;
constexpr int TOK = 12288, TOKC = 8192;
constexpr int NCHUNK = 96;
constexpr float EPSN = 1e-6f;
constexpr int LDS_BYTES = 163840;

constexpr size_t WS_WT_SSD = 0;
constexpr size_t WS_WT_MLP = WS_WT_SSD + (size_t)6400 * 1024 * 2;
constexpr size_t WS_WT_S5  = WS_WT_MLP + (size_t)6144 * 1024 * 2;
constexpr size_t WS_WT_NAT = WS_WT_S5 + (size_t)4096 * 1024 * 2;
constexpr size_t WS_WT_GLU = WS_WT_NAT + (size_t)8192 * 1024 * 2;
constexpr size_t WS_WT_OUT = WS_WT_GLU + (size_t)2048 * 2048 * 2;
constexpr size_t WS_H      = WS_WT_OUT + (size_t)4 * 1024 * 2048 * 2;
constexpr size_t WS_MOD    = WS_H + (size_t)TOK * 1024 * 2;
constexpr size_t WS_DT     = WS_MOD + 147456;
constexpr size_t WS_ACUM   = WS_DT + (size_t)TOK * 64 * 4;
constexpr size_t WS_SSQ    = WS_ACUM + (size_t)TOK * 64 * 4;
constexpr size_t WS_STATS  = WS_SSQ + (size_t)TOK * 32 * 4;
constexpr size_t WS_BAR    = WS_STATS + (size_t)TOK * 8;
constexpr size_t WS_U      = WS_H + (size_t)TOK * 1024 * 2 + 8388608;
constexpr size_t WS_END    = WS_U + (size_t)TOK * 6144 * 2;
static_assert(WS_BAR + 16384 <= WS_U, "small region overflow");
static_assert(WS_END <= 268435456, "workspace over 256 MiB");

constexpr size_t OUT_SSD = (size_t)TOK * 1024;
constexpr size_t OUT_S5  = OUT_SSD + (size_t)32 * 2 * 32 * 64 * 128;
constexpr size_t OUT_CK  = OUT_S5 + (size_t)32 * 2 * 2 * 128 * 64;
constexpr size_t OUT_CV  = OUT_CK + (size_t)32 * 32 * 256 * 64;

struct TJob { const float* src; bf16_t* dst; int K, N, Npad, tile0; };
struct Params {
    const float* in[38];
    float* out;
    char* ws;
    TJob jobs[9];
    int total_tiles, pad;
};

__device__ __forceinline__ float bf2f(unsigned h) { return __uint_as_float(h << 16); }
__device__ __forceinline__ float bflo(unsigned u) { return __uint_as_float(u << 16); }
__device__ __forceinline__ float bfhi(unsigned u) { return __uint_as_float(u & 0xffff0000u); }
typedef __bf16 bf16v2_t __attribute__((ext_vector_type(2)));
__device__ __forceinline__ unsigned pack2(float a, float b) { f32x2 v; v[0] = a; v[1] = b; return __builtin_bit_cast(unsigned, __builtin_convertvector(v, bf16v2_t)); }
__device__ __forceinline__ unsigned f2bf(float f) { return pack2(f, 0.f) & 0xffffu; }
__device__ __forceinline__ u32x2 pack4(f32x4 v) { u32x2 r; r.x = pack2(v[0], v[1]); r.y = pack2(v[2], v[3]); return r; }
__device__ __forceinline__ f32x4 unpack4(u32x2 u) { f32x4 r; r[0] = bflo(u.x); r[1] = bfhi(u.x); r[2] = bflo(u.y); r[3] = bfhi(u.y); return r; }
__device__ __forceinline__ void unpack8(u32x4 u, float* f) {
    f[0] = bflo(u.x); f[1] = bfhi(u.x); f[2] = bflo(u.y); f[3] = bfhi(u.y); f[4] = bflo(u.z); f[5] = bfhi(u.z); f[6] = bflo(u.w); f[7] = bfhi(u.w);
}
__device__ __forceinline__ u32x4 pack8(const float* f) { u32x4 r; r.x = pack2(f[0], f[1]); r.y = pack2(f[2], f[3]); r.z = pack2(f[4], f[5]); r.w = pack2(f[6], f[7]); return r; }
__device__ __forceinline__ float fast_rcp(float x) { return __builtin_amdgcn_rcpf(x); }
__device__ __forceinline__ float siluf(float x) { return x * fast_rcp(1.f + __expf(-x)); }
__device__ __forceinline__ float sigmf(float x) { return fast_rcp(1.f + __expf(-x)); }
__device__ __forceinline__ float geluf(float x) {
    const float y2 = 1.5957691216057308f * (x + 0.044715f * x * x * x);
    return x * fast_rcp(1.f + __expf(-y2));
}
__device__ __forceinline__ float softplusf(float x) { return x > 20.f ? x : log1pf(__expf(x)); }
__device__ __forceinline__ float wave_sum(float v) {
#pragma unroll
    for (int o = 32; o > 0; o >>= 1) v += __shfl_xor(v, o);
    return v;
}
__device__ __forceinline__ int otid() { int t = threadIdx.x; asm volatile("" : "+v"(t)); return t; }
__device__ __forceinline__ int cond_idx(int t) { return t < TOKC ? 0 : 1 + ((t - TOKC) >> 11); }
__device__ __forceinline__ f32x4 mfma16(bf16x8 a, bf16x8 b, f32x4 c) { return __builtin_amdgcn_mfma_f32_16x16x32_bf16(a, b, c, 0, 0, 0); }
__device__ __forceinline__ bf16x8 as_frag(u32x4 u) { union { u32x4 a; bf16x8 b; } x; x.a = u; return x.b; }

__device__ __forceinline__ bf16x8 frag_rm(const bf16_t* tile, int stride, int row0, int k0, int lane) {
    return *(const bf16x8*)(tile + (row0 + (lane & 15)) * stride + k0 + 8 * (lane >> 4));
}
__device__ __forceinline__ bf16x8 frag_tr(const bf16_t* tile, int stride, int k0, int c0, int lane) {
    const bf16_t* p = tile + (k0 + 8 * (lane >> 4) + ((lane >> 2) & 3)) * stride + c0 + 4 * (lane & 3);
    s16x4 lo = __builtin_amdgcn_ds_read_tr16_b64_v4i16((LAS s16x4*)p);
    s16x4 hi = __builtin_amdgcn_ds_read_tr16_b64_v4i16((LAS s16x4*)(p + 4 * stride));
    bf16x8 r; r[0] = lo[0]; r[1] = lo[1]; r[2] = lo[2]; r[3] = lo[3]; r[4] = hi[0]; r[5] = hi[1]; r[6] = hi[2]; r[7] = hi[3];
    return r;
}
__device__ __forceinline__ int sw64(int row, int col) { return row * 64 + ((((col >> 3) ^ (row >> 1)) & 7) << 3) + (col & 7); }
__device__ __forceinline__ bf16x8 frag_rm_sw(const bf16_t* tile, int row0, int k0, int lane) {
    const int row = row0 + (lane & 15);
    return *(const bf16x8*)(tile + sw64(row, k0 + 8 * (lane >> 4)));
}
__device__ __forceinline__ bf16x8 frag_tr_sw(const bf16_t* tile, int k0, int c0, int lane) {
    const int row = k0 + 8 * (lane >> 4) + ((lane >> 2) & 3), col = c0 + 4 * (lane & 3);
    s16x4 lo = __builtin_amdgcn_ds_read_tr16_b64_v4i16((LAS s16x4*)(tile + sw64(row, col)));
    s16x4 hi = __builtin_amdgcn_ds_read_tr16_b64_v4i16((LAS s16x4*)(tile + sw64(row + 4, col)));
    bf16x8 r; r[0] = lo[0]; r[1] = lo[1]; r[2] = lo[2]; r[3] = lo[3]; r[4] = hi[0]; r[5] = hi[1]; r[6] = hi[2]; r[7] = hi[3];
    return r;
}


namespace pg8 {
#define PG8_LAS __attribute__((address_space(3)))
constexpr int BM = 256, BK = 64, HALF = 128, HTB = HALF * BK * 2  , STAGE_BYTES = 8 * HTB, NXCD = 8, WGM = 8;

__host__ __device__ __forceinline__ int lds_byte(int r, int c) { const int st = (r >> 4) * 2 + (c >> 5), rr = r & 15, cc = c & 31, ob = rr * 64 + cc * 2; return st * 1024 + (ob ^ (((ob >> 9) & 1) << 5)); }
__host__ __device__ __forceinline__ void stage_rc(int b, int& R, int& C) { const int st = b / 1024, sb = b % 1024, swz = sb ^ (((sb >> 9) & 1) << 5); R = (st >> 1) * 16 + swz / 64; C = (st & 1) * 32 + (swz % 64) / 2; }
__host__ __device__ __forceinline__ int perm32(int rho) { const int n = rho >> 4, i = rho & 15; return 8 * (i >> 2) + 4 * n + (i & 3); }
struct Unit { int pm, pn; };
struct Gemm { const bf16_t* A; const bf16_t* Bt; int M, N, K, lda; };
struct StaticOrder {
    int nM, nN, nwg, G, c;
    __host__ __device__ void init(int M, int N, int G_, int c_) { nM = M / BM; nN = N / BM; nwg = nM * nN; G = G_; c = c_; }
    __host__ __device__ bool next(int i, Unit& u) const {
        const long L = (long)i * G + c; if (L >= nwg) return false;
        int wgid = (int)L; { const int q = nwg / NXCD, r = nwg % NXCD, xcd = wgid % NXCD, off = wgid / NXCD; wgid = (xcd < r ? xcd * (q + 1) : r * (q + 1) + (xcd - r) * q) + off; }
        const int nig = WGM * nN, gid = wgid / nig, fm = gid * WGM, gsz = (nM - fm) < WGM ? (nM - fm) : WGM;
        u.pm = fm + ((wgid % nig) % gsz); u.pn = (wgid % nig) / gsz; return true;
    }
    __device__ __forceinline__ void a_ready(const Unit&) const {}
    __device__ __forceinline__ void done(const Unit&) const {}
};
template <class Epi, class Sched, bool ALIGN_EPI = false, bool SP2 = false>
__device__ __forceinline__ void gemm_phase(PG8_LAS unsigned char* lds, const Gemm g, const Sched& S, const Epi& E) {
    int tid_ = threadIdx.x; asm volatile("" : "+v"(tid_));
    const int tid = tid_, wid = __builtin_amdgcn_readfirstlane(tid >> 6), lane = tid & 63, wr = wid >> 2, wc = wid & 3, fr = lane & 15, fq = lane >> 4;
    const int K = g.K, nt = K / BK;
    unsigned voffA[2], voffB[2];
#pragma unroll
    for (int i = 0; i < 2; ++i) { int R, C; stage_rc(tid * 16 + i * 8192, R, C); const int Rb = Epi::PERM ? ((R & ~31) + perm32(R & 31)) : R;
        voffA[i] = (unsigned)(R * g.lda + C) * 2u; voffB[i] = (unsigned)(Rb * K + C) * 2u; }
    const size_t kstep = (size_t)(BK * 2);
    const size_t hstep = (size_t)HALF * K * 2;
    const size_t tstep = 2 * hstep;
    const size_t hstepA = (size_t)HALF * g.lda * 2, tstepA = 2 * hstepA;
    const unsigned ldsw = (unsigned)wid * 1024u;
    const int aoff = lds_byte(wr * 64 + fr, fq * 8), boff = lds_byte(wc * 32 + fr, fq * 8);
#define PG8_SA(b, h) (((b) * 2 + (h)) * HTB)
#define PG8_SB(b, h) ((4 + (b) * 2 + (h)) * HTB)
#define PG8_STAGE(bufoff, gbase, voff) do { _Pragma("unroll") for (int _i = 0; _i < 2; ++_i) \
        __builtin_amdgcn_global_load_lds((const unsigned*)((const char*)(gbase) + (voff)[_i]), (PG8_LAS unsigned*)(lds + (bufoff) + ldsw + _i * 8192), 16, 0, 0); } while (0)
#define PG8_LDA(dst, b, h) do { _Pragma("unroll") for (int m = 0; m < 4; ++m) _Pragma("unroll") for (int k = 0; k < 2; ++k) dst[m][k] = *(const PG8_LAS bf16x8*)(lds + PG8_SA(b, h) + aoff + m * 2048 + k * 1024); } while (0)
#define PG8_LDB(dst, b, h) do { _Pragma("unroll") for (int n = 0; n < 2; ++n) _Pragma("unroll") for (int k = 0; k < 2; ++k) dst[n][k] = *(const PG8_LAS bf16x8*)(lds + PG8_SB(b, h) + boff + n * 2048 + k * 1024); } while (0)
#define PG8_MMA(ai, bj, At, Bt) do { __builtin_amdgcn_s_setprio(1); _Pragma("unroll") for (int m = 0; m < 4; ++m) _Pragma("unroll") for (int n = 0; n < 2; ++n) _Pragma("unroll") for (int k = 0; k < 2; ++k) \
        acc[ai][bj][m][n] = __builtin_amdgcn_mfma_f32_16x16x32_bf16(Bt[n][k], At[m][k], acc[ai][bj][m][n], 0, 0, 0); __builtin_amdgcn_s_setprio(0); } while (0)
#define PG8_WAIT_V(n) asm volatile("s_waitcnt vmcnt(" #n ")" ::: "memory")
#define PG8_WAIT_L(n) asm volatile("s_waitcnt lgkmcnt(" #n ")" ::: "memory")
#define PG8_BAR __builtin_amdgcn_s_barrier()
#define PG8_SCHED __builtin_amdgcn_sched_barrier(0)
    Unit cur, nxt; int ui = 0;
    if (!S.next(0, cur)) return;
    f32x4 acc[2][2][4][2];
#pragma unroll
    for (int a = 0; a < 2; ++a)
#pragma unroll
        for (int b = 0; b < 2; ++b)
#pragma unroll
            for (int m = 0; m < 4; ++m)
#pragma unroll
                for (int n = 0; n < 2; ++n) acc[a][b][m][n] = (f32x4){0.f, 0.f, 0.f, 0.f};
    bf16x8 At[4][2], B0[2][2], B1[2][2];
    const char* cA = (const char*)g.A + (size_t)cur.pm * tstepA; const char* cB = (const char*)g.Bt + (size_t)cur.pn * tstep;
    S.a_ready(cur);
    if constexpr (SP2) {
        PG8_STAGE(PG8_SB(0, 0), cB, voffB); PG8_STAGE(PG8_SB(0, 1), cB + hstep, voffB); PG8_STAGE(PG8_SA(0, 0), cA, voffA); PG8_STAGE(PG8_SA(0, 1), cA + hstepA, voffA);
        if (wr == 1) PG8_BAR;
        PG8_WAIT_V(2); PG8_BAR;
        PG8_STAGE(PG8_SB(1, 0), cB + kstep, voffB); PG8_STAGE(PG8_SA(1, 0), cA + kstep, voffA); PG8_STAGE(PG8_SB(1, 1), cB + hstep + kstep, voffB);
        PG8_WAIT_V(6); PG8_BAR;
    } else {
        PG8_STAGE(PG8_SB(0, 0), cB, voffB); PG8_STAGE(PG8_SA(0, 0), cA, voffA); PG8_STAGE(PG8_SB(0, 1), cB + hstep, voffB); PG8_STAGE(PG8_SA(0, 1), cA + hstepA, voffA);
        if (wr == 1) PG8_BAR;
        PG8_WAIT_V(4); PG8_BAR;
        PG8_STAGE(PG8_SB(1, 0), cB + kstep, voffB); PG8_STAGE(PG8_SA(1, 0), cA + kstep, voffA); PG8_STAGE(PG8_SB(1, 1), cB + hstep + kstep, voffB);
        PG8_WAIT_V(6); PG8_BAR;
    }
    for (;;) {
        const bool has_next = S.next(ui + 1, nxt);
        const char* nA = has_next ? (const char*)g.A + (size_t)nxt.pm * tstepA : cA; const char* nB = has_next ? (const char*)g.Bt + (size_t)nxt.pn * tstep : cB;
        for (int t = 0; t < nt; t += 2) {
            const bool last = (t == nt - 2);
            const char* a1 = cA + (size_t)(t + 1) * kstep;
            const char* a2 = last ? nA : cA + (size_t)(t + 2) * kstep; const char* b2 = last ? nB : cB + (size_t)(t + 2) * kstep;
            const char* a3 = a2 + kstep; const char* b3 = b2 + kstep;
            if (last && has_next) S.a_ready(nxt);
            if constexpr (SP2) {
            PG8_LDB(B0, 0, 0); PG8_LDB(B1, 0, 1); PG8_SCHED; PG8_LDA(At, 0, 0); PG8_STAGE(PG8_SA(1, 1), a1 + hstepA, voffA);
            PG8_WAIT_V(8); PG8_WAIT_L(0); PG8_BAR; PG8_MMA(0, 0, At, B0); PG8_MMA(0, 1, At, B1); PG8_BAR; PG8_SCHED;
            PG8_LDA(At, 0, 1); PG8_STAGE(PG8_SB(0, 0), b2, voffB); PG8_STAGE(PG8_SB(0, 1), b2 + hstep, voffB); PG8_STAGE(PG8_SA(0, 0), a2, voffA);
            PG8_WAIT_V(8); PG8_WAIT_L(0); PG8_BAR; PG8_MMA(1, 0, At, B0); PG8_MMA(1, 1, At, B1); PG8_BAR; PG8_SCHED;
            PG8_LDB(B0, 1, 0); PG8_LDB(B1, 1, 1); PG8_SCHED; PG8_LDA(At, 1, 0); PG8_STAGE(PG8_SA(0, 1), a2 + hstepA, voffA);
            PG8_WAIT_V(8); PG8_WAIT_L(0); PG8_BAR; PG8_MMA(0, 0, At, B0); PG8_MMA(0, 1, At, B1); PG8_BAR; PG8_SCHED;
            PG8_LDA(At, 1, 1); PG8_STAGE(PG8_SB(1, 0), b3, voffB); PG8_STAGE(PG8_SB(1, 1), b3 + hstep, voffB); PG8_STAGE(PG8_SA(1, 0), a3, voffA);
            PG8_WAIT_V(8); PG8_WAIT_L(0); PG8_BAR; PG8_MMA(1, 0, At, B0); PG8_MMA(1, 1, At, B1); PG8_BAR; PG8_SCHED;
            } else {
            PG8_LDB(B0, 0, 0); PG8_SCHED; PG8_LDA(At, 0, 0); PG8_STAGE(PG8_SA(1, 1), a1 + hstepA, voffA);
            PG8_WAIT_L(8); PG8_BAR; PG8_WAIT_L(0); PG8_MMA(0, 0, At, B0); PG8_BAR; PG8_SCHED;
            PG8_LDB(B1, 0, 1); PG8_STAGE(PG8_SB(0, 0), b2, voffB);
            PG8_BAR; PG8_WAIT_L(0); PG8_MMA(0, 1, At, B1); PG8_BAR;
            PG8_LDA(At, 0, 1); PG8_STAGE(PG8_SA(0, 0), a2, voffA);
            PG8_BAR; PG8_WAIT_L(0); PG8_MMA(1, 0, At, B0); PG8_BAR; PG8_SCHED;
            PG8_STAGE(PG8_SB(0, 1), b2 + hstep, voffB);
            PG8_WAIT_V(6); PG8_BAR; PG8_MMA(1, 1, At, B1); PG8_BAR;
            PG8_LDB(B0, 1, 0); PG8_SCHED; PG8_LDA(At, 1, 0); PG8_STAGE(PG8_SA(0, 1), a2 + hstepA, voffA);
            PG8_WAIT_L(8); PG8_BAR; PG8_WAIT_L(0); PG8_MMA(0, 0, At, B0); PG8_BAR; PG8_SCHED;
            PG8_LDB(B1, 1, 1); PG8_STAGE(PG8_SB(1, 0), b3, voffB);
            PG8_BAR; PG8_WAIT_L(0); PG8_MMA(0, 1, At, B1); PG8_BAR;
            PG8_LDA(At, 1, 1); PG8_STAGE(PG8_SA(1, 0), a3, voffA);
            PG8_BAR; PG8_WAIT_L(0); PG8_MMA(1, 0, At, B0); PG8_BAR; PG8_SCHED;
            PG8_STAGE(PG8_SB(1, 1), b3 + hstep, voffB);
            PG8_WAIT_V(6); PG8_BAR; PG8_MMA(1, 1, At, B1); PG8_BAR;
            }
        }
        if constexpr (ALIGN_EPI) { if (wr == 0) PG8_BAR; }
        if constexpr (!Epi::AFTER_DRAIN) { E(acc, cur, wr, wc, fr, fq); S.done(cur); }
        if (!has_next) break;
#pragma unroll
        for (int a = 0; a < 2; ++a)
#pragma unroll
            for (int b = 0; b < 2; ++b)
#pragma unroll
                for (int m = 0; m < 4; ++m)
#pragma unroll
                    for (int n = 0; n < 2; ++n) acc[a][b][m][n] = (f32x4){0.f, 0.f, 0.f, 0.f};
        cur = nxt; cA = nA; cB = nB; ++ui;
        if constexpr (ALIGN_EPI) { if (wr == 1) PG8_BAR; }
    }
    PG8_WAIT_V(0);
    if constexpr (!ALIGN_EPI) { if (wr == 0) PG8_BAR; }
    PG8_BAR;
    if constexpr (Epi::AFTER_DRAIN) { E.fused(acc, cur, wr, wc, fr, fq, lds, wid, lane); S.done(cur); }
#undef PG8_SA
#undef PG8_SB
#undef PG8_STAGE
#undef PG8_LDA
#undef PG8_LDB
#undef PG8_MMA
#undef PG8_WAIT_V
#undef PG8_WAIT_L
#undef PG8_BAR
#undef PG8_SCHED
}
}

template <class E> struct PgEpi {
    static constexpr bool PERM = true, AFTER_DRAIN = false;
    E e;
    __device__ __forceinline__ void operator()(const f32x4 (&acc)[2][2][4][2], const pg8::Unit& u, int wr, int wc, int fr, int fq) const {
#pragma unroll
        for (int ai = 0; ai < 2; ++ai)
#pragma unroll
            for (int m = 0; m < 4; ++m) {
                const int row = u.pm * 256 + ai * 128 + wr * 64 + m * 16 + fr;
                const float rs = e.rowscale(row);
#pragma unroll
                for (int bj = 0; bj < 2; ++bj) e(row, u.pn * 256 + bj * 128 + wc * 32 + fq * 8, acc[ai][bj][m][0], acc[ai][bj][m][1], rs);
            }
    }
};
struct XcdOrder {
    int nM, nN, G8, c, tmx, perX;
    __device__ void init(int M, int N, int G_, int c_) { nM = M / 256; nN = N / 256; G8 = G_ >> 3; c = c_; tmx = nM >> 3; perX = tmx * nN; }
    __device__ bool next(int i, pg8::Unit& u) const {
        const int j = i * G8 + (c >> 3); if (j >= perX) return false;
        const int pn = j / tmx; u.pn = pn; u.pm = (c & 7) * tmx + (j - pn * tmx); return true;
    }
    __device__ __forceinline__ void a_ready(const pg8::Unit&) const {}
    __device__ __forceinline__ void done(const pg8::Unit&) const {}
};
#define GEMM_ORDER 0
template <class E>
__device__ __forceinline__ void run_gemm(const bf16_t* A, int lda, const bf16_t* Bt, int N, int K, const E& e, char* smem) {
    pg8::Gemm g{A, Bt, TOK, N, K, lda};
    PgEpi<E> pe{e};
#if GEMM_ORDER
    XcdOrder S; S.init(TOK, N, (int)gridDim.x, (int)blockIdx.x);
    pg8::gemm_phase<PgEpi<E>, XcdOrder, true, true>((LAS unsigned char*)smem, g, S, pe);
#else
    pg8::StaticOrder S; S.init(TOK, N, (int)gridDim.x, (int)blockIdx.x);
    pg8::gemm_phase<PgEpi<E>, pg8::StaticOrder, true, true>((LAS unsigned char*)smem, g, S, pe);
#endif
}

__device__ __forceinline__ u32x4 pack44(f32x4 a, f32x4 b) { u32x4 r; r.x = pack2(a[0], a[1]); r.y = pack2(a[2], a[3]); r.z = pack2(b[0], b[1]); r.w = pack2(b[2], b[3]); return r; }
__device__ __forceinline__ void unpack44(u32x4 u, f32x4& a, f32x4& b) { a[0] = bflo(u.x); a[1] = bfhi(u.x); a[2] = bflo(u.y); a[3] = bfhi(u.y); b[0] = bflo(u.z); b[1] = bfhi(u.z); b[2] = bflo(u.w); b[3] = bfhi(u.w); }
__device__ __forceinline__ f32x4 silu4(f32x4 v) { f32x4 s; s[0] = siluf(v[0]); s[1] = siluf(v[1]); s[2] = siluf(v[2]); s[3] = siluf(v[3]); return s; }
__device__ __forceinline__ f32x4 gelu4(f32x4 v) { f32x4 s; s[0] = geluf(v[0]); s[1] = geluf(v[1]); s[2] = geluf(v[2]); s[3] = geluf(v[3]); return s; }
struct EpiSSD {
    bf16_t* Uz; bf16_t* Uxbc; float* DT; const float* dt_bias;
    __device__ __forceinline__ float rowscale(int) const { return 1.f; }
    __device__ __forceinline__ void operator()(int row, int col, f32x4 v0, f32x4 v1, float) const {
        if (col < 2048) { *(u32x4*)(Uz + (size_t)row * 2048 + col) = pack44(silu4(v0), silu4(v1)); }
        else if (col < 6144) { *(u32x4*)(Uxbc + (size_t)row * 4096 + (col - 2048)) = pack44(v0, v1); }
        else if (col < 6208) { const int c = col - 6144; const f32x4 b0 = *(const f32x4*)(dt_bias + c), b1 = *(const f32x4*)(dt_bias + c + 4);
            *(f32x4*)(DT + (size_t)row * 64 + c) = v0 + b0; *(f32x4*)(DT + (size_t)row * 64 + c + 4) = v1 + b1; }
    }
};
struct EpiMLP {
    bf16_t* U;
    __device__ __forceinline__ float rowscale(int) const { return 1.f; }
    __device__ __forceinline__ void operator()(int row, int col, f32x4 v0, f32x4 v1, float) const {
        u32x4 o;
        if (col < 4096) o = pack44(gelu4(v0), gelu4(v1)); else o = pack44(silu4(v0), silu4(v1));
        *(u32x4*)(U + (size_t)row * 6144 + col) = o;
    }
};
struct EpiS5 {
    bf16_t* Uu; bf16_t* Uz;
    __device__ __forceinline__ float rowscale(int) const { return 1.f; }
    __device__ __forceinline__ void operator()(int row, int col, f32x4 v0, f32x4 v1, float) const {
        if (col < 2048) *(u32x4*)(Uu + (size_t)row * 2048 + col) = pack44(v0, v1);
        else *(u32x4*)(Uz + (size_t)row * 2048 + (col - 2048)) = pack44(silu4(v0), silu4(v1));
    }
};
struct EpiNAT {
    bf16_t* Q; bf16_t* Z; bf16_t* Kl; bf16_t* Vl; float* ck; float* cv; bf16_t* Kc; bf16_t* Vc0; bf16_t* Vc1;
    __device__ __forceinline__ float rowscale(int) const { return 1.f; }
    __device__ __forceinline__ void operator()(int row, int col, f32x4 v0, f32x4 v1, float) const {
        if (col < 2048) { *(u32x4*)(Q + (size_t)row * 2048 + col) = pack44(v0 * 0.18033688011112042f, v1 * 0.18033688011112042f); }
        else if (col < 6144) {
            const bool isv = col >= 4096; const int c = col - (isv ? 4096 : 2048);
            if (row < TOKC) { const int b = row >> 8, s = row & 255, h = c >> 6, d = c & 63; float* dst = (isv ? cv : ck) + ((size_t)((b * 32 + h) * 256 + s)) * 64 + d; *(f32x4*)dst = v0; *(f32x4*)(dst + 4) = v1;
                bf16_t* d2 = isv ? ((b < 20 ? Vc0 + (size_t)row * 2048 : Vc1 + (size_t)(row - 20 * 256) * 2048) + c) : (Kc + (size_t)row * 2048 + c);
                *(u32x4*)d2 = pack44(v0, v1); }
            else { bf16_t* dst = (isv ? Vl : Kl) + (size_t)(row - TOKC) * 2048 + c; *(u32x4*)dst = pack44(v0, v1); }
        } else { *(u32x4*)(Z + (size_t)row * 2048 + (col - 6144)) = pack44(silu4(v0), silu4(v1)); }
    }
};
struct EpiOut {
    const float* xp; const float* xs; float* X; const float* modl; const float* ssq; int first;
    __device__ __forceinline__ float rowscale(int row) const {
        if (!ssq) return 1.f;
        const f32x4* p = (const f32x4*)(ssq + (size_t)row * 32); float s = 0.f;
#pragma unroll
        for (int i = 0; i < 8; ++i) { f32x4 v = p[i]; s += (v[0] + v[1]) + (v[2] + v[3]); }
        return rsqrtf(s * (1.f / 2048.f) + EPSN);
    }
    __device__ __forceinline__ void operator()(int row, int col, f32x4 v0, f32x4 v1, float rs) const {
        const float* gp = modl + cond_idx(row) * 3072 + 2048 + col;
        const f32x4 g0 = *(const f32x4*)gp, g1 = *(const f32x4*)(gp + 4);
        const float* xin = (first ? (row < TOKC ? xp + (size_t)row * 1024 : xs + (size_t)(row - TOKC) * 1024) : X + (size_t)row * 1024) + col;
        const f32x4 x0 = *(const f32x4*)xin, x1 = *(const f32x4*)(xin + 4);
        float* o = X + (size_t)row * 1024 + col;
        *(f32x4*)o = x0 + g0 * (v0 * rs); *(f32x4*)(o + 4) = x1 + g1 * (v1 * rs);
    }
};
struct EpiGLU {
    const bf16_t* Yb; bf16_t* Uz; const float* bglu;
    __device__ __forceinline__ float rowscale(int) const { return 1.f; }
    __device__ __forceinline__ void operator()(int row, int col, f32x4 v0, f32x4 v1, float) const {
        f32x4 y0, y1, z0, z1; unpack44(*(const u32x4*)(Yb + (size_t)row * 2048 + col), y0, y1); unpack44(*(const u32x4*)(Uz + (size_t)row * 2048 + col), z0, z1);
        const f32x4 b0 = *(const f32x4*)(bglu + col), b1 = *(const f32x4*)(bglu + col + 4);
        f32x4 o0, o1;
#pragma unroll
        for (int i = 0; i < 4; ++i) { o0[i] = y0[i] * sigmf(v0[i] + b0[i]) * z0[i]; o1[i] = y1[i] * sigmf(v1[i] + b1[i]) * z1[i]; }
        *(u32x4*)(Uz + (size_t)row * 2048 + col) = pack44(o0, o1);
    }
};

__device__ __forceinline__ void prep_phase(const Params& p, char* smem) {
    int tid_ = threadIdx.x; asm volatile("" : "+v"(tid_));
    const int tid = tid_, lane = tid & 63, wid = tid >> 6;
    float* tile = (float*)smem;
    for (int T4 = blockIdx.x; T4 < (p.total_tiles >> 2); T4 += gridDim.x) {
        const int T = T4 * 4;
        int j = 0;
#pragma unroll
        for (int q = 1; q < 9; ++q) if (T >= p.jobs[q].tile0) j = q;
        const float* src = p.jobs[j].src; bf16_t* dst = p.jobs[j].dst; const int K = p.jobs[j].K, N = p.jobs[j].N;
        const int local = T - p.jobs[j].tile0, nkt = K >> 6, kt = local % nkt, nt = local / nkt, k0 = kt * 64, n0 = nt * 64;
        __syncthreads();
        if (n0 < N) {
            f32x4 v[8];
#pragma unroll
            for (int q = 0; q < 8; ++q) { const int idx = tid + NT * q, r = idx >> 4, c4 = idx & 15; v[q] = *(const f32x4*)(src + (size_t)(k0 + r) * N + n0 + c4 * 4); }
#pragma unroll
            for (int q = 0; q < 8; ++q) { const int idx = tid + NT * q, r = idx >> 4, c4 = idx & 15; float* tp = tile + (r >> 6) * 4160 + (r & 63) * 65 + c4 * 4;
                tp[0] = v[q][0]; tp[1] = v[q][1]; tp[2] = v[q][2]; tp[3] = v[q][3]; }
        }
        __syncthreads();
        {
            const int nn = tid >> 3, kc = tid & 7;
#pragma unroll
            for (int s = 0; s < 4; ++s) { float f[8];
#pragma unroll
                for (int i = 0; i < 8; ++i) f[i] = (n0 < N) ? tile[s * 4160 + (kc * 8 + i) * 65 + nn] : 0.f;
                *(u32x4*)(dst + (size_t)(n0 + nn) * K + k0 + s * 64 + kc * 8) = pack8(f); }
        }
    }
    __syncthreads();
    float* sc = (float*)smem;
    float* part = (float*)smem + 3072;
    for (int q = tid; q < 3072; q += NT) { const int ci = q >> 10, k = q & 1023; const float cv = ci == 0 ? p.in[7][k] : p.in[6][(ci - 1) * 1024 + k]; sc[q] = siluf(cv); }
    __syncthreads();
    float* MOD = (float*)(p.ws + WS_MOD);
    for (int it = blockIdx.x; it < 192; it += gridDim.x) {
        const int layer = it / 48, cg0 = (it % 48) * 64, col = cg0 + lane;
        const float* w = p.in[9] + (size_t)layer * 1024 * 3072 + col;
        float a0 = 0.f, a1 = 0.f, a2 = 0.f;
        for (int k = wid * 128; k < wid * 128 + 128; k += 16) { float wv[16];
#pragma unroll
            for (int u = 0; u < 16; ++u) wv[u] = w[(size_t)(k + u) * 3072];
#pragma unroll
            for (int u = 0; u < 16; ++u) { a0 += sc[k + u] * wv[u]; a1 += sc[1024 + k + u] * wv[u]; a2 += sc[2048 + k + u] * wv[u]; } }
        part[(wid * 3 + 0) * 64 + lane] = a0; part[(wid * 3 + 1) * 64 + lane] = a1; part[(wid * 3 + 2) * 64 + lane] = a2;
        __syncthreads();
        if (tid < 192) { const int ci = tid >> 6, l = tid & 63; float s = p.in[10][layer * 3072 + cg0 + l];
#pragma unroll
            for (int w8 = 0; w8 < 8; ++w8) s += part[(w8 * 3 + ci) * 64 + l];
            MOD[(layer * 3 + ci) * 3072 + cg0 + l] = s; }
        __syncthreads();
    }
}

__device__ __forceinline__ void norm_phase(const Params& p, int layer) {
    const int tid = otid(), lane = tid & 63, gw = blockIdx.x * 8 + (tid >> 6), nw = gridDim.x * 8;
    const float* g = p.in[8] + layer * 1024;
    const float* MOD = (const float*)(p.ws + WS_MOD) + layer * 3 * 3072;
    bf16_t* H = (bf16_t*)(p.ws + WS_H);
    for (int tb = gw; tb < TOK; tb += 3 * nw) {
        f32x4 v[3][4]; float ss[3];
#pragma unroll
        for (int r = 0; r < 3; ++r) { const int t = tb + r * nw; ss[r] = 0.f;
            if (t < TOK) { const float* xr = layer == 0 ? (t < TOKC ? p.in[0] + (size_t)t * 1024 : p.in[1] + (size_t)(t - TOKC) * 1024) : p.out + (size_t)t * 1024;
#pragma unroll
                for (int j = 0; j < 4; ++j) v[r][j] = *(const f32x4*)(xr + j * 256 + lane * 4); } }
#pragma unroll
        for (int r = 0; r < 3; ++r) { const int t = tb + r * nw;
            if (t < TOK) {
#pragma unroll
                for (int j = 0; j < 4; ++j) ss[r] += v[r][j][0] * v[r][j][0] + v[r][j][1] * v[r][j][1] + v[r][j][2] * v[r][j][2] + v[r][j][3] * v[r][j][3];
                ss[r] = wave_sum(ss[r]);
                const float rstd = rsqrtf(ss[r] * (1.f / 1024.f) + EPSN);
                const float* md = MOD + cond_idx(t) * 3072;
#pragma unroll
                for (int j = 0; j < 4; ++j) {
                    const int c = j * 256 + lane * 4;
                    const f32x4 gg = *(const f32x4*)(g + c), sh = *(const f32x4*)(md + c), scl = *(const f32x4*)(md + 1024 + c);
                    f32x4 h; for (int i = 0; i < 4; ++i) h[i] = v[r][j][i] * rstd * gg[i] * (1.f + scl[i]) + sh[i];
                    *(u32x2*)(H + (size_t)t * 1024 + c) = pack4(h);
                }
            } }
    }
}
__device__ __forceinline__ void final_phase(const Params& p) {
    const int tid = otid(), lane = tid & 63, gw = blockIdx.x * 8 + (tid >> 6), nw = gridDim.x * 8;
    const float* g = p.in[12];
    for (int tb = gw; tb < TOK; tb += 3 * nw) {
        f32x4 v[3][4];
#pragma unroll
        for (int r = 0; r < 3; ++r) { const int t = tb + r * nw;
            if (t < TOK) { const float* xr = p.out + (size_t)t * 1024;
#pragma unroll
                for (int j = 0; j < 4; ++j) v[r][j] = *(const f32x4*)(xr + j * 256 + lane * 4); } }
#pragma unroll
        for (int r = 0; r < 3; ++r) { const int t = tb + r * nw;
            if (t < TOK) { float ss = 0.f; float* xr = p.out + (size_t)t * 1024;
#pragma unroll
                for (int j = 0; j < 4; ++j) ss += v[r][j][0] * v[r][j][0] + v[r][j][1] * v[r][j][1] + v[r][j][2] * v[r][j][2] + v[r][j][3] * v[r][j][3];
                ss = wave_sum(ss);
                const float rstd = rsqrtf(ss * (1.f / 1024.f) + EPSN);
#pragma unroll
                for (int j = 0; j < 4; ++j) { const int c = j * 256 + lane * 4; const f32x4 gg = *(const f32x4*)(g + c); *(f32x4*)(xr + c) = v[r][j] * rstd * gg; } } }
    }
}

__device__ __forceinline__ void ssd_conv_phase(const Params& p, const bf16_t* Uxbc, bf16_t* XBC) {
    int tid_ = threadIdx.x; asm volatile("" : "+v"(tid_));
    const int tid = tid_, lane = tid & 63, wid = tid >> 6;
    float* DT = (float*)(p.ws + WS_DT);
    float* ACUM = (float*)(p.ws + WS_ACUM);
    for (int ch = blockIdx.x * 8 + wid; ch < NCHUNK; ch += gridDim.x * 8) {
        const int t0 = ch * 128, d = lane >> 5;
        const float a = -__expf(p.in[17][lane]);
        float acc = 0.f;
        for (int i = 0; i < 128; ++i) { const int l = d ? 127 - i : i; const float dtv = softplusf(DT[(size_t)(t0 + l) * 64 + lane]); DT[(size_t)(t0 + l) * 64 + lane] = dtv; acc += dtv * a; ACUM[(size_t)(t0 + l) * 64 + lane] = acc; }
    }
    const int chn = tid * 8;
    float w[5][8], bias[8];
#pragma unroll
    for (int j = 0; j < 5; ++j) { const f32x4 a = *(const f32x4*)(p.in[14] + j * 4096 + chn), b = *(const f32x4*)(p.in[14] + j * 4096 + chn + 4);
        w[j][0] = a[0]; w[j][1] = a[1]; w[j][2] = a[2]; w[j][3] = a[3]; w[j][4] = b[0]; w[j][5] = b[1]; w[j][6] = b[2]; w[j][7] = b[3]; }
    { const f32x4 a = *(const f32x4*)(p.in[15] + chn), b = *(const f32x4*)(p.in[15] + chn + 4);
      bias[0] = a[0]; bias[1] = a[1]; bias[2] = a[2]; bias[3] = a[3]; bias[4] = b[0]; bias[5] = b[1]; bias[6] = b[2]; bias[7] = b[3]; }
    for (int grp = blockIdx.x; grp < TOK / 8; grp += gridDim.x) {
        const int t0 = grp * 8;
        int s0, s1;
        if (t0 < TOKC) { s0 = t0 & ~255; s1 = s0 + 256; } else { s0 = TOKC + ((t0 - TOKC) & ~2047); s1 = s0 + 2048; }
        u32x4 rowv[12];
#pragma unroll
        for (int i = 0; i < 12; ++i) { const int tt = t0 - 2 + i; rowv[i] = (u32x4){0u, 0u, 0u, 0u};
            if (tt >= s0 && tt < s1) rowv[i] = *(const u32x4*)(Uxbc + (size_t)tt * 4096 + chn); }
#pragma unroll
        for (int o = 0; o < 8; ++o) {
            float acc[8];
#pragma unroll
            for (int i = 0; i < 8; ++i) acc[i] = bias[i];
#pragma unroll
            for (int j = 0; j < 5; ++j) { float f[8]; unpack8(rowv[o + j], f);
#pragma unroll
                for (int i = 0; i < 8; ++i) acc[i] += w[j][i] * f[i]; }
#pragma unroll
            for (int i = 0; i < 8; ++i) acc[i] = siluf(acc[i]);
            *(u32x4*)(XBC + (size_t)(t0 + o) * 4096 + chn) = pack8(acc);
        }
    }
}

template <int NCH>
__device__ __forceinline__ void ssd_state_item(const Params& p, const bf16_t* XBC, bf16_t* SB, char* smem, int ch0, int g, int seq, int tid, int lane, int wid) {
    const float* DT = (const float*)(p.ws + WS_DT);
    const float* ACUM = (const float*)(p.ws + WS_ACUM);
    bf16_t* Bt = (bf16_t*)smem;
    bf16_t* Xs = Bt + NCH * 128 * 136;
    __syncthreads();
#pragma unroll
    for (int c = 0; c < NCH; ++c)
#pragma unroll
        for (int j = 0; j < 4; ++j) { const int q = tid + NT * j, row = q >> 4, cc = q & 15;
            *(u32x4*)(Bt + (c * 128 + row) * 136 + cc * 8) = *(const u32x4*)(XBC + (size_t)((ch0 + c) * 128 + row) * 4096 + 2048 + g * 128 + cc * 8); }
    for (int hh = 0; hh < 4; ++hh) {
        const int h = g * 4 + hh;
        __syncthreads();
#pragma unroll
        for (int c = 0; c < NCH; ++c) {
            const int t0 = (ch0 + c) * 128;
            const float af_last = ACUM[(size_t)(t0 + 127) * 64 + h], sb_first = ACUM[(size_t)t0 * 64 + 32 + h];
#pragma unroll
            for (int j = 0; j < 2; ++j) { const int q = tid + NT * j, row = q >> 3, cc = q & 7; const size_t tr = (size_t)(t0 + row);
                const float wf = __expf(af_last - ACUM[tr * 64 + h]) * DT[tr * 64 + h];
                const float wb = __expf(sb_first - ACUM[tr * 64 + 32 + h]) * DT[tr * 64 + 32 + h];
                float f[8], o[8]; unpack8(*(const u32x4*)(XBC + tr * 4096 + h * 64 + cc * 8), f);
#pragma unroll
                for (int i = 0; i < 8; ++i) o[i] = f[i] * wf;
                *(u32x4*)(Xs + ((c * 2 + 0) * 128 + row) * 72 + cc * 8) = pack8(o);
#pragma unroll
                for (int i = 0; i < 8; ++i) o[i] = f[i] * wb;
                *(u32x4*)(Xs + ((c * 2 + 1) * 128 + row) * 72 + cc * 8) = pack8(o); }
        }
        __syncthreads();
        const int dir = wid >> 2, nq = wid & 3;
        f32x4 acc[NCH][4][2];
#pragma unroll
        for (int c = 0; c < NCH; ++c)
#pragma unroll
            for (int a = 0; a < 4; ++a) { acc[c][a][0] = (f32x4){0.f, 0.f, 0.f, 0.f}; acc[c][a][1] = (f32x4){0.f, 0.f, 0.f, 0.f}; }
#pragma unroll
        for (int c = 0; c < NCH; ++c) {
            const bf16_t* Xd = Xs + (c * 2 + dir) * 128 * 72; const bf16_t* Bc = Bt + c * 128 * 136;
#pragma unroll
            for (int ks = 0; ks < 4; ++ks) {
                bf16x8 xa[4], bb[2];
#pragma unroll
                for (int a = 0; a < 4; ++a) xa[a] = frag_tr(Xd, 72, ks * 32, a * 16, lane);
#pragma unroll
                for (int b = 0; b < 2; ++b) bb[b] = frag_tr(Bc, 136, ks * 32, nq * 32 + b * 16, lane);
#pragma unroll
                for (int a = 0; a < 4; ++a)
#pragma unroll
                    for (int b = 0; b < 2; ++b) acc[c][a][b] = mfma16(bb[b], xa[a], acc[c][a][b]);
            }
        }
        if (NCH == 1) {
            bf16_t* dst = SB + ((size_t)((ch0 * 2 + dir) * 32 + h)) * 8192;
#pragma unroll
            for (int a = 0; a < 4; ++a)
#pragma unroll
                for (int b = 0; b < 2; ++b) { const int pp = a * 16 + (lane & 15), n = nq * 32 + b * 16 + (lane >> 4) * 4;
                    *(u32x2*)(dst + pp * 128 + n) = pack4(acc[0][a][b]); }
        } else {
            const int cfirst = dir ? 1 : 0, csecond = dir ? 0 : 1;
            const int t2 = (ch0 + csecond) * 128;
            const float dec = __expf(dir ? ACUM[(size_t)t2 * 64 + 32 + h] : ACUM[(size_t)(t2 + 127) * 64 + h]);
            bf16_t* dst = SB + ((size_t)(((ch0 + csecond) * 2 + dir) * 32 + h)) * 8192;
            float* fin = p.out + OUT_SSD + ((size_t)((seq * 2 + dir) * 32 + h)) * 8192;
#pragma unroll
            for (int a = 0; a < 4; ++a)
#pragma unroll
                for (int b = 0; b < 2; ++b) { const int pp = a * 16 + (lane & 15), n = nq * 32 + b * 16 + (lane >> 4) * 4;
                    const f32x4 s1 = acc[cfirst][a][b], s2 = acc[NCH - 1 - cfirst][a][b];
                    *(u32x2*)(dst + pp * 128 + n) = pack4(s1);
                    *(f32x4*)(fin + pp * 128 + n) = s1 * dec + s2; }
        }
    }
}
__device__ __forceinline__ void ssd_state_phase(const Params& p, const bf16_t* XBC, bf16_t* SB, char* smem) {
    int tid_ = threadIdx.x; asm volatile("" : "+v"(tid_));
    const int tid = tid_, lane = tid & 63, wid = tid >> 6;
    for (int item = blockIdx.x; item < 512; item += gridDim.x) {
        if (item < 256) { const int seq = item >> 3, g = item & 7; ssd_state_item<2>(p, XBC, SB, smem, seq * 2, g, seq, tid, lane, wid); }
        else { const int it = item - 256, ch = 64 + (it >> 3), g = it & 7; ssd_state_item<1>(p, XBC, SB, smem, ch, g, 0, tid, lane, wid); }
    }
}

__device__ __forceinline__ void ssd_scan_phase(const Params& p, bf16_t* SB) {
    const int tid = otid();
    const float* ACUM = (const float*)(p.ws + WS_ACUM);
    for (int item = blockIdx.x; item < 2 * 64 * 2; item += gridDim.x) {
        const int half = item & 1, it = item >> 1, seq = 32 + (it >> 6), d = (it >> 5) & 1, h = it & 31;
        const int ch0 = 64 + (seq - 32) * 16;
        const int e = (tid + NT * half) * 8;
        float st[8];
        const float* h0 = p.in[2] + ((size_t)(((seq - 32) * 2 + d) * 32 + h)) * 8192 + e; const f32x4 a = *(const f32x4*)h0, b = *(const f32x4*)(h0 + 4);
        st[0] = a[0]; st[1] = a[1]; st[2] = a[2]; st[3] = a[3]; st[4] = b[0]; st[5] = b[1]; st[6] = b[2]; st[7] = b[3];
        u32x4 rs[16]; float tot[16];
#pragma unroll
        for (int ci = 0; ci < 16; ++ci) { const int c = d ? 15 - ci : ci, ch = ch0 + c, t0 = ch * 128;
            rs[ci] = *(const u32x4*)(SB + ((size_t)((ch * 2 + d) * 32 + h)) * 8192 + e);
            tot[ci] = d ? ACUM[(size_t)t0 * 64 + 32 + h] : ACUM[(size_t)(t0 + 127) * 64 + h]; }
#pragma unroll
        for (int ci = 0; ci < 16; ++ci) { const int c = d ? 15 - ci : ci, ch = ch0 + c;
            float s[8]; unpack8(rs[ci], s);
            *(u32x4*)(SB + ((size_t)((ch * 2 + d) * 32 + h)) * 8192 + e) = pack8(st);
            const float dec = __expf(tot[ci]);
#pragma unroll
            for (int i = 0; i < 8; ++i) st[i] = dec * st[i] + s[i]; }
    }
}

template <bool DRY>
__device__ __forceinline__ void ssd_out_phase(const Params& p, const bf16_t* XBC, const bf16_t* SB, bf16_t* Uz, char* smem) {
    int tid_ = threadIdx.x; asm volatile("" : "+v"(tid_));
    const int tid = tid_, lane = tid & 63, wid = tid >> 6;
    const float* DT = (const float*)(p.ws + WS_DT);
    const float* ACUM = (const float*)(p.ws + WS_ACUM);
    float* SSQ = (float*)(p.ws + WS_SSQ);
    bf16_t* Ct = (bf16_t*)smem;
    bf16_t* R1 = Ct + 128 * 136;
    bf16_t* Mt = R1 + 128 * 136;
    bf16_t* Xt = Mt + 128 * 136;
    float* vec = (float*)(Xt + 128 * 72);
    for (int item = blockIdx.x; item < NCHUNK * 8; item += gridDim.x) {
        const int ch = item >> 3, g = item & 7, t0 = ch * 128;
        const bool hasF = !(ch < 64 && (ch & 1) == 0), hasB = !(ch < 64 && (ch & 1) == 1);
        __syncthreads();
#pragma unroll
        for (int j = 0; j < 4; ++j) { const int q = tid + NT * j, row = q >> 4, c = q & 15; const bf16_t* src = XBC + (size_t)(t0 + row) * 4096 + g * 128 + c * 8;
            *(u32x4*)(R1 + row * 136 + c * 8) = *(const u32x4*)(src + 2048);
            *(u32x4*)(Ct + row * 136 + c * 8) = *(const u32x4*)(src + 3072); }
#pragma unroll
        for (int j = 0; j < 4; ++j) { const int idx = tid + NT * j, kind = idx >> 9, hh = (idx >> 7) & 3, l = idx & 127; const int h = g * 4 + hh;
            const float* srcp = (kind < 2 ? ACUM : DT) + (size_t)(t0 + l) * 64 + (kind & 1) * 32 + h;
            vec[idx] = *srcp; }
        __syncthreads();
        f32x4 gacc[8];
#pragma unroll
        for (int st = 0; st < 8; ++st) gacc[st] = (f32x4){0.f, 0.f, 0.f, 0.f};
#pragma unroll
        for (int ks = 0; ks < 4; ++ks) {
            const bf16x8 cf = frag_rm(Ct, 136, 16 * wid, ks * 32, lane);
#pragma unroll
            for (int st = 0; st < 8; ++st) gacc[st] = mfma16(frag_rm(R1, 136, st * 16, ks * 32, lane), cf, gacc[st]);
        }
        const int l = 16 * wid + (lane & 15);
        for (int hh = 0; hh < 4; ++hh) {
            const int h = g * 4 + hh;
            const float* Af = vec + hh * 128; const float* Sb = vec + 512 + hh * 128; const float* dtf = vec + 1024 + hh * 128; const float* dtb = vec + 1536 + hh * 128;
            __syncthreads();
#pragma unroll
            for (int j = 0; j < 2; ++j) { const int q = tid + NT * j, row = q >> 3, c = q & 7;
                *(u32x4*)(Xt + row * 72 + c * 8) = *(const u32x4*)(XBC + (size_t)(t0 + row) * 4096 + h * 64 + c * 8); }
#pragma unroll
            for (int j = 0; j < 4; ++j) { const int q = tid + NT * j, dd = q >> 10, row = (q >> 4) & 63, c = q & 15;
                if (dd ? hasB : hasF) *(u32x4*)(R1 + (dd * 64 + row) * 136 + c * 8) = *(const u32x4*)(SB + ((size_t)((ch * 2 + dd) * 32 + h)) * 8192 + row * 128 + c * 8); }
            {
                const float afl = Af[l], sbl = Sb[l];
#pragma unroll
                for (int st = 0; st < 8; ++st) {
                    f32x4 m;
#pragma unroll
                    for (int r = 0; r < 4; ++r) { const int s = st * 16 + (lane >> 4) * 4 + r;
                        float wgt = 0.f;
                        if (s <= l) wgt += __expf(afl - Af[s]) * dtf[s];
                        if (s >= l) wgt += __expf(sbl - Sb[s]) * dtb[s];
                        m[r] = gacc[st][r] * wgt; }
                    *(u32x2*)(Mt + l * 136 + st * 16 + (lane >> 4) * 4) = pack4(m);
                }
            }
            __syncthreads();
            f32x4 ad[4], af[4], ab[4];
#pragma unroll
            for (int a = 0; a < 4; ++a) { ad[a] = (f32x4){0.f, 0.f, 0.f, 0.f}; af[a] = ad[a]; ab[a] = ad[a]; }
#pragma unroll
            for (int ks = 0; ks < 4; ++ks) {
                const bf16x8 mf = frag_rm(Mt, 136, 16 * wid, ks * 32, lane);
                const bf16x8 cf = frag_rm(Ct, 136, 16 * wid, ks * 32, lane);
#pragma unroll
                for (int a = 0; a < 4; ++a) {
                    ad[a] = mfma16(frag_tr(Xt, 72, ks * 32, a * 16, lane), mf, ad[a]);
                    if (hasF) af[a] = mfma16(frag_rm(R1, 136, a * 16, ks * 32, lane), cf, af[a]);
                    if (hasB) ab[a] = mfma16(frag_rm(R1 + 64 * 136, 136, a * 16, ks * 32, lane), cf, ab[a]);
                }
            }
            const float ef = __expf(Af[l]), eb = __expf(Sb[l]), Dh = p.in[18][h];
            const size_t t = (size_t)(t0 + l);
            float ssq = 0.f;
#pragma unroll
            for (int a = 0; a < 4; ++a) {
                const int pp = a * 16 + (lane >> 4) * 4, col = h * 64 + pp;
                const f32x4 x = unpack4(*(const u32x2*)(Xt + l * 72 + pp));
                const f32x4 sz = unpack4(*(const u32x2*)(Uz + t * 2048 + col));
                const f32x4 ng = *(const f32x4*)(p.in[19] + col);
                f32x4 y = (ad[a] + af[a] * ef + ab[a] * eb + x * Dh) * sz;
                ssq += y[0] * y[0] + y[1] * y[1] + y[2] * y[2] + y[3] * y[3];
                if (!DRY) *(u32x2*)(Uz + t * 2048 + col) = pack4(y * ng); else asm volatile("" :: "v"(y[0] * ng[0]), "v"(y[1]), "v"(y[2]), "v"(y[3]));
            }
            ssq += __shfl_xor(ssq, 16); ssq += __shfl_xor(ssq, 32);
            if (!DRY) { if (lane < 16) SSQ[t * 32 + h] = ssq; } else asm volatile("" :: "v"(ssq));
        }
    }
}


__device__ __forceinline__ void mlp_stats_phase(const Params& p, const bf16_t* U) {
    const int tid = otid(), lane = tid & 63, gw = blockIdx.x * 8 + (tid >> 6), nw = gridDim.x * 8;
    float* STATS = (float*)(p.ws + WS_STATS);
    for (int tb = gw; tb < TOK; tb += 3 * nw) {
        u32x4 raw[3][4];
#pragma unroll
        for (int r = 0; r < 3; ++r) { const int t = tb + r * nw;
            if (t < TOK) {
#pragma unroll
                for (int j = 0; j < 4; ++j) raw[r][j] = *(const u32x4*)(U + (size_t)t * 6144 + 2048 + j * 512 + lane * 8); } }
#pragma unroll
        for (int r = 0; r < 3; ++r) { const int t = tb + r * nw;
            if (t < TOK) {
                float f[32]; float s = 0.f;
#pragma unroll
                for (int j = 0; j < 4; ++j) unpack8(raw[r][j], f + j * 8);
#pragma unroll
                for (int i = 0; i < 32; ++i) s += f[i];
                s = wave_sum(s);
                const float mean = s * (1.f / 2048.f);
                float q = 0.f;
#pragma unroll
                for (int i = 0; i < 32; ++i) { const float dd = f[i] - mean; q += dd * dd; }
                q = wave_sum(q);
                if (lane == 0) { STATS[(size_t)t * 2] = mean; STATS[(size_t)t * 2 + 1] = rsqrtf(q * (1.f / 2048.f) + EPSN); }
            } }
    }
}
template <bool DRY>
__device__ __forceinline__ void mlp_mix_phase(const Params& p, bf16_t* U, char* smem) {
    int tid_ = threadIdx.x; asm volatile("" : "+v"(tid_));
    const int tid = tid_, lane = tid & 63, wid = tid >> 6;
    const float* STATS = (const float*)(p.ws + WS_STATS);
    bf16_t* Wt = (bf16_t*)smem;
    bf16_t* Vt = Wt + 128 * 136;
    const int nitems = NCHUNK * 16;
    int gcur = -1;
    u32x4 vraw[4]; f32x2 vst[4];
    auto prefetch = [&](int item) {
        const int ch = item >> 4, ct = item & 15, c0 = ct * 128, t0 = ch * 128;
#pragma unroll
        for (int jj = 0; jj < 4; ++jj) { const int q = tid + NT * jj, j = q >> 4, c = q & 15; const size_t t = (size_t)(t0 + j);
            vraw[jj] = *(const u32x4*)(U + t * 6144 + 2048 + c0 + c * 8); vst[jj] = *(const f32x2*)(STATS + t * 2); }
    };
    if ((int)blockIdx.x < nitems) prefetch(blockIdx.x);
    for (int item = blockIdx.x; item < nitems; item += gridDim.x) {
        const int ch = item >> 4, ct = item & 15, g = ct >> 1, c0 = ct * 128, t0 = ch * 128;
        __syncthreads();
        if (g != gcur) {
#pragma unroll
            for (int jj = 0; jj < 8; ++jj) { const int q = tid + NT * jj, i = q >> 5, j4 = q & 31;
                const f32x4 w = *(const f32x4*)(p.in[23] + ((size_t)(g * 128 + i)) * 128 + j4 * 4);
                *(u32x2*)(Wt + i * 136 + j4 * 4) = pack4(w); }
            gcur = g;
        }
#pragma unroll
        for (int jj = 0; jj < 4; ++jj) { const int q = tid + NT * jj, j = q >> 4, c = q & 15;
            const float mean = vst[jj][0], rstd = vst[jj][1];
            float f[8]; unpack8(vraw[jj], f);
            const f32x4 g0 = *(const f32x4*)(p.in[21] + c0 + c * 8), g1 = *(const f32x4*)(p.in[21] + c0 + c * 8 + 4);
            const f32x4 b0 = *(const f32x4*)(p.in[22] + c0 + c * 8), b1 = *(const f32x4*)(p.in[22] + c0 + c * 8 + 4);
#pragma unroll
            for (int i = 0; i < 4; ++i) { f[i] = (f[i] - mean) * rstd * g0[i] + b0[i]; f[4 + i] = (f[4 + i] - mean) * rstd * g1[i] + b1[i]; }
            *(u32x4*)(Vt + j * 136 + c * 8) = pack8(f); }
        __syncthreads();
        if (item + (int)gridDim.x < nitems) prefetch(item + gridDim.x);
        const int i = 16 * wid + (lane & 15); const size_t t = (size_t)(t0 + i);
        u32x2 gur[8], szr[8];
#pragma unroll
        for (int a = 0; a < 8; ++a) { const int col = c0 + a * 16 + (lane >> 4) * 4; gur[a] = *(const u32x2*)(U + t * 6144 + col); szr[a] = *(const u32x2*)(U + t * 6144 + 4096 + col); }
        const float bs = p.in[24][g * 128 + i];
        f32x4 acc[8];
#pragma unroll
        for (int a = 0; a < 8; ++a) acc[a] = (f32x4){0.f, 0.f, 0.f, 0.f};
#pragma unroll
        for (int ks = 0; ks < 4; ++ks) {
            const bf16x8 wf = frag_rm(Wt, 136, 16 * wid, ks * 32, lane);
#pragma unroll
            for (int a = 0; a < 8; ++a) acc[a] = mfma16(frag_tr(Vt, 136, ks * 32, a * 16, lane), wf, acc[a]);
        }
#pragma unroll
        for (int a = 0; a < 8; ++a) {
            const int col = c0 + a * 16 + (lane >> 4) * 4;
            const f32x4 o = unpack4(gur[a]) * (acc[a] + bs) * unpack4(szr[a]);
            if (!DRY) *(u32x2*)(U + t * 6144 + col) = pack4(o); else asm volatile("" :: "v"(o[0]), "v"(o[1]), "v"(o[2]), "v"(o[3]));
        }
    }
}

__device__ __forceinline__ void s5_scan_phase(const Params& p, const bf16_t* Uu, bf16_t* Ydir, char* smem) {
    int tid_ = threadIdx.x; asm volatile("" : "+v"(tid_));
    const int tid = tid_, lane = tid & 63, wid = tid >> 6;
    bf16_t* Ktab = (bf16_t*)smem;
    bf16_t* Qtab = (bf16_t*)(smem + 4608);
    bf16_t* Ptab = (bf16_t*)(smem + 37376);
    char* wbase = smem + 72192;
    float* qbuf = (float*)(wbase + wid * 8448);
    bf16_t* Sbuf = (bf16_t*)(wbase + wid * 8448);
    f32x2* t_pow = (f32x2*)wbase;
    f32x2* t_coef = t_pow + 9 * 64;
    f32x2* t_bb = t_coef + 64;
    f32x2* t_c = t_bb + 1024;
    for (int combo = blockIdx.x; combo < 256; combo += gridDim.x) {
        const int cx = combo & 7, cy = combo >> 3, d = cy >> 4, g = cx * 16 + (cy & 15), dg = d * 128 + g;
        __syncthreads();
        if (tid < 64) {
            const float step = __expf(p.in[28][dg]);
            const float lr = p.in[26][dg * 64 + tid], li = p.in[27][dg * 64 + tid];
            const float mag = __expf(lr * step), ang = li * step;
            const float kk = rintf(ang * 0.15915494309189535f);
            float rr = fmaf(-kk, 6.2831854820251465f, ang); rr = fmaf(-kk, -1.7484555e-7f, rr);
            const float ar = mag * __cosf(rr), ai = mag * __sinf(rr);
            const float den = lr * lr + li * li, nr = ar - 1.f;
            t_coef[tid] = (f32x2){(nr * lr + ai * li) / den, (ai * lr - nr * li) / den};
            float pr = 1.f, pi = 0.f;
#pragma unroll
            for (int t = 0; t < 9; ++t) { t_pow[t * 64 + tid] = (f32x2){pr, pi}; const float a = pr * ar - pi * ai, b = pr * ai + pi * ar; pr = a; pi = b; }
        }
#pragma unroll
        for (int i = 0; i < 2; ++i) { const int q = tid + NT * i, j = q >> 6, n = q & 63; const size_t o = ((size_t)(dg * 16 + j)) * 64 + n; t_c[q] = (f32x2){p.in[31][o], p.in[32][o]}; }
        __syncthreads();
#pragma unroll
        for (int i = 0; i < 2; ++i) { const int q = tid + NT * i, n = q >> 4; const size_t o = ((size_t)(dg * 64 + n)) * 16 + (q & 15);
            const float br = p.in[29][o], bi = p.in[30][o]; const f32x2 cf = t_coef[n]; t_bb[q] = (f32x2){cf[0] * br - cf[1] * bi, cf[0] * bi + cf[1] * br}; }
        __syncthreads();
#pragma unroll 4
        for (int i = 0; i < 16; ++i) { const int q = tid + NT * i, t = q >> 10, n = (q >> 4) & 63, ch = q & 15;
            const f32x2 pw = t_pow[(7 - t) * 64 + n], bb = t_bb[n * 16 + ch];
            Qtab[(t * 128 + 2 * n) * 16 + ch] = (bf16_t)f2bf(pw[0] * bb[0] - pw[1] * bb[1]);
            Qtab[(t * 128 + 2 * n + 1) * 16 + ch] = (bf16_t)f2bf(pw[0] * bb[1] + pw[1] * bb[0]); }
#pragma unroll 4
        for (int i = 0; i < 16; ++i) { const int q = tid + NT * i, t = q >> 10, j = (q >> 6) & 15, n = q & 63;
            const f32x2 c = t_c[j * 64 + n], pw = t_pow[(t + 1) * 64 + n];
            *(unsigned*)(Ptab + (t * 16 + j) * 136 + 2 * n) = pack2(c[0] * pw[0] - c[1] * pw[1], -(c[0] * pw[1] + c[1] * pw[0])); }
        {
            const int tau = tid >> 6, j = (tid >> 2) & 15, c4 = tid & 3;
            f32x4 a = (f32x4){0.f, 0.f, 0.f, 0.f};
            for (int n = 0; n < 64; ++n) { const f32x2 c = t_c[j * 64 + n], pw = t_pow[tau * 64 + n];
                const float cpr = c[0] * pw[0] - c[1] * pw[1], cpi = c[0] * pw[1] + c[1] * pw[0];
#pragma unroll
                for (int e2 = 0; e2 < 4; ++e2) { const f32x2 bb = t_bb[n * 16 + 4 * c4 + e2]; a[e2] += cpr * bb[0] - cpi * bb[1]; } }
            *(u32x2*)(Ktab + (tau * 16 + j) * 16 + 4 * c4) = pack4(a);
            if (tid < 64) *(u32x2*)(Ktab + 8 * 256 + tid * 4) = (u32x2){0u, 0u};
        }
        const f32x2 a8 = t_pow[8 * 64 + lane];
        __syncthreads();
        const int slot = wid;
        const int ntl = slot < 2 ? 16 : 2 * ((32 - (slot - 2) + 5) / 6);
        const int cl = lane & 15, ch0 = 8 * ((lane >> 4) & 1), th = lane >> 5;
        const bf16_t* qf0 = Qtab + ((th * 128 + cl) * 16 + ch0);
        const bf16_t* pf0 = Ptab + cl * 136 + 8 * (lane >> 4);
        u32x4 ucur[4], unext[4], unn[4];
        {
            const int seq = slot < 2 ? 32 + slot : (slot - 2);
            const int L = seq < 32 ? 256 : 2048, tb = seq < 32 ? seq * 256 : TOKC + (seq - 32) * 2048;
#pragma unroll
            for (int ks = 0; ks < 4; ++ks) { const int m = cl * 8 + 2 * ks + th, tok = d ? tb + L - 1 - m : tb + m; ucur[ks] = *(const u32x4*)(Uu + (size_t)tok * 2048 + g * 16 + ch0); }
#pragma unroll
            for (int ks = 0; ks < 4; ++ks) { const int m = 128 + cl * 8 + 2 * ks + th, tok = d ? tb + L - 1 - m : tb + m; unext[ks] = *(const u32x4*)(Uu + (size_t)tok * 2048 + g * 16 + ch0); }
#pragma unroll
            for (int ks = 0; ks < 4; ++ks) unn[ks] = unext[ks];
        }
        float sr = 0.f, sim = 0.f;
        for (int k = 0; k < ntl; ++k) {
            const int si = slot < 2 ? 0 : (k >> 1), ti = slot < 2 ? k : (k & 1);
            const int seq = slot < 2 ? 32 + slot : (slot - 2) + 6 * si;
            const int L = seq < 32 ? 256 : 2048, tb = seq < 32 ? seq * 256 : TOKC + (seq - 32) * 2048, ntiles = L >> 7;
            if (ti == 0) {
                sr = 0.f; sim = 0.f;
                if (seq >= 32) { const float* h0 = p.in[3] + ((size_t)(((seq - 32) * 2 + d) * 2) * 128 + g) * 64 + lane; sr = h0[0]; sim = h0[128 * 64]; }
            }
            bf16x8 uf[4];
#pragma unroll
            for (int ks = 0; ks < 4; ++ks) uf[ks] = as_frag(ucur[ks]);
            {
                f32x4 qa[8];
#pragma unroll
                for (int nt = 0; nt < 8; ++nt) qa[nt] = (f32x4){0.f, 0.f, 0.f, 0.f};
#pragma unroll
                for (int ks = 0; ks < 4; ++ks) {
                    bf16x8 fr[8];
#pragma unroll
                    for (int nt = 0; nt < 8; ++nt) fr[nt] = *(const bf16x8*)(qf0 + (2 * ks * 128 + nt * 16) * 16);
                    __builtin_amdgcn_sched_barrier(0);
#pragma unroll
                    for (int nt = 0; nt < 8; ++nt) qa[nt] = mfma16(fr[nt], uf[ks], qa[nt]);
                    __builtin_amdgcn_sched_barrier(0);
                }
#pragma unroll
                for (int nt = 0; nt < 8; ++nt) *(f32x4*)(qbuf + cl * 132 + nt * 16 + (lane >> 4) * 4) = qa[nt];
            }
            if (k + 2 < ntl) {
                const int k2 = k + 2, si2 = slot < 2 ? 0 : (k2 >> 1), ti2 = slot < 2 ? k2 : (k2 & 1);
                const int seq2 = slot < 2 ? 32 + slot : (slot - 2) + 6 * si2;
                const int L2 = seq2 < 32 ? 256 : 2048, tb2 = seq2 < 32 ? seq2 * 256 : TOKC + (seq2 - 32) * 2048;
#pragma unroll
                for (int ks = 0; ks < 4; ++ks) { const int m = ti2 * 128 + cl * 8 + 2 * ks + th, tok = d ? tb2 + L2 - 1 - m : tb2 + m; unn[ks] = *(const u32x4*)(Uu + (size_t)tok * 2048 + g * 16 + ch0); }
            }
            WAVE_LDS_SYNC();
            f32x2 dq[16];
#pragma unroll
            for (int c = 0; c < 16; ++c) dq[c] = *(const f32x2*)(qbuf + c * 132 + 2 * lane);
            unsigned sw[16];
#pragma unroll
            for (int c = 0; c < 16; ++c) { sw[c] = pack2(sr, sim);
                const float nr2 = a8[0] * sr - a8[1] * sim + dq[c][0], ni2 = a8[0] * sim + a8[1] * sr + dq[c][1]; sr = nr2; sim = ni2; }
            WAVE_LDS_SYNC();
#pragma unroll
            for (int c = 0; c < 16; ++c) *(unsigned*)(Sbuf + c * 136 + 2 * lane) = sw[c];
            WAVE_LDS_SYNC();
            bf16x8 sf[4];
#pragma unroll
            for (int ks = 0; ks < 4; ++ks) sf[ks] = frag_rm(Sbuf, 136, 0, ks * 32, lane);
            {
                f32x4 ya[8];
#pragma unroll
                for (int tp = 0; tp < 8; ++tp) ya[tp] = (f32x4){0.f, 0.f, 0.f, 0.f};
#pragma unroll
                for (int ks = 0; ks < 4; ++ks) {
                    bf16x8 pfr[8], kfr[8];
#pragma unroll
                    for (int tp = 0; tp < 8; ++tp) pfr[tp] = *(const bf16x8*)(pf0 + tp * 16 * 136 + ks * 32);
#pragma unroll
                    for (int tp = 0; tp < 8; ++tp) if (2 * ks <= tp) { const int tau = tp - 2 * ks - th, taui = tau < 0 ? 8 : tau; kfr[tp] = *(const bf16x8*)(Ktab + (taui * 16 + cl) * 16 + ch0); }
                    __builtin_amdgcn_sched_barrier(0);
#pragma unroll
                    for (int tp = 0; tp < 8; ++tp) ya[tp] = mfma16(pfr[tp], sf[ks], ya[tp]);
#pragma unroll
                    for (int tp = 0; tp < 8; ++tp) if (2 * ks <= tp) ya[tp] = mfma16(kfr[tp], uf[ks], ya[tp]);
                    __builtin_amdgcn_sched_barrier(0);
                }
#pragma unroll
                for (int tp = 0; tp < 8; ++tp) {
                    const int m = ti * 128 + cl * 8 + tp, tok = d ? tb + L - 1 - m : tb + m;
                    *(u32x2*)(Ydir + ((size_t)d * TOK + tok) * 2048 + g * 16 + (lane >> 4) * 4) = pack4(ya[tp]);
                }
            }
            WAVE_LDS_SYNC();
            if (ti + 1 == ntiles && seq < 32) { float* o = p.out + OUT_S5 + ((size_t)((seq * 2 + d) * 2) * 128 + g) * 64 + lane; o[0] = sr; o[128 * 64] = sim; }
#pragma unroll
            for (int ks = 0; ks < 4; ++ks) { ucur[ks] = unext[ks]; unext[ks] = unn[ks]; }
        }
    }
}
__device__ __forceinline__ void s5_post_phase(const Params& p, const bf16_t* Uu, bf16_t* Ydir) {
    const size_t nvec = (size_t)TOK * 2048 / 8, stride = (size_t)gridDim.x * NT;
    const int tid = otid();
    for (size_t v0 = (size_t)blockIdx.x * NT + tid; v0 < nvec; v0 += 4 * stride) {
        u32x4 ra[4], rb[4], ru[4];
#pragma unroll
        for (int q = 0; q < 4; ++q) { const size_t v = v0 + q * stride;
            if (v < nvec) { ra[q] = *(const u32x4*)(Ydir + v * 8); rb[q] = *(const u32x4*)(Ydir + (size_t)TOK * 2048 + v * 8); ru[q] = *(const u32x4*)(Uu + v * 8); } }
#pragma unroll
        for (int q = 0; q < 4; ++q) { const size_t v = v0 + q * stride;
            if (v < nvec) {
                const int col = (int)((v * 8) & 2047);
                float a[8], b[8], u[8];
                unpack8(ra[q], a); unpack8(rb[q], b); unpack8(ru[q], u);
                const f32x4 d0 = *(const f32x4*)(p.in[33] + col), d1 = *(const f32x4*)(p.in[33] + col + 4);
#pragma unroll
                for (int i = 0; i < 4; ++i) { a[i] = geluf(a[i] + b[i] + d0[i] * u[i]); a[4 + i] = geluf(a[4 + i] + b[4 + i] + d1[i] * u[4 + i]); }
                *(u32x4*)(Ydir + v * 8) = pack8(a);
            } }
    }
}

__device__ __forceinline__ void glds16_asm(const void* gsrc, unsigned lds_dst) {
    unsigned keep;
    asm volatile("s_mov_b32 %0, m0\n\ts_mov_b32 m0, %2\n\ts_nop 0\n\tglobal_load_lds_dwordx4 %1, off\n\ts_mov_b32 m0, %0" : "=&s"(keep) : "v"(gsrc), "s"(lds_dst) : "memory");
}
struct AttnState { float m; f32x4 o[5]; };
__device__ __forceinline__ float xmax16_32(float v) {
    u32x2 r = __builtin_amdgcn_permlane32_swap(__float_as_uint(v), __float_as_uint(v), false, false);
    v = fmaxf(__uint_as_float(r[0]), __uint_as_float(r[1]));
    r = __builtin_amdgcn_permlane16_swap(__float_as_uint(v), __float_as_uint(v), false, false);
    return fmaxf(__uint_as_float(r[0]), __uint_as_float(r[1]));
}
template <int NKT, bool WIN>
__device__ __forceinline__ void attend(AttnState& st, const bf16x8 (&qf)[2], const bf16_t* Kt, const bf16_t* Vt, int krow0,
                                       bf16_t* Pbuf, int lane, const float* rpbh, int qc, int kcol0, int idxr0) {
    constexpr int KSTR = WIN ? 64 : 32;
    f32x4 s[NKT];
    {
        const int row = krow0 + (lane & 15), ksw = (row >> 1) & 7;
        const bf16_t* k0p = Kt + row * 64 + ((((lane >> 4)) ^ ksw) << 3);
        const bf16_t* k1p = Kt + row * 64 + (((4 + (lane >> 4)) ^ ksw) << 3);
        bf16x8 kf[NKT];
#pragma unroll
        for (int kt = 0; kt < NKT; ++kt) kf[kt] = *(const bf16x8*)(k0p + ((kt >> 1) * KSTR + (kt & 1) * 16) * 64);
#pragma unroll
        for (int kt = 0; kt < NKT; ++kt) s[kt] = mfma16(kf[kt], qf[0], (f32x4){0.f, 0.f, 0.f, 0.f});
#pragma unroll
        for (int kt = 0; kt < NKT; ++kt) kf[kt] = *(const bf16x8*)(k1p + ((kt >> 1) * KSTR + (kt & 1) * 16) * 64);
#pragma unroll
        for (int kt = 0; kt < NKT; ++kt) s[kt] = mfma16(kf[kt], qf[1], s[kt]);
    }
    if (WIN) {
        const int cs = min(max(qc - 8, 0), 48);
#pragma unroll
        for (int kt = 0; kt < NKT; ++kt) {
            const int ir = idxr0 + (kt >> 1);
#pragma unroll
            for (int r = 0; r < 4; ++r) { const int kc = kcol0 + (kt & 1) * 16 + (lane >> 4) * 4 + r;
                const bool ok = (kc >= cs) && (kc < cs + 16);
                const int ic = min(max(kc - qc + 15, 0), 30);
                s[kt][r] = ok ? s[kt][r] + rpbh[ir * 31 + ic] : -1e30f; }
        }
    }
    float mx = st.m;
#pragma unroll
    for (int kt = 0; kt < NKT; ++kt) mx = fmaxf(mx, fmaxf(fmaxf(s[kt][0], s[kt][1]), fmaxf(s[kt][2], s[kt][3])));
    mx = xmax16_32(mx);
    const float alpha = __builtin_amdgcn_exp2f(st.m - mx);
    st.m = mx;
#pragma unroll
    for (int a = 0; a < 5; ++a) st.o[a] = st.o[a] * alpha;
    const int vrow = krow0 + 4 * (lane >> 4) + ((lane >> 2) & 3);
    const int vs0 = (vrow >> 1) & 7, c1 = (lane & 3) >> 1, cin = 4 * (lane & 1);
    const bf16_t* vb0 = Vt + vrow * 64 + cin;
    const bf16_t* vb1 = Vt + (vrow + 16) * 64 + cin;
    bf16x8 ones;
#pragma unroll
    for (int i = 0; i < 8; ++i) ones[i] = (short)0x3F80;
#pragma unroll
    for (int kk = 0; kk < NKT / 2; ++kk) {
        s16x4 lo[4], hi[4];
#pragma unroll
        for (int a = 0; a < 4; ++a) {
            lo[a] = __builtin_amdgcn_ds_read_tr16_b64_v4i16((LAS s16x4*)(vb0 + kk * KSTR * 64 + (((2 * a + c1) ^ vs0) << 3)));
            hi[a] = __builtin_amdgcn_ds_read_tr16_b64_v4i16((LAS s16x4*)(vb1 + kk * KSTR * 64 + (((2 * a + c1) ^ vs0) << 3))); }
        u32x4 pu;
        { const f32x4 t0 = s[2 * kk] - mx, t1 = s[2 * kk + 1] - mx;
          pu.x = pack2(__builtin_amdgcn_exp2f(t0[0]), __builtin_amdgcn_exp2f(t0[1])); pu.y = pack2(__builtin_amdgcn_exp2f(t0[2]), __builtin_amdgcn_exp2f(t0[3]));
          pu.z = pack2(__builtin_amdgcn_exp2f(t1[0]), __builtin_amdgcn_exp2f(t1[1])); pu.w = pack2(__builtin_amdgcn_exp2f(t1[2]), __builtin_amdgcn_exp2f(t1[3])); }
        const bf16x8 pf = as_frag(pu);
#pragma unroll
        for (int a = 0; a < 4; ++a) {
            bf16x8 vf; vf[0] = lo[a][0]; vf[1] = lo[a][1]; vf[2] = lo[a][2]; vf[3] = lo[a][3]; vf[4] = hi[a][0]; vf[5] = hi[a][1]; vf[6] = hi[a][2]; vf[7] = hi[a][3];
            st.o[a] = mfma16(vf, pf, st.o[a]);
        }
        st.o[4] = mfma16(ones, pf, st.o[4]);
    }
}

struct AttnBufs { bf16_t* Q; const bf16_t* Z; const bf16_t* Kl; const bf16_t* Vl; const bf16_t* Kc; const bf16_t* Vc0; const bf16_t* Vc1; const bf16_t* CKb; const bf16_t* CVb; };

template <bool DRY>
__device__ __forceinline__ void attn_phase(const Params& p, const AttnBufs& ab, char* smem) {
    int tid_ = threadIdx.x; asm volatile("" : "+v"(tid_));
    const int tid = tid_, lane = tid & 63, wid = __builtin_amdgcn_readfirstlane(tid >> 6);
    bf16_t* Pbuf = (bf16_t*)(smem + 131072) + wid * 640;
    float* rpbs = (float*)(smem + 141312);
    float* mrg = (float*)(smem + 143360);
    const int G = gridDim.x, bid = blockIdx.x;
    const int nctx = (1024 - bid + G - 1) / G, nlat = (2048 - bid + G - 1) / G;
    const int nst = nctx + 3 * nlat;
    const bool xmapl = (G == 256);
#define LAT_ITEM(li) (xmapl ? ((((bid & 7) * 8 + (li)) << 5) | (bid >> 3)) : (bid + (li) * G))
#define ATTN_DMA(sidx, bufp) do { \
        const int s_ = (sidx); const bf16_t* kb_; const bf16_t* vb_; int str_; \
        if (s_ < nctx) { const int it_ = bid + s_ * G, b_ = it_ >> 5, h_ = it_ & 31; kb_ = ab.Kc + (size_t)(b_ * 256) * 2048 + h_ * 64; \
            vb_ = (b_ < 20 ? ab.Vc0 + (size_t)(b_ * 256) * 2048 : ab.Vc1 + (size_t)((b_ - 20) * 256) * 2048) + h_ * 64; str_ = 2048; } \
        else { const int q_ = s_ - nctx, li_ = q_ / 3, sub_ = q_ - 3 * li_, it_ = LAT_ITEM(li_), b_ = it_ >> 10, h_ = (it_ >> 5) & 31, r_ = it_ & 31, rs_ = min(max(r_ - 4, 0), 24); \
            if (sub_ < 2) { const size_t o_ = (size_t)(b_ * 2048 + (rs_ + 4 * sub_) * 64) * 2048 + h_ * 64; kb_ = ab.Kl + o_; vb_ = ab.Vl + o_; str_ = 2048; } \
            else { const size_t o_ = (size_t)((b_ * 32 + h_) * 256) * 64; kb_ = ab.CKb + o_; vb_ = ab.CVb + o_; str_ = 64; } } \
        _Pragma("unroll") for (int i_ = 0; i_ < 8; ++i_) { const int id_ = wid * 8 + i_, row_ = 8 * (id_ & 31) + (lane >> 3), ch_ = (lane & 7) ^ ((row_ >> 1) & 7); \
            const bf16_t* g_ = (id_ < 32 ? kb_ : vb_) + (size_t)row_ * str_ + ch_ * 8; \
            glds16_asm(g_, __builtin_amdgcn_readfirstlane((unsigned)(uintptr_t)(LAS char*)(bufp)) + (unsigned)((id_ < 32 ? 0 : 32768) + (id_ & 31) * 1024)); } \
    } while (0)
    bf16x8 qf[2][2]; u32x2 zr[2][4]; float rpbreg = 0.f;
#define ATTN_PROLOGUE(sidx) do { const int s_ = (sidx); \
        if (s_ < nctx) { const int it_ = bid + s_ * G, b_ = it_ >> 5, h_ = it_ & 31; \
            _Pragma("unroll") for (int qi_ = 0; qi_ < 2; ++qi_) { const size_t tq_ = (size_t)(b_ * 256 + (wid * 2 + qi_) * 16 + (lane & 15)); \
                qf[qi_][0] = *(const bf16x8*)(ab.Q + tq_ * 2048 + h_ * 64 + 8 * (lane >> 4)); qf[qi_][1] = *(const bf16x8*)(ab.Q + tq_ * 2048 + h_ * 64 + 32 + 8 * (lane >> 4)); \
                _Pragma("unroll") for (int a_ = 0; a_ < 4; ++a_) zr[qi_][a_] = *(const u32x2*)(ab.Z + tq_ * 2048 + h_ * 64 + a_ * 16 + (lane >> 4) * 4); } } \
        else { const int q_ = s_ - nctx, li_ = q_ / 3, it_ = LAT_ITEM(li_), b_ = it_ >> 10, h_ = (it_ >> 5) & 31, r_ = it_ & 31; \
            const size_t tq_ = (size_t)(TOKC + b_ * 2048 + r_ * 64 + 16 * (wid & 3) + (lane & 15)); \
            qf[0][0] = *(const bf16x8*)(ab.Q + tq_ * 2048 + h_ * 64 + 8 * (lane >> 4)); qf[0][1] = *(const bf16x8*)(ab.Q + tq_ * 2048 + h_ * 64 + 32 + 8 * (lane >> 4)); \
            _Pragma("unroll") for (int a_ = 0; a_ < 4; ++a_) zr[0][a_] = *(const u32x2*)(ab.Z + tq_ * 2048 + h_ * 64 + a_ * 16 + (lane >> 4) * 4); \
            if (tid < 465) rpbreg = p.in[37][h_ * 465 + tid]; } \
    } while (0)
    __syncthreads();
    if (nst > 0) { ATTN_DMA(0, smem); ATTN_PROLOGUE(0); }
    __builtin_amdgcn_s_waitcnt(0x0F70);
    asm volatile("s_waitcnt vmcnt(0)" ::: "memory");
    __syncthreads();
    AttnState st; st.m = -1e30f;
#pragma unroll
    for (int a = 0; a < 5; ++a) st.o[a] = (f32x4){0.f, 0.f, 0.f, 0.f};
    for (int s = 0; s < nst; ++s) {
        char* buf = smem + (s & 1) * 65536;
        const bf16_t* Kt = (const bf16_t*)buf; const bf16_t* Vt = (const bf16_t*)(buf + 32768);
        const bool isctx = s < nctx;
        const int q3 = isctx ? 0 : s - nctx, li = q3 / 3, sub = q3 - 3 * li;
        if (!isctx && sub == 0) { if (tid < 465) rpbs[tid] = rpbreg * 1.4426950408889634f; __syncthreads(); }
        if (s + 1 < nst && !(DRY && (PROBE & 64))) ATTN_DMA(s + 1, smem + ((s + 1) & 1) * 65536);
        if (isctx) {
            const int it = bid + s * G, b = it >> 5, h = it & 31;
#pragma unroll
            for (int qi = 0; qi < 2; ++qi) {
                st.m = -1e30f;
#pragma unroll
                for (int a = 0; a < 5; ++a) st.o[a] = (f32x4){0.f, 0.f, 0.f, 0.f};
                if (!(DRY && (PROBE & 128))) { attend<8, false>(st, qf[qi], Kt, Vt, 0, Pbuf, lane, nullptr, 0, 0, 0);
                attend<8, false>(st, qf[qi], Kt, Vt, 128, Pbuf, lane, nullptr, 0, 0, 0); }
                const float inv = fast_rcp(st.o[4][0]);
                const size_t tq = (size_t)(b * 256 + (wid * 2 + qi) * 16 + (lane & 15));
#pragma unroll
                for (int a = 0; a < 4; ++a) { const u32x2 o = pack4(st.o[a] * inv * unpack4(zr[qi][a])); if (!DRY) *(u32x2*)(ab.Q + tq * 2048 + h * 64 + a * 16 + (lane >> 4) * 4) = o; else asm volatile("" :: "v"(o.x), "v"(o.y)); }
            }
        } else {
            const int it = LAT_ITEM(li), b = it >> 10, h = (it >> 5) & 31, r = it & 31, rs = min(max(r - 4, 0), 24);
            const int qt = wid & 3, hf = wid >> 2, qc = 16 * qt + (lane & 15);
            const int off = qt == 0 ? 0 : (qt == 1 ? 8 : (qt == 2 ? 24 : 32));
            if (sub == 0) { st.m = -1e30f;
#pragma unroll
                for (int a = 0; a < 5; ++a) st.o[a] = (f32x4){0.f, 0.f, 0.f, 0.f}; }
            if (sub < 2) {
                if (!(DRY && (PROBE & 128))) attend<4, true>(st, qf[0], Kt, Vt, hf * 128 + off, Pbuf, lane, rpbs, qc, off, rs + 4 * sub + 2 * hf - r + 7);
            } else {
                if (!(DRY && (PROBE & 128))) attend<8, false>(st, qf[0], Kt, Vt, hf * 128, Pbuf, lane, nullptr, 0, 0, 0);
                const float l = st.o[4][0];
                if (hf == 1) { float* mp = mrg + qt * 18 * 64 + lane; mp[0] = st.m; mp[64] = l;
#pragma unroll
                    for (int a = 0; a < 4; ++a)
#pragma unroll
                        for (int i = 0; i < 4; ++i) mp[(2 + a * 4 + i) * 64] = st.o[a][i]; }
                __syncthreads();
                if (hf == 0) { const float* mp = mrg + qt * 18 * 64 + lane; const float m2 = mp[0], l2 = mp[64];
                    const float mm = fmaxf(st.m, m2), e1 = __builtin_amdgcn_exp2f(st.m - mm), e2 = __builtin_amdgcn_exp2f(m2 - mm);
                    const float inv = fast_rcp(l * e1 + l2 * e2);
                    const size_t tq = (size_t)(TOKC + b * 2048 + r * 64 + qc);
#pragma unroll
                    for (int a = 0; a < 4; ++a) { f32x4 o2;
#pragma unroll
                        for (int i = 0; i < 4; ++i) o2[i] = mp[(2 + a * 4 + i) * 64];
                        { const u32x2 o = pack4((st.o[a] * e1 + o2 * e2) * inv * unpack4(zr[0][a])); if (!DRY) *(u32x2*)(ab.Q + tq * 2048 + h * 64 + a * 16 + (lane >> 4) * 4) = o; else asm volatile("" :: "v"(o.x), "v"(o.y)); } }
                }
            }
        }
        if (s + 1 < nst) { const int s1 = s + 1; const bool first = s1 < nctx || ((s1 - nctx) % 3) == 0; if (first) ATTN_PROLOGUE(s1); }
        __builtin_amdgcn_s_waitcnt(0x0F70);
        asm volatile("s_waitcnt vmcnt(0)" ::: "memory");
        __syncthreads();
    }
#undef ATTN_DMA
#undef LAT_ITEM
#undef ATTN_PROLOGUE
}

#define XB_TMO      128
#define XB_XCNT(j)  (256  + 64 * (j))
#define XB_XSUB(j)  (1280 + 64 * (j))
#define XB_XGEN(j)  (2304 + 64 * (j))
#define XB_TOP      3328
#define XB_TOPGEN   3392
#define XCD_BAR_WORDS 3456
#define XB_SPIN_CAP (1u << 22)
__device__ __forceinline__ unsigned xb_ld(unsigned* p)              { return __hip_atomic_load(p, __ATOMIC_RELAXED, __HIP_MEMORY_SCOPE_AGENT); }
__device__ __forceinline__ unsigned xb_add(unsigned* p, unsigned v) { return __hip_atomic_fetch_add(p, v, __ATOMIC_RELAXED, __HIP_MEMORY_SCOPE_AGENT); }
__device__ __forceinline__ unsigned xb_xcc_id() { return (unsigned)__builtin_amdgcn_s_getreg((3 << 11) | 20) & 0xFu; }
#define XB_SPIN(cond, bar) do { unsigned _sp = 0; while (cond) { __builtin_amdgcn_s_sleep(1); \
    if ((++_sp & 255u) == 0u) { if (xb_ld(&(bar)[XB_TMO])) break; if (_sp > XB_SPIN_CAP) { atomicAdd(&(bar)[XB_TMO], 1u); break; } } } } while (0)
struct XcdBarrier { unsigned* bar; unsigned x; volatile LAS unsigned* st; };
__device__ __forceinline__ XcdBarrier xcd_barrier_post(unsigned* bar, volatile LAS unsigned* st) {
    XcdBarrier b; b.bar = bar; b.x = xb_xcc_id(); b.st = st;
    if (threadIdx.x == 0) (void)xb_add(&bar[XB_XCNT(b.x)], 1u);
    return b;
}
__device__ __forceinline__ void xcd_barrier_complete(unsigned* bar, unsigned x, unsigned& nloc, unsigned& nx) {
    const unsigned G = gridDim.x * gridDim.y * gridDim.z;
    unsigned sum, cnt, mine, sp = 0u;
    for (;;) {
        sum = 0u; cnt = 0u; mine = 0u;
#pragma unroll
        for (unsigned j = 0; j < 16; ++j) { const unsigned c = xb_ld(&bar[XB_XCNT(j)]); sum += c; cnt += (c > 0u) ? 1u : 0u; mine = (j == x) ? c : mine; }
        if (sum == G) break;
        __builtin_amdgcn_s_sleep(1);
        if ((++sp & 255u) == 0u) { if (xb_ld(&bar[XB_TMO])) break; if (sp > XB_SPIN_CAP) { atomicAdd(&bar[XB_TMO], 1u); break; } }
    }
    nloc = mine > 0u ? mine : 1u; nx = cnt > 0u ? cnt : 1u;
}
__device__ __forceinline__ void xcd_barrier(const XcdBarrier& b) {
    asm volatile("s_waitcnt vmcnt(0)" ::: "memory");
    __syncthreads();
    if (threadIdx.x == 0) {
        unsigned* bar = b.bar;
        __builtin_amdgcn_s_waitcnt(0);
        unsigned nloc = b.st[0], nx = b.st[1];
        if (nloc == 0u) { xcd_barrier_complete(bar, b.x, nloc, nx); b.st[0] = nloc; b.st[1] = nx; }
        const unsigned old = xb_add(&bar[XB_XSUB(b.x)], 1u);
        const unsigned gen = old / nloc;
        if (old + 1u == (gen + 1u) * nloc) {
            __builtin_amdgcn_fence(__ATOMIC_RELEASE, "agent");
            asm volatile("s_waitcnt vmcnt(0)" ::: "memory");
            const unsigned og = xb_add(&bar[XB_TOP], 1u);
            const unsigned tg = og / nx;
            if (og + 1u == (tg + 1u) * nx) xb_add(&bar[XB_TOPGEN], 1u);
            else XB_SPIN(xb_ld(&bar[XB_TOPGEN]) == tg, bar);
            __builtin_amdgcn_fence(__ATOMIC_ACQUIRE, "agent");
            xb_add(&bar[XB_XGEN(b.x)], 1u);
            asm volatile("s_waitcnt vmcnt(0)" ::: "memory");
        } else {
            XB_SPIN(xb_ld(&bar[XB_XGEN(b.x)]) == gen, bar);
            __builtin_amdgcn_fence(__ATOMIC_ACQUIRE, "agent");
            asm volatile("s_waitcnt vmcnt(0)" ::: "memory");
        }
    }
    __syncthreads();
}

__global__ void __launch_bounds__(NT) fwd_megakernel(Params p) {
    extern __shared__ __attribute__((aligned(16))) char smem[];
    cg::grid_group grid = cg::this_grid();
    char* ws = p.ws;
    bf16_t* H = (bf16_t*)(ws + WS_H);
    float* MOD = (float*)(ws + WS_MOD);
    bf16_t* U = (bf16_t*)(ws + WS_U);
    bf16_t* SCR = (bf16_t*)(p.out + OUT_CK);
    const bf16_t* WtOut = (const bf16_t*)(ws + WS_WT_OUT);
    volatile LAS unsigned* xbst = (volatile LAS unsigned*)(smem + LDS_BYTES - 16);
    if (threadIdx.x == 0) { xbst[0] = 0u; xbst[1] = 0u; xbst[2] = 0u; xbst[3] = 0u; }
    __syncthreads();
    const XcdBarrier xbar = xcd_barrier_post((unsigned*)(ws + WS_BAR), xbst);
    if (p.pad == 0x5eed) grid.sync();
#define GSYNC() xcd_barrier(xbar)
    prep_phase(p, smem);
    GSYNC();
    if (PROBE & 2) { prep_phase(p, smem); GSYNC(); }
    norm_phase(p, 0);
    GSYNC();
    if (PROBE & 2) { norm_phase(p, 0); GSYNC(); }
    {
        bf16_t* Uz = U; bf16_t* Uxbc = U + (size_t)TOK * 2048; bf16_t* SB = Uxbc; bf16_t* XBC = SCR;
        { EpiSSD e{Uz, Uxbc, (float*)(ws + WS_DT), p.in[16]}; run_gemm(H, 1024, (const bf16_t*)(ws + WS_WT_SSD), 6400, 1024, e, smem);
          if (PROBE & 1) { GSYNC(); run_gemm(H, 1024, (const bf16_t*)(ws + WS_WT_SSD), 6400, 1024, e, smem); } }
        GSYNC();
        ssd_conv_phase(p, Uxbc, XBC);
        GSYNC();
        ssd_state_phase(p, XBC, SB, smem);
        GSYNC();
        if (PROBE & 2) { ssd_state_phase(p, XBC, SB, smem); GSYNC(); }
        ssd_scan_phase(p, SB);
        GSYNC();
        if (PROBE & 8) { ssd_out_phase<true>(p, XBC, SB, Uz, smem); GSYNC(); }
        ssd_out_phase<false>(p, XBC, SB, Uz, smem);
        GSYNC();
        { EpiOut e{p.in[0], p.in[1], p.out, MOD + 0 * 3 * 3072, (const float*)(ws + WS_SSQ), 1}; run_gemm(Uz, 2048, WtOut, 1024, 2048, e, smem);
          if (PROBE & 1) { GSYNC(); run_gemm(Uz, 2048, WtOut, 1024, 2048, e, smem); } }
        GSYNC();
    }
    if (PROBE & 256) { for (int i = 0; i < 20; ++i) GSYNC(); }
    norm_phase(p, 1);
    GSYNC();
    if (PROBE & 2) { norm_phase(p, 1); GSYNC(); }
    {
        { EpiMLP e{U}; run_gemm(H, 1024, (const bf16_t*)(ws + WS_WT_MLP), 6144, 1024, e, smem);
          if (PROBE & 1) { GSYNC(); run_gemm(H, 1024, (const bf16_t*)(ws + WS_WT_MLP), 6144, 1024, e, smem); } }
        GSYNC();
        mlp_stats_phase(p, U);
        GSYNC();
        if (PROBE & 2) { mlp_stats_phase(p, U); GSYNC(); }
        if (PROBE & 16) { mlp_mix_phase<true>(p, U, smem); GSYNC(); }
        mlp_mix_phase<false>(p, U, smem);
        GSYNC();
        { EpiOut e{p.in[0], p.in[1], p.out, MOD + 1 * 3 * 3072, nullptr, 0}; run_gemm(U, 6144, WtOut + (size_t)1 * 1024 * 2048, 1024, 2048, e, smem); }
        GSYNC();
    }
    norm_phase(p, 2);
    GSYNC();
    if (PROBE & 2) { norm_phase(p, 2); GSYNC(); }
    {
        bf16_t* Uu = U; bf16_t* Uz = U + (size_t)TOK * 2048; bf16_t* Ydir = SCR;
        { EpiS5 e{Uu, Uz}; run_gemm(H, 1024, (const bf16_t*)(ws + WS_WT_S5), 4096, 1024, e, smem);
          if (PROBE & 1) { GSYNC(); run_gemm(H, 1024, (const bf16_t*)(ws + WS_WT_S5), 4096, 1024, e, smem); } }
        GSYNC();
        s5_scan_phase(p, Uu, Ydir, smem);
        GSYNC();
        if (PROBE & 4) { s5_scan_phase(p, Uu, Ydir, smem); GSYNC(); }
        s5_post_phase(p, Uu, Ydir);
        GSYNC();
        { EpiGLU e{Ydir, Uz, p.in[35]}; run_gemm(Ydir, 2048, (const bf16_t*)(ws + WS_WT_GLU), 2048, 2048, e, smem); }
        GSYNC();
        { EpiOut e{p.in[0], p.in[1], p.out, MOD + 2 * 3 * 3072, nullptr, 0}; run_gemm(Uz, 2048, WtOut + (size_t)2 * 1024 * 2048, 1024, 2048, e, smem); }
        GSYNC();
    }
    norm_phase(p, 3);
    GSYNC();
    if (PROBE & 2) { norm_phase(p, 3); GSYNC(); }
    {
        bf16_t* Q = U; bf16_t* Z = U + (size_t)TOK * 2048; bf16_t* Kl = U + (size_t)TOK * 4096; bf16_t* Vl = Kl + (size_t)4096 * 2048;
        bf16_t* Kc = (bf16_t*)(ws + WS_WT_SSD);
        bf16_t* Vc0 = (bf16_t*)(ws + WS_WT_GLU);
        bf16_t* Vc1 = (bf16_t*)(ws + WS_U + 134217728);
        bf16_t* CKb = Vc1 + (size_t)12 * 256 * 2048;
        bf16_t* CVb = CKb + (size_t)2 * 32 * 256 * 64;
        { EpiNAT e{Q, Z, Kl, Vl, p.out + OUT_CK, p.out + OUT_CV, Kc, Vc0, Vc1}; run_gemm(H, 1024, (const bf16_t*)(ws + WS_WT_NAT), 8192, 1024, e, smem);
          if (PROBE & 1) { GSYNC(); run_gemm(H, 1024, (const bf16_t*)(ws + WS_WT_NAT), 8192, 1024, e, smem); }
          { const int t2 = otid(); for (int v = blockIdx.x * NT + t2; v < 2 * 131072; v += gridDim.x * NT) { const int w = v >= 131072; const size_t o = (size_t)(v - w * 131072) * 8;
                const float* sp = (w ? p.in[5] : p.in[4]) + o; const f32x4 a = *(const f32x4*)sp, b2 = *(const f32x4*)(sp + 4); *(u32x4*)((w ? CVb : CKb) + o) = pack44(a, b2); } } }
        GSYNC();
        { const AttnBufs ab{Q, Z, Kl, Vl, Kc, Vc0, Vc1, CKb, CVb};
          if (PROBE & (32 | 64 | 128)) { attn_phase<true>(p, ab, smem); GSYNC(); }
          attn_phase<false>(p, ab, smem); }
        GSYNC();
        { EpiOut e{p.in[0], p.in[1], p.out, MOD + 3 * 3 * 3072, nullptr, 0}; run_gemm(Q, 2048, WtOut + (size_t)3 * 1024 * 2048, 1024, 2048, e, smem); }
        GSYNC();
    }
    final_phase(p);
}

extern "C" void kernel_launch(void* const* d_in, const int* in_sizes, int n_in, void* d_out, int out_size, void* d_ws, size_t ws_size,
                              hipStream_t stream) {
    static int grid_blocks = 0;
    if (grid_blocks == 0) {
        int dev = 0, cus = 0, per_cu = 0;
        hipGetDevice(&dev);
        hipDeviceGetAttribute(&cus, hipDeviceAttributeMultiprocessorCount, dev);
        if (hipFuncSetAttribute((const void*)fwd_megakernel, hipFuncAttributeMaxDynamicSharedMemorySize, LDS_BYTES) != hipSuccess) { fprintf(stderr, "hipFuncSetAttribute failed\n"); }
        if (hipOccupancyMaxActiveBlocksPerMultiprocessor(&per_cu, (const void*)fwd_megakernel, NT, LDS_BYTES) != hipSuccess || per_cu < 1) { fprintf(stderr, "occupancy query failed (%d)\n", per_cu); per_cu = 1; }
        (void)hipGetLastError();
        grid_blocks = cus;
        if (ws_size < WS_END) { fprintf(stderr, "workspace too small: %zu < %zu\n", ws_size, (size_t)WS_END); grid_blocks = -1; }
        if (n_in != 38) { fprintf(stderr, "expected 38 inputs, got %d\n", n_in); grid_blocks = -1; }
    }
    if (grid_blocks < 0) return;
    Params p;
    memset(&p, 0, sizeof(p));
    for (int i = 0; i < 38; ++i) p.in[i] = (const float*)d_in[i];
    p.out = (float*)d_out; p.ws = (char*)d_ws;
    char* ws = (char*)d_ws;
    int t0 = 0;
    auto job = [&](int i, const float* src, size_t off, int K, int N, int Npad) {
        p.jobs[i].src = src; p.jobs[i].dst = (bf16_t*)(ws + off); p.jobs[i].K = K; p.jobs[i].N = N; p.jobs[i].Npad = Npad; p.jobs[i].tile0 = t0; t0 += (K / 64) * (Npad / 64);
    };
    job(0, p.in[13], WS_WT_SSD, 1024, 6208, 6400);
    job(1, p.in[20], WS_WT_MLP, 1024, 6144, 6144);
    job(2, p.in[25], WS_WT_S5, 1024, 4096, 4096);
    job(3, p.in[36], WS_WT_NAT, 1024, 8192, 8192);
    job(4, p.in[34], WS_WT_GLU, 2048, 2048, 2048);
    for (int l = 0; l < 4; ++l) job(5 + l, p.in[11] + (size_t)l * 2048 * 1024, WS_WT_OUT + (size_t)l * 1024 * 2048 * 2, 2048, 1024, 1024);
    p.total_tiles = t0;
    if (hipMemsetAsync(ws + WS_BAR, 0, XCD_BAR_WORDS * 4, stream) != hipSuccess) { fprintf(stderr, "memset of barrier words failed\n"); return; }
    void* args[] = {&p};
    hipError_t e = hipLaunchCooperativeKernel((const void*)fwd_megakernel, dim3(grid_blocks), dim3(NT), args, LDS_BYTES, stream);
    if (e != hipSuccess) fprintf(stderr, "cooperative launch failed: %s (grid %d)\n", hipGetErrorString(e), grid_blocks);
}
```
